# Optimizing an MI355X kernel written in HIP

```python
import math
import jax, jax.numpy as jnp
from jax import lax
import numpy as np

D_MODEL = 1024
BATCH = 8
SEQ = 2048
DEPTH = 1
DEC_BATCH = 128
DEC_SEQ = 1
PAST_LEN = 16384
PAGE_SIZE = 128

MIX = D_MODEL
POOL_WIDTH = MIX // 2
POOL_WINDOWS = (2, 4, 8, 16)
POOL_GROUPS = len(POOL_WINDOWS)
POOL_GROUP_W = POOL_WIDTH // POOL_GROUPS
POOL_HIST = max(POOL_WINDOWS) - 1
CONV_CH = MIX - POOL_WIDTH
CONV_K = 31
CONV_HIST = CONV_K - 1
IN_COLS = POOL_WIDTH + 2 * CONV_CH
N_MEM = 256
MEM_HEADS = 4
MEM_HEAD_DIM = D_MODEL // MEM_HEADS
D_FF = -(-8 * D_MODEL // (3 * 256)) * 256
EPS = 1e-6

kernel_name = "hymba_pool_conformer_memxattn_step"


def rmsnorm(x, g):
    xf = x.astype(jnp.float32)
    y = xf * lax.rsqrt(jnp.mean(xf * xf, axis=-1, keepdims=True) + EPS)
    return (y * g.astype(jnp.float32)).astype(x.dtype)


def pool_mixer(a_ext, start_pos, w_map, b_map, scale):
    B, T, C = a_ext.shape
    L = T - POOL_HIST
    af = a_ext.astype(jnp.float32)
    csum = jnp.concatenate([jnp.zeros((B, 1, C), jnp.float32), jnp.cumsum(af, axis=1)], axis=1)
    pos = start_pos + jnp.arange(L)
    outs = []
    for g, w in enumerate(POOL_WINDOWS):
        sl = slice(g * POOL_GROUP_W, (g + 1) * POOL_GROUP_W)
        cg = csum[..., sl]
        win_sum = cg[:, POOL_HIST + 1:] - cg[:, POOL_HIST + 1 - w: POOL_HIST + 1 - w + L]
        cnt = jnp.minimum(w, pos + 1).astype(jnp.float32)[None, :, None]
        outs.append(win_sum / cnt - af[:, POOL_HIST:, sl])
    d = jnp.concatenate(outs, axis=-1).reshape(B, L, POOL_GROUPS, POOL_GROUP_W)
    y = jnp.einsum('blgc,gcd->blgd', d, w_map.astype(jnp.float32)).reshape(B, L, C)
    y = (y + b_map.astype(jnp.float32)) * scale.astype(jnp.float32)
    return y.astype(a_ext.dtype)


def conv_mixer(g_ext, w_dw, b_dw, ln_g, ln_b):
    y = lax.conv_general_dilated(g_ext, w_dw[:, None, :], window_strides=(1,), padding='VALID',
                                 dimension_numbers=('NWC', 'WIO', 'NWC'), feature_group_count=CONV_CH)
    yf = (y + b_dw).astype(jnp.float32)
    mu = jnp.mean(yf, axis=-1, keepdims=True)
    var = jnp.mean(jnp.square(yf - mu), axis=-1, keepdims=True)
    yn = (yf - mu) * lax.rsqrt(var + EPS) * ln_g.astype(jnp.float32) + ln_b.astype(jnp.float32)
    return jax.nn.silu(yn).astype(g_ext.dtype)


def mem_kv(mem, g_mem, w_k, w_v):
    B = mem.shape[0]
    m = rmsnorm(mem, g_mem)
    k = (m @ w_k).reshape(B, N_MEM, MEM_HEADS, MEM_HEAD_DIM)
    v = (m @ w_v).reshape(B, N_MEM, MEM_HEADS, MEM_HEAD_DIM)
    return k, v


def cross_attn(h, k, v, w_q, w_o):
    B, L, _ = h.shape
    q = (h @ w_q).reshape(B, L, MEM_HEADS, MEM_HEAD_DIM)
    s = jnp.einsum('blhd,bmhd->bhlm', q, k).astype(jnp.float32) / math.sqrt(MEM_HEAD_DIM)
    p = jax.nn.softmax(s, axis=-1).astype(v.dtype)
    o = jnp.einsum('bhlm,bmhd->blhd', p, v).reshape(B, L, D_MODEL)
    return o @ w_o


def layer(x, pool_hist, conv_hist, start_pos, mk, mv, g_mix, w_in, pool_map_w, pool_map_b, pool_scale,
          conv_dw_w, conv_dw_b, conv_ln_g, conv_ln_b, w_out, g_attn, w_q, w_o, g_ffn, w_gate, w_up, w_down):
    h = rmsnorm(x, g_mix)
    u = h @ w_in
    a = u[..., :POOL_WIDTH]
    val = u[..., POOL_WIDTH:POOL_WIDTH + CONV_CH]
    gate = u[..., POOL_WIDTH + CONV_CH:]
    glu = val * jax.nn.sigmoid(gate)
    a_ext = jnp.concatenate([pool_hist, a], axis=1)
    g_ext = jnp.concatenate([conv_hist, glu], axis=1)
    ya = pool_mixer(a_ext, start_pos, pool_map_w, pool_map_b, pool_scale)
    yb = conv_mixer(g_ext, conv_dw_w, conv_dw_b, conv_ln_g, conv_ln_b)
    x = x + jnp.concatenate([ya, yb], axis=-1) @ w_out
    x = x + cross_attn(rmsnorm(x, g_attn), mk, mv, w_q, w_o)
    h = rmsnorm(x, g_ffn)
    x = x + (jax.nn.silu(h @ w_gate) * (h @ w_up)) @ w_down
    return x, a_ext[:, -POOL_HIST:], g_ext[:, -CONV_HIST:]


def setup_inputs(seed: int = 0) -> dict:
    key = jax.random.key(seed)
    ks = jax.random.split(key, 32)
    f32 = jnp.float32

    def nrm(k, shape, scale=1.0):
        return jax.random.normal(k, shape, f32) * scale

    def gain(k, shape):
        return 1.0 + 0.05 * jax.random.normal(k, shape, f32)

    return {
        "x_prompt": nrm(ks[0], (BATCH, SEQ, D_MODEL)),
        "x_sample": nrm(ks[1], (DEC_BATCH, DEC_SEQ, D_MODEL)),
        "mem_prompt": nrm(ks[2], (BATCH, N_MEM, D_MODEL)),
        "state_pool": nrm(ks[3], (DEPTH, DEC_BATCH, POOL_HIST, POOL_WIDTH)),
        "state_conv": nrm(ks[4], (DEPTH, DEC_BATCH, CONV_HIST, CONV_CH), 0.5),
        "cache_mem_k": nrm(ks[5], (DEPTH, DEC_BATCH, N_MEM, MEM_HEADS, MEM_HEAD_DIM)),
        "cache_mem_v": nrm(ks[6], (DEPTH, DEC_BATCH, N_MEM, MEM_HEADS, MEM_HEAD_DIM)),
        "g_mix": gain(ks[7], (DEPTH, D_MODEL)),
        "w_in": nrm(ks[8], (DEPTH, D_MODEL, IN_COLS), D_MODEL ** -0.5),
        "pool_map_w": nrm(ks[9], (DEPTH, POOL_GROUPS, POOL_GROUP_W, POOL_GROUP_W), POOL_GROUP_W ** -0.5),
        "pool_map_b": nrm(ks[10], (DEPTH, POOL_WIDTH), 0.02),
        "pool_scale": gain(ks[11], (DEPTH, POOL_WIDTH)),
        "conv_dw_w": nrm(ks[12], (DEPTH, CONV_K, CONV_CH), CONV_K ** -0.5),
        "conv_dw_b": nrm(ks[13], (DEPTH, CONV_CH), 0.02),
        "conv_ln_g": gain(ks[14], (DEPTH, CONV_CH)),
        "conv_ln_b": nrm(ks[15], (DEPTH, CONV_CH), 0.02),
        "w_out": nrm(ks[16], (DEPTH, MIX, D_MODEL), MIX ** -0.5),
        "g_attn": gain(ks[17], (DEPTH, D_MODEL)),
        "g_mem": gain(ks[18], (DEPTH, D_MODEL)),
        "w_q": nrm(ks[19], (DEPTH, D_MODEL, D_MODEL), D_MODEL ** -0.5),
        "w_k": nrm(ks[20], (DEPTH, D_MODEL, D_MODEL), D_MODEL ** -0.5),
        "w_v": nrm(ks[21], (DEPTH, D_MODEL, D_MODEL), D_MODEL ** -0.5),
        "w_o": nrm(ks[22], (DEPTH, D_MODEL, D_MODEL), D_MODEL ** -0.5),
        "g_ffn": gain(ks[23], (DEPTH, D_MODEL)),
        "w_gate": nrm(ks[24], (DEPTH, D_MODEL, D_FF), D_MODEL ** -0.5),
        "w_up": nrm(ks[25], (DEPTH, D_MODEL, D_FF), D_MODEL ** -0.5),
        "w_down": nrm(ks[26], (DEPTH, D_FF, D_MODEL), D_FF ** -0.5),
        "g_final": gain(ks[27], (D_MODEL,)),
    }


def reference(x_prompt, x_sample, mem_prompt, state_pool, state_conv, cache_mem_k, cache_mem_v,
              g_mix, w_in, pool_map_w, pool_map_b, pool_scale, conv_dw_w, conv_dw_b, conv_ln_g, conv_ln_b,
              w_out, g_attn, g_mem, w_q, w_k, w_v, w_o, g_ffn, w_gate, w_up, w_down, g_final):
    xp, xs = x_prompt, x_sample
    pool_p, pool_s, conv_p, conv_s, mk_p, mv_p = [], [], [], [], [], []
    for l in range(DEPTH):
        shared = (g_mix[l], w_in[l], pool_map_w[l], pool_map_b[l], pool_scale[l], conv_dw_w[l], conv_dw_b[l],
                  conv_ln_g[l], conv_ln_b[l], w_out[l], g_attn[l], w_q[l], w_o[l], g_ffn[l], w_gate[l], w_up[l],
                  w_down[l])
        mk, mv = mem_kv(mem_prompt, g_mem[l], w_k[l], w_v[l])
        zp = jnp.zeros((xp.shape[0], POOL_HIST, POOL_WIDTH), xp.dtype)
        zc = jnp.zeros((xp.shape[0], CONV_HIST, CONV_CH), xp.dtype)
        xp, hp, cp = layer(xp, zp, zc, 0, mk, mv, *shared)
        xs, hs, cs = layer(xs, state_pool[l], state_conv[l], PAST_LEN, cache_mem_k[l], cache_mem_v[l], *shared)
        pool_p.append(hp); pool_s.append(hs); conv_p.append(cp); conv_s.append(cs)
        mk_p.append(mk); mv_p.append(mv)
    y_prompt = rmsnorm(xp, g_final)
    y_sample = rmsnorm(xs, g_final)
    return (y_prompt, y_sample, jnp.stack(pool_p), jnp.stack(pool_s), jnp.stack(conv_p), jnp.stack(conv_s),
            jnp.stack(mk_p), jnp.stack(mv_p))
```

```cpp
#include <hip/hip_runtime.h>
#include <hip/hip_cooperative_groups.h>
#include <cstdio>
#include <cstdint>
namespace cg = cooperative_groups;
namespace pg8 {
#define PG8_LAS __attribute__((address_space(3)))
typedef unsigned short bf16_t;
typedef short bf16x8 __attribute__((ext_vector_type(8)));
typedef float f32x4 __attribute__((ext_vector_type(4)));
typedef unsigned u32x4 __attribute__((ext_vector_type(4)));
constexpr int BM = 256, BK = 64, HALF = 128, HTB = HALF * BK * 2  , STAGE_BYTES = 8 * HTB, NXCD = 8, WGM = 8;

__host__ __device__ __forceinline__ int lds_byte(int r, int c) { const int st = (r >> 4) * 2 + (c >> 5), rr = r & 15, cc = c & 31, ob = rr * 64 + cc * 2; return st * 1024 + (ob ^ (((ob >> 9) & 1) << 5)); }
__host__ __device__ __forceinline__ void stage_rc(int b, int& R, int& C) { const int st = b / 1024, sb = b % 1024, swz = sb ^ (((sb >> 9) & 1) << 5); R = (st >> 1) * 16 + swz / 64; C = (st & 1) * 32 + (swz % 64) / 2; }
__host__ __device__ __forceinline__ int perm32(int rho) { const int n = rho >> 4, i = rho & 15; return 8 * (i >> 2) + 4 * n + (i & 3); }

struct Unit { int pm, pn; };
struct Gemm { const bf16_t* A; const bf16_t* Bt; int M, N, K; };

struct StaticOrder {
    int nM, nN, nwg, G, c;
    __host__ __device__ void init(int M, int N, int G_, int c_) { nM = M / BM; nN = N / BM; nwg = nM * nN; G = G_; c = c_; }
    __host__ __device__ bool next(int i, Unit& u) const {
        const long L = (long)i * G + c; if (L >= nwg) return false;
        int wgid = (int)L; { const int q = nwg / NXCD, r = nwg % NXCD, xcd = wgid % NXCD, off = wgid / NXCD; wgid = (xcd < r ? xcd * (q + 1) : r * (q + 1) + (xcd - r) * q) + off; }
        const int nig = WGM * nN, gid = wgid / nig, fm = gid * WGM, gsz = (nM - fm) < WGM ? (nM - fm) : WGM;
        u.pm = fm + ((wgid % nig) % gsz); u.pn = (wgid % nig) / gsz; return true;
    }
    __device__ __forceinline__ void a_ready(const Unit&) const {}
    __device__ __forceinline__ void done(const Unit&) const {}
};
typedef unsigned u32x4 __attribute__((ext_vector_type(4)));
constexpr float EPSF = 1e-6f;
__device__ __forceinline__ unsigned cvt_pk_bf16(float lo, float hi) { unsigned r; asm volatile("v_cvt_pk_bf16_f32 %0, %1, %2" : "=v"(r) : "v"(lo), "v"(hi)); return r; }
__device__ __forceinline__ u32x4 pack8(const f32x4 a, const f32x4 b) { u32x4 w; w.x = cvt_pk_bf16(a[0], a[1]); w.y = cvt_pk_bf16(a[2], a[3]); w.z = cvt_pk_bf16(b[0], b[1]); w.w = cvt_pk_bf16(b[2], b[3]); return w; }
__device__ __forceinline__ float sigm(float x) { return __builtin_amdgcn_rcpf(1.0f + __builtin_amdgcn_exp2f(-1.4426950408889634f * x)); }
__device__ __forceinline__ float rstd16(const float* p) {
    const f32x4 a = ((const f32x4*)p)[0], b = ((const f32x4*)p)[1], c = ((const f32x4*)p)[2], d = ((const f32x4*)p)[3];
    const float s = ((a[0] + a[1]) + (a[2] + a[3])) + ((b[0] + b[1]) + (b[2] + b[3])) + ((c[0] + c[1]) + (c[2] + c[3])) + ((d[0] + d[1]) + (d[2] + d[3]));
    return 1.0f / sqrtf(s * (1.0f / 1024.0f) + EPSF);
}
struct EpiIn {
    static constexpr bool PERM = true, AFTER_DRAIN = false;
    bf16_t* AP; bf16_t* GLU; float* outPP; float* outCP;
    __device__ __forceinline__ void operator()(const f32x4 (&acc)[2][2][4][2], const Unit& u, int wr, int wc, int fr, int fq) const {
        const int row0 = u.pm * BM + wr * 64 + fr, cl = wc * 32 + 8 * fq;
        if (u.pn < 2) {
#pragma unroll
            for (int ai = 0; ai < 2; ++ai)
#pragma unroll
                for (int m = 0; m < 4; ++m) { const int row = row0 + ai * HALF + m * 16, t = row & 2047, b = row >> 11;
#pragma unroll
                    for (int bj = 0; bj < 2; ++bj) { const int col = u.pn * 256 + bj * HALF + cl; const f32x4 v0 = acc[ai][bj][m][0], v1 = acc[ai][bj][m][1];
                        *(u32x4*)(AP + (size_t)row * 512 + col) = pack8(v0, v1);
                        if (t >= 2033) { float* o = outPP + ((size_t)(b * 15 + t - 2033) * 512 + col); *(f32x4*)o = v0; *(f32x4*)(o + 4) = v1; } } }
        } else {
            const int ch = (u.pn - 2) * 128 + cl;
#pragma unroll
            for (int ai = 0; ai < 2; ++ai)
#pragma unroll
                for (int m = 0; m < 4; ++m) { const int row = row0 + ai * HALF + m * 16, t = row & 2047, b = row >> 11;
                    f32x4 o0, o1;
#pragma unroll
                    for (int j = 0; j < 4; ++j) { o0[j] = acc[ai][0][m][0][j] * sigm(acc[ai][1][m][0][j]); o1[j] = acc[ai][0][m][1][j] * sigm(acc[ai][1][m][1][j]); }
                    *(u32x4*)(GLU + (size_t)row * 512 + ch) = pack8(o0, o1);
                    if (t >= 2018) { float* o = outCP + ((size_t)(b * 30 + t - 2018) * 512 + ch); *(f32x4*)o = o0; *(f32x4*)(o + 4) = o1; } }
        }
    }
};
struct EpiKV {
    static constexpr bool PERM = true, AFTER_DRAIN = false;
    float* outK; float* outV; bf16_t* KB;
    __device__ __forceinline__ void operator()(const f32x4 (&acc)[2][2][4][2], const Unit& u, int wr, int wc, int fr, int fq) const {
        const int row0 = u.pm * BM + wr * 64 + fr, cl = wc * 32 + 8 * fq;
#pragma unroll
        for (int ai = 0; ai < 2; ++ai)
#pragma unroll
            for (int m = 0; m < 4; ++m) { const int row = row0 + ai * HALF + m * 16;
#pragma unroll
                for (int bj = 0; bj < 2; ++bj) { const int col = u.pn * 256 + bj * HALF + cl; const f32x4 v0 = acc[ai][bj][m][0], v1 = acc[ai][bj][m][1];
                    if (u.pn < 4) { float* o = outK + (size_t)row * 1024 + col; *(f32x4*)o = v0; *(f32x4*)(o + 4) = v1; *(u32x4*)(KB + (size_t)row * 1024 + col) = pack8(v0, v1); }
                    else { float* o = outV + (size_t)row * 1024 + (col - 1024); *(f32x4*)o = v0; *(f32x4*)(o + 4) = v1; } } }
    }
};
struct EpiPlain {
    static constexpr bool PERM = true, AFTER_DRAIN = false;
    bf16_t* O; int ldc;
    __device__ __forceinline__ void operator()(const f32x4 (&acc)[2][2][4][2], const Unit& u, int wr, int wc, int fr, int fq) const {
        const int row0 = u.pm * BM + wr * 64 + fr, cl = wc * 32 + 8 * fq;
#pragma unroll
        for (int ai = 0; ai < 2; ++ai)
#pragma unroll
            for (int m = 0; m < 4; ++m) { const int row = row0 + ai * HALF + m * 16;
#pragma unroll
                for (int bj = 0; bj < 2; ++bj) { const int col = u.pn * 256 + bj * HALF + cl; *(u32x4*)(O + (size_t)row * ldc + col) = pack8(acc[ai][bj][m][0], acc[ai][bj][m][1]); } }
    }
};
struct EpiRes {
    static constexpr bool PERM = true, AFTER_DRAIN = false;
    const float* resid; float* xout; bf16_t* xb; float* ssq;
    __device__ __forceinline__ void operator()(const f32x4 (&acc)[2][2][4][2], const Unit& u, int wr, int wc, int fr, int fq) const {
        const int row0 = u.pm * BM + wr * 64 + fr, cl = wc * 32 + 8 * fq;
#pragma unroll
        for (int ai = 0; ai < 2; ++ai)
#pragma unroll
            for (int m = 0; m < 4; ++m) { const int row = row0 + ai * HALF + m * 16; float ss = 0.f;
#pragma unroll
                for (int bj = 0; bj < 2; ++bj) { const size_t off = (size_t)row * 1024 + u.pn * 256 + bj * HALF + cl;
                    const f32x4 r0 = *(const f32x4*)(resid + off), r1 = *(const f32x4*)(resid + off + 4);
                    const f32x4 x0 = r0 + acc[ai][bj][m][0], x1 = r1 + acc[ai][bj][m][1];
                    *(f32x4*)(xout + off) = x0; *(f32x4*)(xout + off + 4) = x1;
                    if (xb) *(u32x4*)(xb + off) = pack8(x0, x1);
                    ss += ((x0[0] * x0[0] + x0[1] * x0[1]) + (x0[2] * x0[2] + x0[3] * x0[3])) + ((x1[0] * x1[0] + x1[1] * x1[1]) + (x1[2] * x1[2] + x1[3] * x1[3])); }
                ss += __shfl_xor(ss, 16); ss += __shfl_xor(ss, 32);
                if (fq == 0) ssq[(size_t)row * 16 + u.pn * 4 + wc] = ss; }
    }
};
struct EpiQ {
    static constexpr bool PERM = true, AFTER_DRAIN = false;
    const float* ssq; bf16_t* Q; float scale;
    __device__ __forceinline__ void operator()(const f32x4 (&acc)[2][2][4][2], const Unit& u, int wr, int wc, int fr, int fq) const {
        const int row0 = u.pm * BM + wr * 64 + fr, cl = wc * 32 + 8 * fq;
#pragma unroll
        for (int ai = 0; ai < 2; ++ai)
#pragma unroll
            for (int m = 0; m < 4; ++m) { const int row = row0 + ai * HALF + m * 16; const float rs = rstd16(ssq + (size_t)row * 16) * scale;
#pragma unroll
                for (int bj = 0; bj < 2; ++bj) { const size_t off = (size_t)row * 1024 + u.pn * 256 + bj * HALF + cl;
                    *(u32x4*)(Q + off) = pack8(acc[ai][bj][m][0] * rs, acc[ai][bj][m][1] * rs); } }
    }
};
struct EpiGU {
    static constexpr bool PERM = true, AFTER_DRAIN = false;
    const float* ssq; bf16_t* F;
    __device__ __forceinline__ void operator()(const f32x4 (&acc)[2][2][4][2], const Unit& u, int wr, int wc, int fr, int fq) const {
        const int row0 = u.pm * BM + wr * 64 + fr, cl = wc * 32 + 8 * fq;
#pragma unroll
        for (int ai = 0; ai < 2; ++ai)
#pragma unroll
            for (int m = 0; m < 4; ++m) { const int row = row0 + ai * HALF + m * 16; const float rs = rstd16(ssq + (size_t)row * 16);
                f32x4 o0, o1;
#pragma unroll
                for (int j = 0; j < 4; ++j) { const float g0 = acc[ai][0][m][0][j] * rs, g1 = acc[ai][0][m][1][j] * rs;
                    o0[j] = g0 * sigm(g0) * (acc[ai][1][m][0][j] * rs); o1[j] = g1 * sigm(g1) * (acc[ai][1][m][1][j] * rs); }
                *(u32x4*)(F + (size_t)row * 2816 + u.pn * 128 + cl) = pack8(o0, o1); }
    }
};
template <class Epi, class Sched, bool ALIGN_EPI = false, bool SP2 = false>
__device__ __forceinline__ void gemm_phase(PG8_LAS unsigned char* lds, const Gemm g, const Sched& S, const Epi& E) {
    const int tid = threadIdx.x, wid = __builtin_amdgcn_readfirstlane(tid >> 6), lane = tid & 63, wr = wid >> 2, wc = wid & 3, fr = lane & 15, fq = lane >> 4;
    const int K = g.K, nt = K / BK;
    unsigned voffA[2], voffB[2];
#pragma unroll
    for (int i = 0; i < 2; ++i) { int R, C; stage_rc(tid * 16 + i * 8192, R, C); const int Rb = Epi::PERM ? ((R & ~31) + perm32(R & 31)) : R;
        voffA[i] = (unsigned)(R * K + C) * 2u; voffB[i] = (unsigned)(Rb * K + C) * 2u; }
    const size_t kstep = (size_t)(BK * 2);
    const size_t hstep = (size_t)HALF * K * 2;
    const size_t tstep = 2 * hstep;
    const unsigned ldsw = (unsigned)wid * 1024u;
    const int aoff = lds_byte(wr * 64 + fr, fq * 8), boff = lds_byte(wc * 32 + fr, fq * 8);
#define PG8_SA(b, h) (((b) * 2 + (h)) * HTB)
#define PG8_SB(b, h) ((4 + (b) * 2 + (h)) * HTB)
#define PG8_STAGE(bufoff, gbase, voff) do { _Pragma("unroll") for (int _i = 0; _i < 2; ++_i) \
        __builtin_amdgcn_global_load_lds((const unsigned*)((const char*)(gbase) + (voff)[_i]), (PG8_LAS unsigned*)(lds + (bufoff) + ldsw + _i * 8192), 16, 0, 0); } while (0)
#define PG8_LDA(dst, b, h) do { _Pragma("unroll") for (int m = 0; m < 4; ++m) _Pragma("unroll") for (int k = 0; k < 2; ++k) dst[m][k] = *(const PG8_LAS bf16x8*)(lds + PG8_SA(b, h) + aoff + m * 2048 + k * 1024); } while (0)
#define PG8_LDB(dst, b, h) do { _Pragma("unroll") for (int n = 0; n < 2; ++n) _Pragma("unroll") for (int k = 0; k < 2; ++k) dst[n][k] = *(const PG8_LAS bf16x8*)(lds + PG8_SB(b, h) + boff + n * 2048 + k * 1024); } while (0)
#define PG8_MMA(ai, bj, At, Bt) do { __builtin_amdgcn_s_setprio(1); _Pragma("unroll") for (int m = 0; m < 4; ++m) _Pragma("unroll") for (int n = 0; n < 2; ++n) _Pragma("unroll") for (int k = 0; k < 2; ++k) \
        acc[ai][bj][m][n] = __builtin_amdgcn_mfma_f32_16x16x32_bf16(Bt[n][k], At[m][k], acc[ai][bj][m][n], 0, 0, 0); __builtin_amdgcn_s_setprio(0); } while (0)
#define PG8_WAIT_V(n) asm volatile("s_waitcnt vmcnt(" #n ")" ::: "memory")
#define PG8_WAIT_L(n) asm volatile("s_waitcnt lgkmcnt(" #n ")" ::: "memory")
#define PG8_BAR __builtin_amdgcn_s_barrier()
#define PG8_SCHED __builtin_amdgcn_sched_barrier(0)
    Unit cur, nxt; int ui = 0;
    if (!S.next(0, cur)) return;
    f32x4 acc[2][2][4][2];
#pragma unroll
    for (int a = 0; a < 2; ++a)
#pragma unroll
        for (int b = 0; b < 2; ++b)
#pragma unroll
            for (int m = 0; m < 4; ++m)
#pragma unroll
                for (int n = 0; n < 2; ++n) acc[a][b][m][n] = (f32x4){0.f, 0.f, 0.f, 0.f};
    bf16x8 At[4][2], B0[2][2], B1[2][2];
    const char* cA = (const char*)g.A + (size_t)cur.pm * tstep; const char* cB = (const char*)g.Bt + (size_t)cur.pn * tstep;
    S.a_ready(cur);
    if constexpr (SP2) {
        PG8_STAGE(PG8_SB(0, 0), cB, voffB); PG8_STAGE(PG8_SB(0, 1), cB + hstep, voffB); PG8_STAGE(PG8_SA(0, 0), cA, voffA); PG8_STAGE(PG8_SA(0, 1), cA + hstep, voffA);
        if (wr == 1) PG8_BAR;
        PG8_WAIT_V(2); PG8_BAR;
        PG8_STAGE(PG8_SB(1, 0), cB + kstep, voffB); PG8_STAGE(PG8_SA(1, 0), cA + kstep, voffA); PG8_STAGE(PG8_SB(1, 1), cB + hstep + kstep, voffB);
        PG8_WAIT_V(6); PG8_BAR;
    } else {
        PG8_STAGE(PG8_SB(0, 0), cB, voffB); PG8_STAGE(PG8_SA(0, 0), cA, voffA); PG8_STAGE(PG8_SB(0, 1), cB + hstep, voffB); PG8_STAGE(PG8_SA(0, 1), cA + hstep, voffA);
        if (wr == 1) PG8_BAR;
        PG8_WAIT_V(4); PG8_BAR;
        PG8_STAGE(PG8_SB(1, 0), cB + kstep, voffB); PG8_STAGE(PG8_SA(1, 0), cA + kstep, voffA); PG8_STAGE(PG8_SB(1, 1), cB + hstep + kstep, voffB);
        PG8_WAIT_V(6); PG8_BAR;
    }
    for (;;) {
        const bool has_next = S.next(ui + 1, nxt);
        const char* nA = has_next ? (const char*)g.A + (size_t)nxt.pm * tstep : cA; const char* nB = has_next ? (const char*)g.Bt + (size_t)nxt.pn * tstep : cB;
        for (int t = 0; t < nt; t += 2) {
            const bool last = (t == nt - 2);
            const char* a1 = cA + (size_t)(t + 1) * kstep;
            const char* a2 = last ? nA : cA + (size_t)(t + 2) * kstep; const char* b2 = last ? nB : cB + (size_t)(t + 2) * kstep;
            const char* a3 = a2 + kstep; const char* b3 = b2 + kstep;
            if (last && has_next) S.a_ready(nxt);
            if constexpr (SP2) {
            PG8_LDB(B0, 0, 0); PG8_LDB(B1, 0, 1); PG8_SCHED; PG8_LDA(At, 0, 0); PG8_STAGE(PG8_SA(1, 1), a1 + hstep, voffA);
            PG8_WAIT_V(8); PG8_WAIT_L(0); PG8_BAR; PG8_MMA(0, 0, At, B0); PG8_MMA(0, 1, At, B1); PG8_BAR; PG8_SCHED;
            PG8_LDA(At, 0, 1); PG8_STAGE(PG8_SB(0, 0), b2, voffB); PG8_STAGE(PG8_SB(0, 1), b2 + hstep, voffB); PG8_STAGE(PG8_SA(0, 0), a2, voffA);
            PG8_WAIT_V(8); PG8_WAIT_L(0); PG8_BAR; PG8_MMA(1, 0, At, B0); PG8_MMA(1, 1, At, B1); PG8_BAR; PG8_SCHED;
            PG8_LDB(B0, 1, 0); PG8_LDB(B1, 1, 1); PG8_SCHED; PG8_LDA(At, 1, 0); PG8_STAGE(PG8_SA(0, 1), a2 + hstep, voffA);
            PG8_WAIT_V(8); PG8_WAIT_L(0); PG8_BAR; PG8_MMA(0, 0, At, B0); PG8_MMA(0, 1, At, B1); PG8_BAR; PG8_SCHED;
            PG8_LDA(At, 1, 1); PG8_STAGE(PG8_SB(1, 0), b3, voffB); PG8_STAGE(PG8_SB(1, 1), b3 + hstep, voffB); PG8_STAGE(PG8_SA(1, 0), a3, voffA);
            PG8_WAIT_V(8); PG8_WAIT_L(0); PG8_BAR; PG8_MMA(1, 0, At, B0); PG8_MMA(1, 1, At, B1); PG8_BAR; PG8_SCHED;
            } else {
            PG8_LDB(B0, 0, 0); PG8_SCHED; PG8_LDA(At, 0, 0); PG8_STAGE(PG8_SA(1, 1), a1 + hstep, voffA);
            PG8_WAIT_L(8); PG8_BAR; PG8_WAIT_L(0); PG8_MMA(0, 0, At, B0); PG8_BAR; PG8_SCHED;
            PG8_LDB(B1, 0, 1); PG8_STAGE(PG8_SB(0, 0), b2, voffB);
            PG8_BAR; PG8_WAIT_L(0); PG8_MMA(0, 1, At, B1); PG8_BAR;
            PG8_LDA(At, 0, 1); PG8_STAGE(PG8_SA(0, 0), a2, voffA);
            PG8_BAR; PG8_WAIT_L(0); PG8_MMA(1, 0, At, B0); PG8_BAR; PG8_SCHED;
            PG8_STAGE(PG8_SB(0, 1), b2 + hstep, voffB);
            PG8_WAIT_V(6); PG8_BAR; PG8_MMA(1, 1, At, B1); PG8_BAR;
            PG8_LDB(B0, 1, 0); PG8_SCHED; PG8_LDA(At, 1, 0); PG8_STAGE(PG8_SA(0, 1), a2 + hstep, voffA);
            PG8_WAIT_L(8); PG8_BAR; PG8_WAIT_L(0); PG8_MMA(0, 0, At, B0); PG8_BAR; PG8_SCHED;
            PG8_LDB(B1, 1, 1); PG8_STAGE(PG8_SB(1, 0), b3, voffB);
            PG8_BAR; PG8_WAIT_L(0); PG8_MMA(0, 1, At, B1); PG8_BAR;
            PG8_LDA(At, 1, 1); PG8_STAGE(PG8_SA(1, 0), a3, voffA);
            PG8_BAR; PG8_WAIT_L(0); PG8_MMA(1, 0, At, B0); PG8_BAR; PG8_SCHED;
            PG8_STAGE(PG8_SB(1, 1), b3 + hstep, voffB);
            PG8_WAIT_V(6); PG8_BAR; PG8_MMA(1, 1, At, B1); PG8_BAR;
            }
        }
        if constexpr (ALIGN_EPI) { if (wr == 0) PG8_BAR; }
        if constexpr (!Epi::AFTER_DRAIN) { E(acc, cur, wr, wc, fr, fq); S.done(cur); }
        if (!has_next) break;
#pragma unroll
        for (int a = 0; a < 2; ++a)
#pragma unroll
            for (int b = 0; b < 2; ++b)
#pragma unroll
                for (int m = 0; m < 4; ++m)
#pragma unroll
                    for (int n = 0; n < 2; ++n) acc[a][b][m][n] = (f32x4){0.f, 0.f, 0.f, 0.f};
        cur = nxt; cA = nA; cB = nB; ++ui;
        if constexpr (ALIGN_EPI) { if (wr == 1) PG8_BAR; }
    }
    PG8_WAIT_V(0);
    if constexpr (!ALIGN_EPI) { if (wr == 0) PG8_BAR; }
    PG8_BAR;
    if constexpr (Epi::AFTER_DRAIN) { E.fused(acc, cur, wr, wc, fr, fq, lds, wid, lane); S.done(cur); }
#undef PG8_SA
#undef PG8_SB
#undef PG8_STAGE
#undef PG8_LDA
#undef PG8_LDB
#undef PG8_MMA
#undef PG8_WAIT_V
#undef PG8_WAIT_L
#undef PG8_BAR
#undef PG8_SCHED
}
}

#define LAS __attribute__((address_space(3)))
typedef unsigned short bf16;
typedef float f32x4 __attribute__((ext_vector_type(4)));
typedef short bf16x8 __attribute__((ext_vector_type(8)));
typedef unsigned u32x4 __attribute__((ext_vector_type(4)));
typedef unsigned u32x2 __attribute__((ext_vector_type(2)));
constexpr int DM = 1024, NB = 8, SEQ = 2048, MP = NB * SEQ, NS = 128, MALL = MP + NS, NMEM = 256, FF = 2816, FF2 = 5632, MMEM = NB * NMEM;
constexpr float EPS = 1e-6f;
constexpr float QSCALE = 0.0625f * 1.4426950408889634f;
constexpr size_t O_Y = 0, O_YS = 16777216, O_PP = O_YS + 131072, O_PS = O_PP + 61440, O_CP = O_PS + 983040, O_CS = O_CP + 122880, O_MK = O_CS + 1966080, O_MV = O_MK + 2097152;
constexpr size_t MiB = 1u << 20;
constexpr size_t WS_CTL = 0, CTL_ZERO_BYTES = MiB;
constexpr size_t WS_WIN = 1 * MiB, WS_WKV = 4 * MiB, WS_WOUT = 8 * MiB, WS_WQ = 10 * MiB, WS_WO = 12 * MiB, WS_WGU = 14 * MiB, WS_WD = 25 * MiB, WS_WMAP = 31 * MiB;
constexpr size_t WS_HB = 32 * MiB, WS_AP = 65 * MiB, WS_GLU = 82 * MiB, WS_C = 99 * MiB, WS_X1 = 132 * MiB, WS_X1B = 197 * MiB, WS_Q = 230 * MiB, WS_KB = 263 * MiB, WS_VT = 267 * MiB;
constexpr size_t WS_O = 271 * MiB, WS_X2B = 304 * MiB, WS_F = 337 * MiB, WS_MB = 426 * MiB, WS_SSQ1 = 430 * MiB, WS_SSQ2 = 431 * MiB, WS_SSQ3 = 432 * MiB, WS_SSQS = 433 * MiB, WS_US = 434 * MiB, WS_HC = 435 * MiB;
constexpr size_t WS_HP = WS_HC + 512 * 1024, WS_END = 436 * MiB;
constexpr int LDS_BYTES = 147456;
constexpr int NPHASE = 10;

__device__ __forceinline__ float wave_sum(float v) {
#pragma unroll
    for (int o = 1; o < 64; o <<= 1) v += __shfl_xor(v, o);
    return v;
}
__device__ __forceinline__ float wave_max(float v) {
#pragma unroll
    for (int o = 1; o < 64; o <<= 1) v = fmaxf(v, __shfl_xor(v, o));
    return v;
}
__device__ __forceinline__ unsigned f2bf(float f) { unsigned u = __builtin_bit_cast(unsigned, f); return (u + 0x7fffu + ((u >> 16) & 1u)) >> 16; }
__device__ __forceinline__ unsigned pk2(float lo, float hi) { return f2bf(lo) | (f2bf(hi) << 16); }
__device__ __forceinline__ float bf2f(bf16 v) { return __builtin_bit_cast(float, (unsigned)v << 16); }
__device__ __forceinline__ float sigm(float x) { return __builtin_amdgcn_rcpf(1.0f + __builtin_amdgcn_exp2f(-1.4426950408889634f * x)); }
#define LDS_WAIT() asm volatile("s_waitcnt lgkmcnt(0)" ::: "memory")

__device__ __forceinline__ void transpose_item(const float* W, int K, int N, const float* gk, bf16* WT, int dst_row0, LAS float* scr, int k0, int n0, int lane) {
#pragma unroll 8
    for (int i = 0; i < 32; ++i) { const int kk = 2 * i + (lane >> 5); float v = W[(size_t)(k0 + kk) * N + n0 + (lane & 31)]; if (gk) v *= gk[k0 + kk]; scr[kk * 33 + (lane & 31)] = v; }
    LDS_WAIT();
    const int c = lane & 7;
#pragma unroll
    for (int j = 0; j < 4; ++j) { const int n = (lane >> 3) + 8 * j; const LAS float* s = scr + (8 * c) * 33 + n;
        u32x4 o; o.x = pk2(s[0 * 33], s[1 * 33]); o.y = pk2(s[2 * 33], s[3 * 33]); o.z = pk2(s[4 * 33], s[5 * 33]); o.w = pk2(s[6 * 33], s[7 * 33]);
        *(u32x4*)(WT + (size_t)(dst_row0 + n) * K + k0 + 8 * c) = o; }
    LDS_WAIT();
}
__device__ __forceinline__ void rms_row_to_bf16(const float* xrow, const float* g, bf16* orow, int lane) {
    const f32x4* xr = (const f32x4*)xrow + lane; const f32x4* gr = (const f32x4*)g + lane;
    f32x4 v[4]; float s = 0.f;
#pragma unroll
    for (int j = 0; j < 4; ++j) { v[j] = xr[64 * j]; s += (v[j].x * v[j].x + v[j].y * v[j].y) + (v[j].z * v[j].z + v[j].w * v[j].w); }
    const float rstd = 1.0f / sqrtf(wave_sum(s) * (1.0f / DM) + EPS);
    unsigned long long* o8 = (unsigned long long*)orow + lane;
#pragma unroll
    for (int j = 0; j < 4; ++j) { const f32x4 gg = gr[64 * j]; const f32x4 o = v[j] * rstd * gg;
        o8[64 * j] = (unsigned long long)pk2(o.x, o.y) | ((unsigned long long)pk2(o.z, o.w) << 32); }
}

struct Args { const float* in[28]; float* out; unsigned char* ws; int ph_lo, ph_hi; };

__device__ __forceinline__ void p0_prologue(const Args& a, LAS unsigned char* lds, int bid, int G, int tid, int lane, int wave) {
    unsigned char* ws = a.ws;
    LAS float* scr = (LAS float*)(lds + wave * 16384);
    const int gw = bid * 8 + wave, NGW = G * 8;
    constexpr int I_IN = 16 * 48, I_SQ = 16 * 32, I_GU = 16 * 88, I_D = 44 * 32, I_PM = 2 * 4;
    constexpr int NITEMS = I_IN + 5 * I_SQ + 2 * I_GU + I_D + 4 * I_PM;
    for (int it = gw; it < NITEMS; it += NGW) {
        int r = it;
        if (r < I_IN) { const int kb = r / 48, n0 = (r % 48) * 32; int dr;
            if (n0 < 512) dr = n0; else { int j = n0 - 512; int hi = 0; if (j >= 512) { j -= 512; hi = 128; } dr = 512 + (j >> 7) * 256 + hi + (j & 127); }
            transpose_item(a.in[8], 1024, 1536, nullptr, (bf16*)(ws + WS_WIN), dr, scr, 64 * kb, n0, lane); continue; } r -= I_IN;
        if (r < I_SQ) { transpose_item(a.in[20], 1024, 1024, nullptr, (bf16*)(ws + WS_WKV), (r % 32) * 32, scr, 64 * (r / 32), (r % 32) * 32, lane); continue; } r -= I_SQ;
        if (r < I_SQ) { transpose_item(a.in[21], 1024, 1024, nullptr, (bf16*)(ws + WS_WKV), 1024 + (r % 32) * 32, scr, 64 * (r / 32), (r % 32) * 32, lane); continue; } r -= I_SQ;
        if (r < I_SQ) { transpose_item(a.in[16], 1024, 1024, nullptr, (bf16*)(ws + WS_WOUT), (r % 32) * 32, scr, 64 * (r / 32), (r % 32) * 32, lane); continue; } r -= I_SQ;
        if (r < I_SQ) { transpose_item(a.in[19], 1024, 1024, a.in[17], (bf16*)(ws + WS_WQ), (r % 32) * 32, scr, 64 * (r / 32), (r % 32) * 32, lane); continue; } r -= I_SQ;
        if (r < I_SQ) { transpose_item(a.in[22], 1024, 1024, nullptr, (bf16*)(ws + WS_WO), (r % 32) * 32, scr, 64 * (r / 32), (r % 32) * 32, lane); continue; } r -= I_SQ;
        if (r < I_GU) { const int n0 = (r % 88) * 32; transpose_item(a.in[24], 1024, FF, a.in[23], (bf16*)(ws + WS_WGU), (n0 >> 7) * 256 + (n0 & 127), scr, 64 * (r / 88), n0, lane); continue; } r -= I_GU;
        if (r < I_GU) { const int n0 = (r % 88) * 32; transpose_item(a.in[25], 1024, FF, a.in[23], (bf16*)(ws + WS_WGU), (n0 >> 7) * 256 + 128 + (n0 & 127), scr, 64 * (r / 88), n0, lane); continue; } r -= I_GU;
        if (r < I_D) { transpose_item(a.in[26], FF, 1024, nullptr, (bf16*)(ws + WS_WD), (r % 32) * 32, scr, 64 * (r / 32), (r % 32) * 32, lane); continue; } r -= I_D;
        { const int g = r / I_PM, q = r % I_PM; transpose_item(a.in[9] + (size_t)g * 16384, 128, 128, nullptr, (bf16*)(ws + WS_WMAP) + (size_t)g * 16384, (q % 4) * 32, scr, 64 * (q / 4), (q % 4) * 32, lane); }
    }
    for (int m = gw; m < MALL + MMEM; m += NGW) {
        if (m < MP) rms_row_to_bf16(a.in[0] + (size_t)m * DM, a.in[7], (bf16*)(ws + WS_HB) + (size_t)m * DM, lane);
        else if (m < MALL) rms_row_to_bf16(a.in[1] + (size_t)(m - MP) * DM, a.in[7], (bf16*)(ws + WS_HB) + (size_t)m * DM, lane);
        else rms_row_to_bf16(a.in[2] + (size_t)(m - MALL) * DM, a.in[18], (bf16*)(ws + WS_MB) + (size_t)(m - MALL) * DM, lane);
    }
    const float* spool = a.in[3]; const float* sconv = a.in[4]; const float* wdw = a.in[12]; const float* bdw = a.in[13];
    float* HC = (float*)(ws + WS_HC); float* HP = (float*)(ws + WS_HP);
    for (int e = bid * 512 + tid; e < NS * 512; e += G * 512) {
        const int b = e >> 9, ch = e & 511;
        float acc = bdw[ch];
#pragma unroll 10
        for (int j = 0; j < 30; ++j) { const float v = sconv[(size_t)(b * 30 + j) * 512 + ch]; acc += wdw[j * 512 + ch] * v; if (j >= 1) a.out[O_CS + (size_t)(b * 30 + j - 1) * 512 + ch] = v; }
        HC[e] = acc;
        const int w = 2 << (ch >> 7); float s = 0.f;
#pragma unroll 5
        for (int j = 0; j < 15; ++j) { const float v = spool[(size_t)(b * 15 + j) * 512 + ch]; if (j >= 1) a.out[O_PS + (size_t)(b * 15 + j - 1) * 512 + ch] = v; if (j >= 16 - w) s += v; }
        HP[e] = s;
    }
}

template <bool PAIR, class Fn>
__device__ __forceinline__ void skinny(const bf16* A, const bf16* Bt, int K, int nColBlk, int c, int G, LAS float* red, int tid, const Fn& fn) {
    const int lane = tid & 63, wave = __builtin_amdgcn_readfirstlane(tid >> 6), fr = lane & 15, fq = lane >> 4;
    const int nItems = nColBlk * 4, kw = K >> 3;
    for (int it = c; it < nItems; it += G) {
        const int rb = it & 3, cb = it >> 2;
        const int n0 = PAIR ? ((cb >> 3) * 256 + (cb & 7) * 16) : cb * 16;
        const bf16* ap = A + (size_t)(32 * rb + fr) * K + wave * kw + 8 * fq;
        const bf16* bp = Bt + (size_t)(n0 + fr) * K + wave * kw + 8 * fq;
        f32x4 c00 = {0.f, 0.f, 0.f, 0.f}, c01 = c00, c10 = c00, c11 = c00;
        for (int ks = 0; ks < kw; ks += 32) {
            const bf16x8 b0 = *(const bf16x8*)(bp + ks), a0 = *(const bf16x8*)(ap + ks), a1 = *(const bf16x8*)(ap + (size_t)16 * K + ks);
            c00 = __builtin_amdgcn_mfma_f32_16x16x32_bf16(b0, a0, c00, 0, 0, 0); c01 = __builtin_amdgcn_mfma_f32_16x16x32_bf16(b0, a1, c01, 0, 0, 0);
            if (PAIR) { const bf16x8 b1 = *(const bf16x8*)(bp + (size_t)128 * K + ks);
                c10 = __builtin_amdgcn_mfma_f32_16x16x32_bf16(b1, a0, c10, 0, 0, 0); c11 = __builtin_amdgcn_mfma_f32_16x16x32_bf16(b1, a1, c11, 0, 0, 0); }
        }
        LAS float* rw = red + wave * 1024;
        *(LAS f32x4*)(rw + fr * 16 + 4 * fq) = c00; *(LAS f32x4*)(rw + (16 + fr) * 16 + 4 * fq) = c01;
        if (PAIR) { *(LAS f32x4*)(rw + 512 + fr * 16 + 4 * fq) = c10; *(LAS f32x4*)(rw + 512 + (16 + fr) * 16 + 4 * fq) = c11; }
        __syncthreads();
        float v0 = 0.f, v1 = 0.f;
#pragma unroll
        for (int w = 0; w < 8; ++w) { v0 += red[w * 1024 + tid]; if (PAIR) v1 += red[w * 1024 + 512 + tid]; }
        fn(32 * rb + (tid >> 4), cb * 16 + (tid & 15), cb, v0, v1);
        __syncthreads();
    }
}
__device__ __forceinline__ float red16(float s) { s += __shfl_xor(s, 1); s += __shfl_xor(s, 2); s += __shfl_xor(s, 4); s += __shfl_xor(s, 8); return s; }
__device__ __forceinline__ float rstd_s(const float* p, int row, int ci) {
    const float* q = p + row * 64 + ci; return 1.0f / sqrtf(red16((q[0] + q[16]) + (q[32] + q[48])) * (1.0f / DM) + EPS);
}
struct SkRaw { float* O; int ld; __device__ __forceinline__ void operator()(int row, int col, int, float v0, float) const { O[(size_t)row * ld + col] = v0; } };
struct SkRes { const float* resid; float* xout; bf16* xb; float* ssq;
    __device__ __forceinline__ void operator()(int row, int col, int cb, float v0, float) const {
        const size_t off = (size_t)row * DM + col; const float x = resid[off] + v0; xout[off] = x; if (xb) xb[off] = (bf16)f2bf(x);
        const float ss = red16(x * x); if ((col & 15) == 0) ssq[row * 64 + cb] = ss; } };
struct SkQ { const float* ssq; bf16* Q; __device__ __forceinline__ void operator()(int row, int col, int, float v0, float) const {
        const float rs = rstd_s(ssq, row, col & 15) * QSCALE; Q[(size_t)row * DM + col] = (bf16)f2bf(v0 * rs); } };
struct SkGU { const float* ssq; bf16* F; __device__ __forceinline__ void operator()(int row, int col, int, float v0, float v1) const {
        const float rs = rstd_s(ssq, row, col & 15); const float g = v0 * rs; F[(size_t)row * FF + col] = (bf16)f2bf(g * sigm(g) * (v1 * rs)); } };

constexpr int MX_YC = 0, MX_D = 65536, MX_DSTRIDE = 1040;
template <int W> __device__ __forceinline__ void pool_half(const bf16* AP, int b, int t0, int r0, int tid, LAS unsigned char* lds) {
    float in[16 + W - 1];
#pragma unroll
    for (int i = 0; i < 16 + W - 1; ++i) { const int t = t0 + r0 - (W - 1) + i; const int tt = t < 0 ? 0 : t; const float v = bf2f(AP[(size_t)(b * SEQ + tt) * 512 + tid]); in[i] = t >= 0 ? v : 0.f; }
#pragma unroll
    for (int r = 0; r < 16; ++r) { float s = 0.f;
#pragma unroll
        for (int j = 0; j < W; ++j) s += in[r + j];
        const int t = t0 + r0 + r; const int cnt = (t + 1 < W) ? (t + 1) : W;
        const float d = s / (float)cnt - in[r + W - 1];
        *(LAS bf16*)(lds + MX_D + (r0 + r) * MX_DSTRIDE + tid * 2) = (bf16)f2bf(d); }
}
__device__ __forceinline__ void mixer_finish(const Args& a, LAS unsigned char* lds, int crow0, int tid, int lane, int wave) {
    bf16* C = (bf16*)(a.ws + WS_C);
    const LAS float* yc = (const LAS float*)(lds + MX_YC);
    { const f32x4 g0 = *(const f32x4*)(a.in[14] + lane * 8), g1 = *(const f32x4*)(a.in[14] + lane * 8 + 4), b0 = *(const f32x4*)(a.in[15] + lane * 8), b1 = *(const f32x4*)(a.in[15] + lane * 8 + 4);
#pragma unroll
      for (int i = 0; i < 4; ++i) { const int r = 4 * wave + i;
        const f32x4 y0 = *(const LAS f32x4*)(yc + r * 512 + lane * 8), y1 = *(const LAS f32x4*)(yc + r * 512 + lane * 8 + 4);
        const float mu = wave_sum((y0.x + y0.y) + (y0.z + y0.w) + (y1.x + y1.y) + (y1.z + y1.w)) * (1.0f / 512.0f);
        const f32x4 d0 = y0 - mu, d1 = y1 - mu;
        const float var = wave_sum((d0.x * d0.x + d0.y * d0.y) + (d0.z * d0.z + d0.w * d0.w) + (d1.x * d1.x + d1.y * d1.y) + (d1.z * d1.z + d1.w * d1.w)) * (1.0f / 512.0f);
        const float rs = 1.0f / sqrtf(var + EPS);
        f32x4 n0 = d0 * rs * g0 + b0, n1 = d1 * rs * g1 + b1;
#pragma unroll
        for (int j = 0; j < 4; ++j) { n0[j] = n0[j] * sigm(n0[j]); n1[j] = n1[j] * sigm(n1[j]); }
        u32x4 o; o.x = pk2(n0.x, n0.y); o.y = pk2(n0.z, n0.w); o.z = pk2(n1.x, n1.y); o.w = pk2(n1.z, n1.w);
        *(u32x4*)(C + (size_t)(crow0 + r) * DM + 512 + lane * 8) = o; } }
    { const int g = wave >> 1, nh = wave & 1, fr = lane & 15, fq = lane >> 4;
      const bf16* WT = (const bf16*)(a.ws + WS_WMAP) + (size_t)g * 16384;
      f32x4 acc[2][4];
#pragma unroll
      for (int mb = 0; mb < 2; ++mb)
#pragma unroll
          for (int nb = 0; nb < 4; ++nb) acc[mb][nb] = (f32x4){0.f, 0.f, 0.f, 0.f};
#pragma unroll
      for (int kc = 0; kc < 4; ++kc) {
          bf16x8 af[2];
#pragma unroll
          for (int mb = 0; mb < 2; ++mb) af[mb] = *(const LAS bf16x8*)(lds + MX_D + (16 * mb + fr) * MX_DSTRIDE + (g * 128 + 32 * kc + 8 * fq) * 2);
#pragma unroll
          for (int nb = 0; nb < 4; ++nb) { const bf16x8 bf = *(const bf16x8*)(WT + (size_t)(64 * nh + 16 * nb + fr) * 128 + 32 * kc + 8 * fq);
#pragma unroll
              for (int mb = 0; mb < 2; ++mb) acc[mb][nb] = __builtin_amdgcn_mfma_f32_16x16x32_bf16(bf, af[mb], acc[mb][nb], 0, 0, 0); }
      }
#pragma unroll
      for (int nb = 0; nb < 4; ++nb) { const int ch = g * 128 + 64 * nh + 16 * nb + 4 * fq;
          const f32x4 bm = *(const f32x4*)(a.in[10] + ch), sc = *(const f32x4*)(a.in[11] + ch);
#pragma unroll
          for (int mb = 0; mb < 2; ++mb) { const f32x4 y = (acc[mb][nb] + bm) * sc; u32x2 o; o.x = pk2(y.x, y.y); o.y = pk2(y.z, y.w);
              *(u32x2*)(C + (size_t)(crow0 + 16 * mb + fr) * DM + ch) = o; } } }
}
__device__ __forceinline__ void mixer_prompt_unit(const Args& a, LAS unsigned char* lds, int u, int tid, int lane, int wave) {
    const int b = u >> 6, t0 = (u & 63) * 32;
    const bf16* GLU = (const bf16*)(a.ws + WS_GLU); const bf16* AP = (const bf16*)(a.ws + WS_AP);
    LAS float* yc = (LAS float*)(lds + MX_YC);
    { float w[31];
#pragma unroll
      for (int j = 0; j < 31; ++j) w[j] = a.in[12][j * 512 + tid];
      const float bias = a.in[13][tid];
#pragma unroll 1
      for (int h = 0; h < 2; ++h) { const int r0 = 16 * h; float in[46];
#pragma unroll
          for (int i = 0; i < 46; ++i) { const int t = t0 + r0 - 30 + i; const int tt = t < 0 ? 0 : t; const float v = bf2f(GLU[(size_t)(b * SEQ + tt) * 512 + tid]); in[i] = t >= 0 ? v : 0.f; }
#pragma unroll
          for (int r = 0; r < 16; ++r) { float acc = bias;
#pragma unroll
              for (int j = 0; j < 31; ++j) acc += w[j] * in[r + j];
              yc[(r0 + r) * 512 + tid] = acc; } } }
    { const int g = tid >> 7;
#pragma unroll 1
      for (int h = 0; h < 2; ++h) {
          if (g == 0) pool_half<2>(AP, b, t0, 16 * h, tid, lds); else if (g == 1) pool_half<4>(AP, b, t0, 16 * h, tid, lds);
          else if (g == 2) pool_half<8>(AP, b, t0, 16 * h, tid, lds); else pool_half<16>(AP, b, t0, 16 * h, tid, lds); } }
    __syncthreads();
    mixer_finish(a, lds, b * SEQ + t0, tid, lane, wave);
    __syncthreads();
}
__device__ __forceinline__ void mixer_sample_unit(const Args& a, LAS unsigned char* lds, int su, int tid, int lane, int wave) {
    const float* US = (const float*)(a.ws + WS_US); const float* HC = (const float*)(a.ws + WS_HC); const float* HP = (const float*)(a.ws + WS_HP);
    LAS float* yc = (LAS float*)(lds + MX_YC);
    const float w30 = a.in[12][30 * 512 + tid]; const int wdt = 2 << (tid >> 7); const float invw = 1.0f / (float)wdt;
    const int gcol = 512 + (tid >> 7) * 256 + (tid & 127);
#pragma unroll 4
    for (int s = 0; s < 32; ++s) { const int bs = 32 * su + s;
        const float val = US[(size_t)bs * 1536 + gcol], gate = US[(size_t)bs * 1536 + gcol + 128], av = US[(size_t)bs * 1536 + tid];
        const float glu = val * sigm(gate);
        a.out[O_CS + (size_t)(bs * 30 + 29) * 512 + tid] = glu; a.out[O_PS + (size_t)(bs * 15 + 14) * 512 + tid] = av;
        yc[s * 512 + tid] = HC[bs * 512 + tid] + w30 * glu;
        const float d = (av + HP[bs * 512 + tid]) * invw - av;
        *(LAS bf16*)(lds + MX_D + s * MX_DSTRIDE + tid * 2) = (bf16)f2bf(d); }
    __syncthreads();
    mixer_finish(a, lds, MP + 32 * su, tid, lane, wave);
    __syncthreads();
}

constexpr int AT_K = 0, AT_KSTR = 528, AT_V = 64 * AT_KSTR, AT_VSTR = 144;
__device__ __forceinline__ float fexp2(float x) { return __builtin_amdgcn_exp2f(x); }
__device__ __forceinline__ void attn_prompt_unit(const Args& a, LAS unsigned char* lds, int u, int tid, int lane, int wave) {
    const int qb = u & 15, h = (u >> 4) & 3, b = u >> 6, fr = lane & 15, fq = lane >> 4;
    const bf16* Q = (const bf16*)(a.ws + WS_Q); const bf16* KB = (const bf16*)(a.ws + WS_KB); const bf16* VT = (const bf16*)(a.ws + WS_VT); bf16* O = (bf16*)(a.ws + WS_O);
    const size_t rowq = (size_t)b * SEQ + qb * 128 + wave * 16 + fr;
    bf16x8 qf[8];
#pragma unroll
    for (int kd = 0; kd < 8; ++kd) qf[kd] = *(const bf16x8*)(Q + rowq * DM + h * 256 + 32 * kd + 8 * fq);
    f32x4 o[16];
#pragma unroll
    for (int i = 0; i < 16; ++i) o[i] = (f32x4){0.f, 0.f, 0.f, 0.f};
    float mrun = -INFINITY, lrun = 0.f;
    u32x4 kr[4], vr[4];
#define AT_LOAD(c) do { _Pragma("unroll") for (int i = 0; i < 4; ++i) { const int p = tid + 512 * i; \
        kr[i] = *(const u32x4*)(KB + (size_t)(b * 256 + 64 * (c) + (p >> 5)) * DM + h * 256 + (p & 31) * 8); \
        vr[i] = *(const u32x4*)(VT + (size_t)(h * 256 + (p >> 3)) * 2048 + b * 256 + 64 * (c) + (p & 7) * 8); } } while (0)
    AT_LOAD(0);
#pragma unroll 1
    for (int c = 0; c < 4; ++c) {
        __syncthreads();
#pragma unroll
        for (int i = 0; i < 4; ++i) { const int p = tid + 512 * i;
            *(LAS u32x4*)(lds + AT_K + (p >> 5) * AT_KSTR + (p & 31) * 16) = kr[i];
            *(LAS u32x4*)(lds + AT_V + (p >> 3) * AT_VSTR + (p & 7) * 16) = vr[i]; }
        __syncthreads();
        if (c < 3) AT_LOAD(c + 1);
        f32x4 s[4];
#pragma unroll
        for (int nb = 0; nb < 4; ++nb) { s[nb] = (f32x4){0.f, 0.f, 0.f, 0.f};
#pragma unroll
            for (int kd = 0; kd < 8; ++kd) { const bf16x8 kf = *(const LAS bf16x8*)(lds + AT_K + (16 * nb + fr) * AT_KSTR + kd * 64 + fq * 16);
                s[nb] = __builtin_amdgcn_mfma_f32_16x16x32_bf16(kf, qf[kd], s[nb], 0, 0, 0); } }
        float mx = s[0][0];
#pragma unroll
        for (int nb = 0; nb < 4; ++nb)
#pragma unroll
            for (int j = 0; j < 4; ++j) mx = fmaxf(mx, s[nb][j]);
        mx = fmaxf(mx, __shfl_xor(mx, 16)); mx = fmaxf(mx, __shfl_xor(mx, 32));
        const float mnew = fmaxf(mrun, mx), alpha = fexp2(mrun - mnew);
        float ps = 0.f;
#pragma unroll
        for (int nb = 0; nb < 4; ++nb)
#pragma unroll
            for (int j = 0; j < 4; ++j) { s[nb][j] = fexp2(s[nb][j] - mnew); ps += s[nb][j]; }
        ps += __shfl_xor(ps, 16); ps += __shfl_xor(ps, 32);
        lrun = lrun * alpha + ps; mrun = mnew;
#pragma unroll
        for (int i = 0; i < 16; ++i) o[i] = o[i] * alpha;
#pragma unroll
        for (int kb = 0; kb < 2; ++kb) {
            u32x4 pw; pw.x = pg8::cvt_pk_bf16(s[2 * kb][0], s[2 * kb][1]); pw.y = pg8::cvt_pk_bf16(s[2 * kb][2], s[2 * kb][3]);
            pw.z = pg8::cvt_pk_bf16(s[2 * kb + 1][0], s[2 * kb + 1][1]); pw.w = pg8::cvt_pk_bf16(s[2 * kb + 1][2], s[2 * kb + 1][3]);
            const bf16x8 pf = __builtin_bit_cast(bf16x8, pw);
#pragma unroll
            for (int db = 0; db < 16; ++db) {
                const u32x2 v0 = *(const LAS u32x2*)(lds + AT_V + (16 * db + fr) * AT_VSTR + kb * 64 + fq * 8), v1 = *(const LAS u32x2*)(lds + AT_V + (16 * db + fr) * AT_VSTR + kb * 64 + 32 + fq * 8);
                u32x4 vw; vw.x = v0.x; vw.y = v0.y; vw.z = v1.x; vw.w = v1.y;
                o[db] = __builtin_amdgcn_mfma_f32_16x16x32_bf16(__builtin_bit_cast(bf16x8, vw), pf, o[db], 0, 0, 0); }
        }
    }
#undef AT_LOAD
    const float inv = 1.0f / lrun;
#pragma unroll
    for (int db = 0; db < 16; ++db) { const f32x4 y = o[db] * inv; u32x2 w; w.x = pg8::cvt_pk_bf16(y.x, y.y); w.y = pg8::cvt_pk_bf16(y.z, y.w);
        *(u32x2*)(O + rowq * DM + h * 256 + 16 * db + 4 * fq) = w; }
}
__device__ __forceinline__ void attn_sample_unit(const Args& a, LAS unsigned char* lds, int u, int tid, int lane, int wave) {
    const int b = u >> 2, h = u & 3;
    const bf16* Q = (const bf16*)(a.ws + WS_Q) + (size_t)(MP + b) * DM + h * 256; bf16* O = (bf16*)(a.ws + WS_O) + (size_t)(MP + b) * DM + h * 256;
    const float* ck = a.in[5] + ((size_t)b * 256 * 4 + h) * 256 + lane * 4; const float* cv = a.in[6] + ((size_t)b * 256 * 4 + h) * 256 + lane * 4;
    LAS float* sc = (LAS float*)lds; LAS float* pn = sc + 256; LAS float* red = sc + 512;
    const u32x2 qw = *(const u32x2*)(Q + lane * 4);
    const f32x4 q = {__builtin_bit_cast(float, qw.x << 16), __builtin_bit_cast(float, qw.x & 0xffff0000u), __builtin_bit_cast(float, qw.y << 16), __builtin_bit_cast(float, qw.y & 0xffff0000u)};
    float mine = 0.f;
#pragma unroll 16
    for (int i = 0; i < 32; ++i) { const f32x4 kv = *(const f32x4*)(ck + (size_t)(32 * wave + i) * 1024);
        const float sdot = wave_sum((kv.x * q.x + kv.y * q.y) + (kv.z * q.z + kv.w * q.w)); mine = (lane == i) ? sdot : mine; }
    __syncthreads();
    if (lane < 32) sc[32 * wave + lane] = mine;
    __syncthreads();
    { const f32x4 sv = *(const LAS f32x4*)(sc + lane * 4); const float mx = wave_max(fmaxf(fmaxf(sv.x, sv.y), fmaxf(sv.z, sv.w)));
      f32x4 e; e.x = fexp2(sv.x - mx); e.y = fexp2(sv.y - mx); e.z = fexp2(sv.z - mx); e.w = fexp2(sv.w - mx);
      const float inv = 1.0f / wave_sum((e.x + e.y) + (e.z + e.w));
      if (wave == 0) *(LAS f32x4*)(pn + lane * 4) = e * inv; }
    __syncthreads();
    f32x4 acc = {0.f, 0.f, 0.f, 0.f};
#pragma unroll 16
    for (int i = 0; i < 32; ++i) { const f32x4 vv = *(const f32x4*)(cv + (size_t)(32 * wave + i) * 1024); const float p = pn[32 * wave + i]; acc += vv * p; }
    *(LAS f32x4*)(red + wave * 256 + lane * 4) = acc;
    __syncthreads();
    if (tid < 256) { float s = 0.f;
#pragma unroll
        for (int w = 0; w < 8; ++w) s += red[w * 256 + tid];
        O[tid] = (bf16)f2bf(s); }
    __syncthreads();
}

__global__ void __launch_bounds__(512, 2) fwd_kernel(Args a) {
    extern __shared__ __attribute__((aligned(16))) unsigned char lds_raw[];
    LAS unsigned char* lds = (LAS unsigned char*)lds_raw;
    const int tid = threadIdx.x, lane = tid & 63, wave = __builtin_amdgcn_readfirstlane(tid >> 6);
    const int G = gridDim.x, bid = blockIdx.x;
    unsigned char* ws = a.ws;
    const int lo = a.ph_lo, hi = a.ph_hi;
    cg::grid_group grid = cg::this_grid();
#define IN(k) (lo <= (k) && (k) < hi)
#define SEAM(k) do { if (lo <= (k) && (k) + 1 < hi) grid.sync(); } while (0)
    bf16* HB = (bf16*)(ws + WS_HB); bf16* C = (bf16*)(ws + WS_C); float* X1 = (float*)(ws + WS_X1); bf16* X1B = (bf16*)(ws + WS_X1B); bf16* Qb = (bf16*)(ws + WS_Q);
    bf16* Ob = (bf16*)(ws + WS_O); bf16* X2B = (bf16*)(ws + WS_X2B); bf16* Fb = (bf16*)(ws + WS_F);
    float* SSQ1 = (float*)(ws + WS_SSQ1); float* SSQ2 = (float*)(ws + WS_SSQ2); float* SSQ3 = (float*)(ws + WS_SSQ3);
    float* SSQ1S = (float*)(ws + WS_SSQS); float* SSQ2S = SSQ1S + NS * 64; float* SSQ3S = SSQ2S + NS * 64;
    LAS float* red = (LAS float*)lds;

    if (IN(0)) { p0_prologue(a, lds, bid, G, tid, lane, wave); }
    SEAM(0);
    if (IN(1)) {
        { pg8::Gemm g{HB, (const bf16*)(ws + WS_WIN), MP, 1536, 1024}; pg8::StaticOrder S; S.init(MP, 1536, G, bid);
          pg8::EpiIn E{(bf16*)(ws + WS_AP), (bf16*)(ws + WS_GLU), a.out + O_PP, a.out + O_CP};
          pg8::gemm_phase<pg8::EpiIn, pg8::StaticOrder, true, true>(lds, g, S, E); }
        { pg8::Gemm g{(const bf16*)(ws + WS_MB), (const bf16*)(ws + WS_WKV), MMEM, 2048, 1024}; pg8::StaticOrder S; S.init(MMEM, 2048, G, (bid + G - (128 % G)) % G);
          pg8::EpiKV E{a.out + O_MK, a.out + O_MV, (bf16*)(ws + WS_KB)};
          pg8::gemm_phase<pg8::EpiKV, pg8::StaticOrder, true, true>(lds, g, S, E); }
        { pg8::Gemm g{(const bf16*)(ws + WS_WKV) + (size_t)1024 * 1024, (const bf16*)(ws + WS_MB), 1024, MMEM, 1024}; pg8::StaticOrder S; S.init(1024, MMEM, G, (bid + G - (192 % G)) % G);
          pg8::EpiPlain E{(bf16*)(ws + WS_VT), 2048};
          pg8::gemm_phase<pg8::EpiPlain, pg8::StaticOrder, true, true>(lds, g, S, E); }
        __syncthreads();
        { SkRaw f{(float*)(ws + WS_US), 1536}; const int ge = G > 32 ? 32 : G, cc = (bid + G - (224 % G)) % G; if (cc < ge) skinny<false>(HB + (size_t)MP * DM, (const bf16*)(ws + WS_WIN), 1024, 96, cc, ge, red, tid, f); }
    }
    SEAM(1);
    if (IN(2)) {
        for (int u = bid; u < 512 + 4; u += G) { if (u < 512) mixer_prompt_unit(a, lds, u, tid, lane, wave); else mixer_sample_unit(a, lds, u - 512, tid, lane, wave); }
    }
    SEAM(2);
    if (IN(3)) {
        { pg8::Gemm g{C, (const bf16*)(ws + WS_WOUT), MP, 1024, 1024}; pg8::StaticOrder S; S.init(MP, 1024, G, bid);
          pg8::EpiRes E{a.in[0], X1, X1B, SSQ1};
          pg8::gemm_phase<pg8::EpiRes, pg8::StaticOrder, false, true>(lds, g, S, E); }
        __syncthreads();
        { SkRes f{a.in[1], X1 + (size_t)MP * DM, X1B + (size_t)MP * DM, SSQ1S}; skinny<false>(C + (size_t)MP * DM, (const bf16*)(ws + WS_WOUT), 1024, 64, bid, G, red, tid, f); }
    }
    SEAM(3);
    if (IN(4)) {
        { pg8::Gemm g{X1B, (const bf16*)(ws + WS_WQ), MP, 1024, 1024}; pg8::StaticOrder S; S.init(MP, 1024, G, bid);
          pg8::EpiQ E{SSQ1, Qb, QSCALE};
          pg8::gemm_phase<pg8::EpiQ, pg8::StaticOrder, false, true>(lds, g, S, E); }
        __syncthreads();
        { SkQ f{SSQ1S, Qb + (size_t)MP * DM}; skinny<false>(X1B + (size_t)MP * DM, (const bf16*)(ws + WS_WQ), 1024, 64, bid, G, red, tid, f); }
    }
    SEAM(4);
    if (IN(5)) {
        for (int u = bid; u < 512; u += G) attn_prompt_unit(a, lds, u, tid, lane, wave);
        __syncthreads();
        for (int u = bid; u < 512; u += G) attn_sample_unit(a, lds, u, tid, lane, wave);
    }
    SEAM(5);
    if (IN(6)) {
        { pg8::Gemm g{Ob, (const bf16*)(ws + WS_WO), MP, 1024, 1024}; pg8::StaticOrder S; S.init(MP, 1024, G, bid);
          pg8::EpiRes E{X1, X1, X2B, SSQ2};
          pg8::gemm_phase<pg8::EpiRes, pg8::StaticOrder, false, true>(lds, g, S, E); }
        __syncthreads();
        { SkRes f{X1 + (size_t)MP * DM, X1 + (size_t)MP * DM, X2B + (size_t)MP * DM, SSQ2S}; skinny<false>(Ob + (size_t)MP * DM, (const bf16*)(ws + WS_WO), 1024, 64, bid, G, red, tid, f); }
    }
    SEAM(6);
    if (IN(7)) {
        { pg8::Gemm g{X2B, (const bf16*)(ws + WS_WGU), MP, FF2, 1024}; pg8::StaticOrder S; S.init(MP, FF2, G, bid);
          pg8::EpiGU E{SSQ2, Fb};
          pg8::gemm_phase<pg8::EpiGU, pg8::StaticOrder, true, true>(lds, g, S, E); }
        __syncthreads();
        { SkGU f{SSQ2S, Fb + (size_t)MP * FF}; const int half = G >= 2 ? G / 2 : 1;
          if (bid >= G - half) skinny<true>(X2B + (size_t)MP * DM, (const bf16*)(ws + WS_WGU), 1024, 176, bid - (G - half), half, red, tid, f); }
    }
    SEAM(7);
    if (IN(8)) {
        { pg8::Gemm g{Fb, (const bf16*)(ws + WS_WD), MP, 1024, FF}; pg8::StaticOrder S; S.init(MP, 1024, G, bid);
          pg8::EpiRes E{X1, a.out + O_Y, nullptr, SSQ3};
          pg8::gemm_phase<pg8::EpiRes, pg8::StaticOrder, false, true>(lds, g, S, E); }
        __syncthreads();
        { SkRes f{X1 + (size_t)MP * DM, a.out + O_YS, nullptr, SSQ3S}; skinny<false>(Fb + (size_t)MP * FF, (const bf16*)(ws + WS_WD), FF, 64, bid, G, red, tid, f); }
    }
    SEAM(8);
    if (IN(9)) {
        const int gw = bid * 8 + wave, NGW = G * 8;
        const f32x4* gf = (const f32x4*)a.in[27] + lane;
        for (int m = gw; m < MALL; m += NGW) {
            float* xrow; float ssum;
            if (m < MP) { xrow = a.out + O_Y + (size_t)m * DM; const float v = (lane < 16) ? SSQ3[(size_t)m * 16 + lane] : 0.f; ssum = wave_sum(v); }
            else { xrow = a.out + O_YS + (size_t)(m - MP) * DM; ssum = wave_sum(SSQ3S[(m - MP) * 64 + lane]); }
            const float rstd = 1.0f / sqrtf(ssum * (1.0f / DM) + EPS);
            f32x4* xr = (f32x4*)xrow + lane;
#pragma unroll
            for (int j = 0; j < 4; ++j) { const f32x4 v = xr[64 * j]; xr[64 * j] = v * rstd * gf[64 * j]; }
        }
    }
#undef IN
#undef SEAM
}

#ifndef MK_MULTI
#define MK_MULTI 1
#endif
extern "C" void kernel_launch(void* const* d_in, const int* in_sizes, int n_in, void* d_out, int out_size, void* d_ws, size_t ws_size, hipStream_t stream) {
    static int grid = 0;
    if (grid == 0) {
        if (n_in != 28 || ws_size < WS_END) { fprintf(stderr, "kernel_launch: unexpected n_in %d / ws_size %zu\n", n_in, ws_size); grid = -1; return; }
        int dev = 0, cus = 0, per_cu = 0;
        (void)hipGetDevice(&dev); (void)hipDeviceGetAttribute(&cus, hipDeviceAttributeMultiprocessorCount, dev);
        if (hipFuncSetAttribute((const void*)fwd_kernel, hipFuncAttributeMaxDynamicSharedMemorySize, LDS_BYTES) != hipSuccess) { fprintf(stderr, "kernel_launch: hipFuncSetAttribute failed\n"); grid = -1; return; }
        if (hipOccupancyMaxActiveBlocksPerMultiprocessor(&per_cu, (const void*)fwd_kernel, 512, LDS_BYTES) != hipSuccess || per_cu < 1) { fprintf(stderr, "kernel_launch: occupancy query says %d\n", per_cu); per_cu = 1; }
        (void)hipGetLastError();
        grid = cus;
    }
    if (grid < 0) return;
    (void)hipMemsetAsync((char*)d_ws + WS_CTL, 0, CTL_ZERO_BYTES, stream);
    Args a{};
    for (int i = 0; i < 28; ++i) a.in[i] = (const float*)d_in[i];
    a.out = (float*)d_out; a.ws = (unsigned char*)d_ws;
#if MK_MULTI
    for (int p = 0; p < NPHASE; ++p) { a.ph_lo = p; a.ph_hi = p + 1; hipLaunchKernelGGL(fwd_kernel, dim3(grid), dim3(512), LDS_BYTES, stream, a); }
#else
    a.ph_lo = 0; a.ph_hi = NPHASE;
    void* args[] = {&a};
    hipError_t e = hipLaunchCooperativeKernel((const void*)fwd_kernel, dim3(grid), dim3(512), args, LDS_BYTES, stream);
    if (e != hipSuccess) fprintf(stderr, "cooperative launch failed: %s (grid %d)\n", hipGetErrorString(e), grid);
#endif
}
```

```cpp
#include <hip/hip_runtime.h>
#include <hip/hip_cooperative_groups.h>
#include <cstdio>
#include <cstdint>
namespace cg = cooperative_groups;
namespace pg8 {
#define PG8_LAS __attribute__((address_space(3)))
typedef unsigned short bf16_t;
typedef short bf16x8 __attribute__((ext_vector_type(8)));
typedef float f32x4 __attribute__((ext_vector_type(4)));
typedef unsigned u32x4 __attribute__((ext_vector_type(4)));
constexpr int BM = 256, BK = 64, HALF = 128, HTB = HALF * BK * 2  , STAGE_BYTES = 8 * HTB, NXCD = 8, WGM = 8;

__host__ __device__ __forceinline__ int lds_byte(int r, int c) { const int st = (r >> 4) * 2 + (c >> 5), rr = r & 15, cc = c & 31, ob = rr * 64 + cc * 2; return st * 1024 + (ob ^ (((ob >> 9) & 1) << 5)); }
__host__ __device__ __forceinline__ void stage_rc(int b, int& R, int& C) { const int st = b / 1024, sb = b % 1024, swz = sb ^ (((sb >> 9) & 1) << 5); R = (st >> 1) * 16 + swz / 64; C = (st & 1) * 32 + (swz % 64) / 2; }
__host__ __device__ __forceinline__ int perm32(int rho) { const int n = rho >> 4, i = rho & 15; return 8 * (i >> 2) + 4 * n + (i & 3); }

struct Unit { int pm, pn; };
struct Gemm { const bf16_t* A; const bf16_t* Bt; int M, N, K; };

struct StaticOrder {
    int nM, nN, nwg, G, c;
    __host__ __device__ void init(int M, int N, int G_, int c_) { nM = M / BM; nN = N / BM; nwg = nM * nN; G = G_; c = c_; }
    __host__ __device__ bool next(int i, Unit& u) const {
        const long L = (long)i * G + c; if (L >= nwg) return false;
        int wgid = (int)L; { const int q = nwg / NXCD, r = nwg % NXCD, xcd = wgid % NXCD, off = wgid / NXCD; wgid = (xcd < r ? xcd * (q + 1) : r * (q + 1) + (xcd - r) * q) + off; }
        const int nig = WGM * nN, gid = wgid / nig, fm = gid * WGM, gsz = (nM - fm) < WGM ? (nM - fm) : WGM;
        u.pm = fm + ((wgid % nig) % gsz); u.pn = (wgid % nig) / gsz; return true;
    }
    __device__ __forceinline__ void a_ready(const Unit&) const {}
    __device__ __forceinline__ void done(const Unit&) const {}
};
typedef unsigned u32x4 __attribute__((ext_vector_type(4)));
constexpr float EPSF = 1e-6f;
__device__ __forceinline__ unsigned cvt_pk_bf16(float lo, float hi) { unsigned r; asm volatile("v_cvt_pk_bf16_f32 %0, %1, %2" : "=v"(r) : "v"(lo), "v"(hi)); return r; }
__device__ __forceinline__ u32x4 pack8(const f32x4 a, const f32x4 b) { u32x4 w; w.x = cvt_pk_bf16(a[0], a[1]); w.y = cvt_pk_bf16(a[2], a[3]); w.z = cvt_pk_bf16(b[0], b[1]); w.w = cvt_pk_bf16(b[2], b[3]); return w; }
__device__ __forceinline__ float sigm(float x) { return __builtin_amdgcn_rcpf(1.0f + __builtin_amdgcn_exp2f(-1.4426950408889634f * x)); }
__device__ __forceinline__ float rstd16(const float* p) {
    const f32x4 a = ((const f32x4*)p)[0], b = ((const f32x4*)p)[1], c = ((const f32x4*)p)[2], d = ((const f32x4*)p)[3];
    const float s = ((a[0] + a[1]) + (a[2] + a[3])) + ((b[0] + b[1]) + (b[2] + b[3])) + ((c[0] + c[1]) + (c[2] + c[3])) + ((d[0] + d[1]) + (d[2] + d[3]));
    return 1.0f / sqrtf(s * (1.0f / 1024.0f) + EPSF);
}
struct EpiIn {
    static constexpr bool PERM = true, AFTER_DRAIN = false;
    bf16_t* AP; bf16_t* GLU; float* outPP; float* outCP;
    __device__ __forceinline__ void operator()(const f32x4 (&acc)[2][2][4][2], const Unit& u, int wr, int wc, int fr, int fq) const {
        const int row0 = u.pm * BM + wr * 64 + fr, cl = wc * 32 + 8 * fq;
        if (u.pn < 2) {
#pragma unroll
            for (int ai = 0; ai < 2; ++ai)
#pragma unroll
                for (int m = 0; m < 4; ++m) { const int row = row0 + ai * HALF + m * 16, t = row & 2047, b = row >> 11;
#pragma unroll
                    for (int bj = 0; bj < 2; ++bj) { const int col = u.pn * 256 + bj * HALF + cl; const f32x4 v0 = acc[ai][bj][m][0], v1 = acc[ai][bj][m][1];
                        *(u32x4*)(AP + (size_t)row * 512 + col) = pack8(v0, v1);
                        if (t >= 2033) { float* o = outPP + ((size_t)(b * 15 + t - 2033) * 512 + col); *(f32x4*)o = v0; *(f32x4*)(o + 4) = v1; } } }
        } else {
            const int ch = (u.pn - 2) * 128 + cl;
#pragma unroll
            for (int ai = 0; ai < 2; ++ai)
#pragma unroll
                for (int m = 0; m < 4; ++m) { const int row = row0 + ai * HALF + m * 16, t = row & 2047, b = row >> 11;
                    f32x4 o0, o1;
#pragma unroll
                    for (int j = 0; j < 4; ++j) { o0[j] = acc[ai][0][m][0][j] * sigm(acc[ai][1][m][0][j]); o1[j] = acc[ai][0][m][1][j] * sigm(acc[ai][1][m][1][j]); }
                    *(u32x4*)(GLU + (size_t)row * 512 + ch) = pack8(o0, o1);
                    if (t >= 2018) { float* o = outCP + ((size_t)(b * 30 + t - 2018) * 512 + ch); *(f32x4*)o = o0; *(f32x4*)(o + 4) = o1; } }
        }
    }
};
struct EpiKV {
    static constexpr bool PERM = true, AFTER_DRAIN = false;
    float* outK; float* outV; bf16_t* KB;
    __device__ __forceinline__ void operator()(const f32x4 (&acc)[2][2][4][2], const Unit& u, int wr, int wc, int fr, int fq) const {
        const int row0 = u.pm * BM + wr * 64 + fr, cl = wc * 32 + 8 * fq;
#pragma unroll
        for (int ai = 0; ai < 2; ++ai)
#pragma unroll
            for (int m = 0; m < 4; ++m) { const int row = row0 + ai * HALF + m * 16;
#pragma unroll
                for (int bj = 0; bj < 2; ++bj) { const int col = u.pn * 256 + bj * HALF + cl; const f32x4 v0 = acc[ai][bj][m][0], v1 = acc[ai][bj][m][1];
                    if (u.pn < 4) { float* o = outK + (size_t)row * 1024 + col; *(f32x4*)o = v0; *(f32x4*)(o + 4) = v1; *(u32x4*)(KB + (size_t)row * 1024 + col) = pack8(v0, v1); }
                    else { float* o = outV + (size_t)row * 1024 + (col - 1024); *(f32x4*)o = v0; *(f32x4*)(o + 4) = v1; } } }
    }
};
struct EpiPlain {
    static constexpr bool PERM = true, AFTER_DRAIN = false;
    bf16_t* O; int ldc;
    __device__ __forceinline__ void operator()(const f32x4 (&acc)[2][2][4][2], const Unit& u, int wr, int wc, int fr, int fq) const {
        const int row0 = u.pm * BM + wr * 64 + fr, cl = wc * 32 + 8 * fq;
#pragma unroll
        for (int ai = 0; ai < 2; ++ai)
#pragma unroll
            for (int m = 0; m < 4; ++m) { const int row = row0 + ai * HALF + m * 16;
#pragma unroll
                for (int bj = 0; bj < 2; ++bj) { const int col = u.pn * 256 + bj * HALF + cl; *(u32x4*)(O + (size_t)row * ldc + col) = pack8(acc[ai][bj][m][0], acc[ai][bj][m][1]); } }
    }
};
struct EpiRes {
    static constexpr bool PERM = true, AFTER_DRAIN = false;
    const float* resid; float* xout; bf16_t* xb; float* ssq;
    __device__ __forceinline__ void operator()(const f32x4 (&acc)[2][2][4][2], const Unit& u, int wr, int wc, int fr, int fq) const {
        const int row0 = u.pm * BM + wr * 64 + fr, cl = wc * 32 + 8 * fq;
#pragma unroll
        for (int ai = 0; ai < 2; ++ai)
#pragma unroll
            for (int m = 0; m < 4; ++m) { const int row = row0 + ai * HALF + m * 16; float ss = 0.f;
#pragma unroll
                for (int bj = 0; bj < 2; ++bj) { const size_t off = (size_t)row * 1024 + u.pn * 256 + bj * HALF + cl;
                    const f32x4 r0 = *(const f32x4*)(resid + off), r1 = *(const f32x4*)(resid + off + 4);
                    const f32x4 x0 = r0 + acc[ai][bj][m][0], x1 = r1 + acc[ai][bj][m][1];
                    *(f32x4*)(xout + off) = x0; *(f32x4*)(xout + off + 4) = x1;
                    if (xb) *(u32x4*)(xb + off) = pack8(x0, x1);
                    ss += ((x0[0] * x0[0] + x0[1] * x0[1]) + (x0[2] * x0[2] + x0[3] * x0[3])) + ((x1[0] * x1[0] + x1[1] * x1[1]) + (x1[2] * x1[2] + x1[3] * x1[3])); }
                ss += __shfl_xor(ss, 16); ss += __shfl_xor(ss, 32);
                if (fq == 0) ssq[(size_t)row * 16 + u.pn * 4 + wc] = ss; }
    }
};
struct EpiQ {
    static constexpr bool PERM = true, AFTER_DRAIN = false;
    const float* ssq; bf16_t* Q; float scale;
    __device__ __forceinline__ void operator()(const f32x4 (&acc)[2][2][4][2], const Unit& u, int wr, int wc, int fr, int fq) const {
        const int row0 = u.pm * BM + wr * 64 + fr, cl = wc * 32 + 8 * fq;
#pragma unroll
        for (int ai = 0; ai < 2; ++ai)
#pragma unroll
            for (int m = 0; m < 4; ++m) { const int row = row0 + ai * HALF + m * 16; const float rs = rstd16(ssq + (size_t)row * 16) * scale;
#pragma unroll
                for (int bj = 0; bj < 2; ++bj) { const size_t off = (size_t)row * 1024 + u.pn * 256 + bj * HALF + cl;
                    *(u32x4*)(Q + off) = pack8(acc[ai][bj][m][0] * rs, acc[ai][bj][m][1] * rs); } }
    }
};
struct EpiGU {
    static constexpr bool PERM = true, AFTER_DRAIN = false;
    const float* ssq; bf16_t* F;
    __device__ __forceinline__ void operator()(const f32x4 (&acc)[2][2][4][2], const Unit& u, int wr, int wc, int fr, int fq) const {
        const int row0 = u.pm * BM + wr * 64 + fr, cl = wc * 32 + 8 * fq;
#pragma unroll
        for (int ai = 0; ai < 2; ++ai)
#pragma unroll
            for (int m = 0; m < 4; ++m) { const int row = row0 + ai * HALF + m * 16; const float rs = rstd16(ssq + (size_t)row * 16);
                f32x4 o0, o1;
#pragma unroll
                for (int j = 0; j < 4; ++j) { const float g0 = acc[ai][0][m][0][j] * rs, g1 = acc[ai][0][m][1][j] * rs;
                    o0[j] = g0 * sigm(g0) * (acc[ai][1][m][0][j] * rs); o1[j] = g1 * sigm(g1) * (acc[ai][1][m][1][j] * rs); }
                *(u32x4*)(F + (size_t)row * 2816 + u.pn * 128 + cl) = pack8(o0, o1); }
    }
};
template <class Epi, class Sched, bool ALIGN_EPI = false, bool SP2 = false>
__device__ __forceinline__ void gemm_phase(PG8_LAS unsigned char* lds, const Gemm g, const Sched& S, const Epi& E) {
    const int tid = threadIdx.x, wid = __builtin_amdgcn_readfirstlane(tid >> 6), lane = tid & 63, wr = wid >> 2, wc = wid & 3, fr = lane & 15, fq = lane >> 4;
    const int K = g.K, nt = K / BK;
    unsigned voffA[2], voffB[2];
#pragma unroll
    for (int i = 0; i < 2; ++i) { int R, C; stage_rc(tid * 16 + i * 8192, R, C); const int Rb = Epi::PERM ? ((R & ~31) + perm32(R & 31)) : R;
        voffA[i] = (unsigned)(R * K + C) * 2u; voffB[i] = (unsigned)(Rb * K + C) * 2u; }
    const size_t kstep = (size_t)(BK * 2);
    const size_t hstep = (size_t)HALF * K * 2;
    const size_t tstep = 2 * hstep;
    const unsigned ldsw = (unsigned)wid * 1024u;
    const int aoff = lds_byte(wr * 64 + fr, fq * 8), boff = lds_byte(wc * 32 + fr, fq * 8);
#define PG8_SA(b, h) (((b) * 2 + (h)) * HTB)
#define PG8_SB(b, h) ((4 + (b) * 2 + (h)) * HTB)
#define PG8_STAGE(bufoff, gbase, voff) do { _Pragma("unroll") for (int _i = 0; _i < 2; ++_i) \
        __builtin_amdgcn_global_load_lds((const unsigned*)((const char*)(gbase) + (voff)[_i]), (PG8_LAS unsigned*)(lds + (bufoff) + ldsw + _i * 8192), 16, 0, 0); } while (0)
#define PG8_LDA(dst, b, h) do { _Pragma("unroll") for (int m = 0; m < 4; ++m) _Pragma("unroll") for (int k = 0; k < 2; ++k) dst[m][k] = *(const PG8_LAS bf16x8*)(lds + PG8_SA(b, h) + aoff + m * 2048 + k * 1024); } while (0)
#define PG8_LDB(dst, b, h) do { _Pragma("unroll") for (int n = 0; n < 2; ++n) _Pragma("unroll") for (int k = 0; k < 2; ++k) dst[n][k] = *(const PG8_LAS bf16x8*)(lds + PG8_SB(b, h) + boff + n * 2048 + k * 1024); } while (0)
#define PG8_MMA(ai, bj, At, Bt) do { __builtin_amdgcn_s_setprio(1); _Pragma("unroll") for (int m = 0; m < 4; ++m) _Pragma("unroll") for (int n = 0; n < 2; ++n) _Pragma("unroll") for (int k = 0; k < 2; ++k) \
        acc[ai][bj][m][n] = __builtin_amdgcn_mfma_f32_16x16x32_bf16(Bt[n][k], At[m][k], acc[ai][bj][m][n], 0, 0, 0); __builtin_amdgcn_s_setprio(0); } while (0)
#define PG8_WAIT_V(n) asm volatile("s_waitcnt vmcnt(" #n ")" ::: "memory")
#define PG8_WAIT_L(n) asm volatile("s_waitcnt lgkmcnt(" #n ")" ::: "memory")
#define PG8_BAR __builtin_amdgcn_s_barrier()
#define PG8_SCHED __builtin_amdgcn_sched_barrier(0)
    Unit cur, nxt; int ui = 0;
    if (!S.next(0, cur)) return;
    f32x4 acc[2][2][4][2];
#pragma unroll
    for (int a = 0; a < 2; ++a)
#pragma unroll
        for (int b = 0; b < 2; ++b)
#pragma unroll
            for (int m = 0; m < 4; ++m)
#pragma unroll
                for (int n = 0; n < 2; ++n) acc[a][b][m][n] = (f32x4){0.f, 0.f, 0.f, 0.f};
    bf16x8 At[4][2], B0[2][2], B1[2][2];
    const char* cA = (const char*)g.A + (size_t)cur.pm * tstep; const char* cB = (const char*)g.Bt + (size_t)cur.pn * tstep;
    S.a_ready(cur);
    if constexpr (SP2) {
        PG8_STAGE(PG8_SB(0, 0), cB, voffB); PG8_STAGE(PG8_SB(0, 1), cB + hstep, voffB); PG8_STAGE(PG8_SA(0, 0), cA, voffA); PG8_STAGE(PG8_SA(0, 1), cA + hstep, voffA);
        if (wr == 1) PG8_BAR;
        PG8_WAIT_V(2); PG8_BAR;
        PG8_STAGE(PG8_SB(1, 0), cB + kstep, voffB); PG8_STAGE(PG8_SA(1, 0), cA + kstep, voffA); PG8_STAGE(PG8_SB(1, 1), cB + hstep + kstep, voffB);
        PG8_WAIT_V(6); PG8_BAR;
    } else {
        PG8_STAGE(PG8_SB(0, 0), cB, voffB); PG8_STAGE(PG8_SA(0, 0), cA, voffA); PG8_STAGE(PG8_SB(0, 1), cB + hstep, voffB); PG8_STAGE(PG8_SA(0, 1), cA + hstep, voffA);
        if (wr == 1) PG8_BAR;
        PG8_WAIT_V(4); PG8_BAR;
        PG8_STAGE(PG8_SB(1, 0), cB + kstep, voffB); PG8_STAGE(PG8_SA(1, 0), cA + kstep, voffA); PG8_STAGE(PG8_SB(1, 1), cB + hstep + kstep, voffB);
        PG8_WAIT_V(6); PG8_BAR;
    }
    for (;;) {
        const bool has_next = S.next(ui + 1, nxt);
        const char* nA = has_next ? (const char*)g.A + (size_t)nxt.pm * tstep : cA; const char* nB = has_next ? (const char*)g.Bt + (size_t)nxt.pn * tstep : cB;
        for (int t = 0; t < nt; t += 2) {
            const bool last = (t == nt - 2);
            const char* a1 = cA + (size_t)(t + 1) * kstep;
            const char* a2 = last ? nA : cA + (size_t)(t + 2) * kstep; const char* b2 = last ? nB : cB + (size_t)(t + 2) * kstep;
            const char* a3 = a2 + kstep; const char* b3 = b2 + kstep;
            if (last && has_next) S.a_ready(nxt);
            if constexpr (SP2) {
            PG8_LDB(B0, 0, 0); PG8_LDB(B1, 0, 1); PG8_SCHED; PG8_LDA(At, 0, 0); PG8_STAGE(PG8_SA(1, 1), a1 + hstep, voffA);
            PG8_WAIT_V(8); PG8_WAIT_L(0); PG8_BAR; PG8_MMA(0, 0, At, B0); PG8_MMA(0, 1, At, B1); PG8_BAR; PG8_SCHED;
            PG8_LDA(At, 0, 1); PG8_STAGE(PG8_SB(0, 0), b2, voffB); PG8_STAGE(PG8_SB(0, 1), b2 + hstep, voffB); PG8_STAGE(PG8_SA(0, 0), a2, voffA);
            PG8_WAIT_V(8); PG8_WAIT_L(0); PG8_BAR; PG8_MMA(1, 0, At, B0); PG8_MMA(1, 1, At, B1); PG8_BAR; PG8_SCHED;
            PG8_LDB(B0, 1, 0); PG8_LDB(B1, 1, 1); PG8_SCHED; PG8_LDA(At, 1, 0); PG8_STAGE(PG8_SA(0, 1), a2 + hstep, voffA);
            PG8_WAIT_V(8); PG8_WAIT_L(0); PG8_BAR; PG8_MMA(0, 0, At, B0); PG8_MMA(0, 1, At, B1); PG8_BAR; PG8_SCHED;
            PG8_LDA(At, 1, 1); PG8_STAGE(PG8_SB(1, 0), b3, voffB); PG8_STAGE(PG8_SB(1, 1), b3 + hstep, voffB); PG8_STAGE(PG8_SA(1, 0), a3, voffA);
            PG8_WAIT_V(8); PG8_WAIT_L(0); PG8_BAR; PG8_MMA(1, 0, At, B0); PG8_MMA(1, 1, At, B1); PG8_BAR; PG8_SCHED;
            } else {
            PG8_LDB(B0, 0, 0); PG8_SCHED; PG8_LDA(At, 0, 0); PG8_STAGE(PG8_SA(1, 1), a1 + hstep, voffA);
            PG8_WAIT_L(8); PG8_BAR; PG8_WAIT_L(0); PG8_MMA(0, 0, At, B0); PG8_BAR; PG8_SCHED;
            PG8_LDB(B1, 0, 1); PG8_STAGE(PG8_SB(0, 0), b2, voffB);
            PG8_BAR; PG8_WAIT_L(0); PG8_MMA(0, 1, At, B1); PG8_BAR;
            PG8_LDA(At, 0, 1); PG8_STAGE(PG8_SA(0, 0), a2, voffA);
            PG8_BAR; PG8_WAIT_L(0); PG8_MMA(1, 0, At, B0); PG8_BAR; PG8_SCHED;
            PG8_STAGE(PG8_SB(0, 1), b2 + hstep, voffB);
            PG8_WAIT_V(6); PG8_BAR; PG8_MMA(1, 1, At, B1); PG8_BAR;
            PG8_LDB(B0, 1, 0); PG8_SCHED; PG8_LDA(At, 1, 0); PG8_STAGE(PG8_SA(0, 1), a2 + hstep, voffA);
            PG8_WAIT_L(8); PG8_BAR; PG8_WAIT_L(0); PG8_MMA(0, 0, At, B0); PG8_BAR; PG8_SCHED;
            PG8_LDB(B1, 1, 1); PG8_STAGE(PG8_SB(1, 0), b3, voffB);
            PG8_BAR; PG8_WAIT_L(0); PG8_MMA(0, 1, At, B1); PG8_BAR;
            PG8_LDA(At, 1, 1); PG8_STAGE(PG8_SA(1, 0), a3, voffA);
            PG8_BAR; PG8_WAIT_L(0); PG8_MMA(1, 0, At, B0); PG8_BAR; PG8_SCHED;
            PG8_STAGE(PG8_SB(1, 1), b3 + hstep, voffB);
            PG8_WAIT_V(6); PG8_BAR; PG8_MMA(1, 1, At, B1); PG8_BAR;
            }
        }
        if constexpr (ALIGN_EPI) { if (wr == 0) PG8_BAR; }
        if constexpr (!Epi::AFTER_DRAIN) { E(acc, cur, wr, wc, fr, fq); S.done(cur); }
        if (!has_next) break;
#pragma unroll
        for (int a = 0; a < 2; ++a)
#pragma unroll
            for (int b = 0; b < 2; ++b)
#pragma unroll
                for (int m = 0; m < 4; ++m)
#pragma unroll
                    for (int n = 0; n < 2; ++n) acc[a][b][m][n] = (f32x4){0.f, 0.f, 0.f, 0.f};
        cur = nxt; cA = nA; cB = nB; ++ui;
        if constexpr (ALIGN_EPI) { if (wr == 1) PG8_BAR; }
    }
    PG8_WAIT_V(0);
    if constexpr (!ALIGN_EPI) { if (wr == 0) PG8_BAR; }
    PG8_BAR;
    if constexpr (Epi::AFTER_DRAIN) { E.fused(acc, cur, wr, wc, fr, fq, lds, wid, lane); S.done(cur); }
#undef PG8_SA
#undef PG8_SB
#undef PG8_STAGE
#undef PG8_LDA
#undef PG8_LDB
#undef PG8_MMA
#undef PG8_WAIT_V
#undef PG8_WAIT_L
#undef PG8_BAR
#undef PG8_SCHED
}
}

#define LAS __attribute__((address_space(3)))
typedef unsigned short bf16;
typedef float f32x4 __attribute__((ext_vector_type(4)));
typedef short bf16x8 __attribute__((ext_vector_type(8)));
typedef unsigned u32x4 __attribute__((ext_vector_type(4)));
typedef unsigned u32x2 __attribute__((ext_vector_type(2)));
constexpr int DM = 1024, NB = 8, SEQ = 2048, MP = NB * SEQ, NS = 128, MALL = MP + NS, NMEM = 256, FF = 2816, FF2 = 5632, MMEM = NB * NMEM;
constexpr float EPS = 1e-6f;
constexpr float QSCALE = 0.0625f * 1.4426950408889634f;
constexpr size_t O_Y = 0, O_YS = 16777216, O_PP = O_YS + 131072, O_PS = O_PP + 61440, O_CP = O_PS + 983040, O_CS = O_CP + 122880, O_MK = O_CS + 1966080, O_MV = O_MK + 2097152;
constexpr size_t MiB = 1u << 20;
constexpr size_t WS_CTL = 0, CTL_ZERO_BYTES = MiB;
constexpr size_t WS_WIN = 1 * MiB, WS_WKV = 4 * MiB, WS_WOUT = 8 * MiB, WS_WQ = 10 * MiB, WS_WO = 12 * MiB, WS_WGU = 14 * MiB, WS_WD = 25 * MiB, WS_WMAP = 31 * MiB;
constexpr size_t WS_HB = 32 * MiB, WS_AP = 65 * MiB, WS_GLU = 82 * MiB, WS_C = 99 * MiB, WS_X1 = 132 * MiB, WS_X1B = 197 * MiB, WS_Q = 230 * MiB, WS_KB = 263 * MiB, WS_VT = 267 * MiB;
constexpr size_t WS_O = 271 * MiB, WS_X2B = 304 * MiB, WS_F = 337 * MiB, WS_MB = 426 * MiB, WS_SSQ1 = 430 * MiB, WS_SSQ2 = 431 * MiB, WS_SSQ3 = 432 * MiB, WS_SSQS = 433 * MiB, WS_US = 434 * MiB, WS_HC = 435 * MiB;
constexpr size_t WS_HP = WS_HC + 512 * 1024, WS_END = 436 * MiB;
constexpr int LDS_BYTES = 147456;
constexpr int NPHASE = 10;

__device__ __forceinline__ float wave_sum(float v) {
#pragma unroll
    for (int o = 1; o < 64; o <<= 1) v += __shfl_xor(v, o);
    return v;
}
__device__ __forceinline__ float wave_max(float v) {
#pragma unroll
    for (int o = 1; o < 64; o <<= 1) v = fmaxf(v, __shfl_xor(v, o));
    return v;
}
__device__ __forceinline__ unsigned f2bf(float f) { unsigned u = __builtin_bit_cast(unsigned, f); return (u + 0x7fffu + ((u >> 16) & 1u)) >> 16; }
__device__ __forceinline__ unsigned pk2(float lo, float hi) { return f2bf(lo) | (f2bf(hi) << 16); }
__device__ __forceinline__ float bf2f(bf16 v) { return __builtin_bit_cast(float, (unsigned)v << 16); }
__device__ __forceinline__ float sigm(float x) { return __builtin_amdgcn_rcpf(1.0f + __builtin_amdgcn_exp2f(-1.4426950408889634f * x)); }
#define LDS_WAIT() asm volatile("s_waitcnt lgkmcnt(0)" ::: "memory")

__device__ __forceinline__ void transpose_item(const float* W, int K, int N, const float* gk, bf16* WT, int dst_row0, LAS float* scr, int k0, int n0, int lane) {
#pragma unroll 8
    for (int i = 0; i < 32; ++i) { const int kk = 2 * i + (lane >> 5); float v = W[(size_t)(k0 + kk) * N + n0 + (lane & 31)]; if (gk) v *= gk[k0 + kk]; scr[kk * 33 + (lane & 31)] = v; }
    LDS_WAIT();
    const int c = lane & 7;
#pragma unroll
    for (int j = 0; j < 4; ++j) { const int n = (lane >> 3) + 8 * j; const LAS float* s = scr + (8 * c) * 33 + n;
        u32x4 o; o.x = pk2(s[0 * 33], s[1 * 33]); o.y = pk2(s[2 * 33], s[3 * 33]); o.z = pk2(s[4 * 33], s[5 * 33]); o.w = pk2(s[6 * 33], s[7 * 33]);
        *(u32x4*)(WT + (size_t)(dst_row0 + n) * K + k0 + 8 * c) = o; }
    LDS_WAIT();
}
__device__ __forceinline__ void rms_row_to_bf16(const float* xrow, const float* g, bf16* orow, int lane) {
    const f32x4* xr = (const f32x4*)xrow + lane; const f32x4* gr = (const f32x4*)g + lane;
    f32x4 v[4]; float s = 0.f;
#pragma unroll
    for (int j = 0; j < 4; ++j) { v[j] = xr[64 * j]; s += (v[j].x * v[j].x + v[j].y * v[j].y) + (v[j].z * v[j].z + v[j].w * v[j].w); }
    const float rstd = 1.0f / sqrtf(wave_sum(s) * (1.0f / DM) + EPS);
    unsigned long long* o8 = (unsigned long long*)orow + lane;
#pragma unroll
    for (int j = 0; j < 4; ++j) { const f32x4 gg = gr[64 * j]; const f32x4 o = v[j] * rstd * gg;
        o8[64 * j] = (unsigned long long)pk2(o.x, o.y) | ((unsigned long long)pk2(o.z, o.w) << 32); }
}

struct Args { const float* in[28]; float* out; unsigned char* ws; int ph_lo, ph_hi; };

__device__ __forceinline__ void p0_prologue(const Args& a, LAS unsigned char* lds, int bid, int G, int tid, int lane, int wave) {
    unsigned char* ws = a.ws;
    LAS float* scr = (LAS float*)(lds + wave * 16384);
    const int gw = bid * 8 + wave, NGW = G * 8;
    constexpr int I_IN = 16 * 48, I_SQ = 16 * 32, I_GU = 16 * 88, I_D = 44 * 32, I_PM = 2 * 4;
    constexpr int NITEMS = I_IN + 5 * I_SQ + 2 * I_GU + I_D + 4 * I_PM;
    for (int it = gw; it < NITEMS; it += NGW) {
        int r = it;
        if (r < I_IN) { const int kb = r / 48, n0 = (r % 48) * 32; int dr;
            if (n0 < 512) dr = n0; else { int j = n0 - 512; int hi = 0; if (j >= 512) { j -= 512; hi = 128; } dr = 512 + (j >> 7) * 256 + hi + (j & 127); }
            transpose_item(a.in[8], 1024, 1536, nullptr, (bf16*)(ws + WS_WIN), dr, scr, 64 * kb, n0, lane); continue; } r -= I_IN;
        if (r < I_SQ) { transpose_item(a.in[20], 1024, 1024, nullptr, (bf16*)(ws + WS_WKV), (r % 32) * 32, scr, 64 * (r / 32), (r % 32) * 32, lane); continue; } r -= I_SQ;
        if (r < I_SQ) { transpose_item(a.in[21], 1024, 1024, nullptr, (bf16*)(ws + WS_WKV), 1024 + (r % 32) * 32, scr, 64 * (r / 32), (r % 32) * 32, lane); continue; } r -= I_SQ;
        if (r < I_SQ) { transpose_item(a.in[16], 1024, 1024, nullptr, (bf16*)(ws + WS_WOUT), (r % 32) * 32, scr, 64 * (r / 32), (r % 32) * 32, lane); continue; } r -= I_SQ;
        if (r < I_SQ) { transpose_item(a.in[19], 1024, 1024, a.in[17], (bf16*)(ws + WS_WQ), (r % 32) * 32, scr, 64 * (r / 32), (r % 32) * 32, lane); continue; } r -= I_SQ;
        if (r < I_SQ) { transpose_item(a.in[22], 1024, 1024, nullptr, (bf16*)(ws + WS_WO), (r % 32) * 32, scr, 64 * (r / 32), (r % 32) * 32, lane); continue; } r -= I_SQ;
        if (r < I_GU) { const int n0 = (r % 88) * 32; transpose_item(a.in[24], 1024, FF, a.in[23], (bf16*)(ws + WS_WGU), (n0 >> 7) * 256 + (n0 & 127), scr, 64 * (r / 88), n0, lane); continue; } r -= I_GU;
        if (r < I_GU) { const int n0 = (r % 88) * 32; transpose_item(a.in[25], 1024, FF, a.in[23], (bf16*)(ws + WS_WGU), (n0 >> 7) * 256 + 128 + (n0 & 127), scr, 64 * (r / 88), n0, lane); continue; } r -= I_GU;
        if (r < I_D) { transpose_item(a.in[26], FF, 1024, nullptr, (bf16*)(ws + WS_WD), (r % 32) * 32, scr, 64 * (r / 32), (r % 32) * 32, lane); continue; } r -= I_D;
        { const int g = r / I_PM, q = r % I_PM; transpose_item(a.in[9] + (size_t)g * 16384, 128, 128, nullptr, (bf16*)(ws + WS_WMAP) + (size_t)g * 16384, (q % 4) * 32, scr, 64 * (q / 4), (q % 4) * 32, lane); }
    }
    for (int m = gw; m < MALL + MMEM; m += NGW) {
        if (m < MP) rms_row_to_bf16(a.in[0] + (size_t)m * DM, a.in[7], (bf16*)(ws + WS_HB) + (size_t)m * DM, lane);
        else if (m < MALL) rms_row_to_bf16(a.in[1] + (size_t)(m - MP) * DM, a.in[7], (bf16*)(ws + WS_HB) + (size_t)m * DM, lane);
        else rms_row_to_bf16(a.in[2] + (size_t)(m - MALL) * DM, a.in[18], (bf16*)(ws + WS_MB) + (size_t)(m - MALL) * DM, lane);
    }
    const float* spool = a.in[3]; const float* sconv = a.in[4]; const float* wdw = a.in[12]; const float* bdw = a.in[13];
    float* HC = (float*)(ws + WS_HC); float* HP = (float*)(ws + WS_HP);
    for (int e = bid * 512 + tid; e < NS * 512; e += G * 512) {
        const int b = e >> 9, ch = e & 511;
        float acc = bdw[ch];
#pragma unroll 10
        for (int j = 0; j < 30; ++j) { const float v = sconv[(size_t)(b * 30 + j) * 512 + ch]; acc += wdw[j * 512 + ch] * v; if (j >= 1) a.out[O_CS + (size_t)(b * 30 + j - 1) * 512 + ch] = v; }
        HC[e] = acc;
        const int w = 2 << (ch >> 7); float s = 0.f;
#pragma unroll 5
        for (int j = 0; j < 15; ++j) { const float v = spool[(size_t)(b * 15 + j) * 512 + ch]; if (j >= 1) a.out[O_PS + (size_t)(b * 15 + j - 1) * 512 + ch] = v; if (j >= 16 - w) s += v; }
        HP[e] = s;
    }
}

template <bool PAIR, class Fn>
__device__ __forceinline__ void skinny(const bf16* A, const bf16* Bt, int K, int nColBlk, int c, int G, LAS float* red, int tid, const Fn& fn) {
    const int lane = tid & 63, wave = __builtin_amdgcn_readfirstlane(tid >> 6), fr = lane & 15, fq = lane >> 4;
    const int nItems = nColBlk * 4, kw = K >> 3;
    for (int it = c; it < nItems; it += G) {
        const int rb = it & 3, cb = it >> 2;
        const int n0 = PAIR ? ((cb >> 3) * 256 + (cb & 7) * 16) : cb * 16;
        const bf16* ap = A + (size_t)(32 * rb + fr) * K + wave * kw + 8 * fq;
        const bf16* bp = Bt + (size_t)(n0 + fr) * K + wave * kw + 8 * fq;
        f32x4 c00 = {0.f, 0.f, 0.f, 0.f}, c01 = c00, c10 = c00, c11 = c00;
        for (int ks = 0; ks < kw; ks += 32) {
            const bf16x8 b0 = *(const bf16x8*)(bp + ks), a0 = *(const bf16x8*)(ap + ks), a1 = *(const bf16x8*)(ap + (size_t)16 * K + ks);
            c00 = __builtin_amdgcn_mfma_f32_16x16x32_bf16(b0, a0, c00, 0, 0, 0); c01 = __builtin_amdgcn_mfma_f32_16x16x32_bf16(b0, a1, c01, 0, 0, 0);
            if (PAIR) { const bf16x8 b1 = *(const bf16x8*)(bp + (size_t)128 * K + ks);
                c10 = __builtin_amdgcn_mfma_f32_16x16x32_bf16(b1, a0, c10, 0, 0, 0); c11 = __builtin_amdgcn_mfma_f32_16x16x32_bf16(b1, a1, c11, 0, 0, 0); }
        }
        LAS float* rw = red + wave * 1024;
        *(LAS f32x4*)(rw + fr * 16 + 4 * fq) = c00; *(LAS f32x4*)(rw + (16 + fr) * 16 + 4 * fq) = c01;
        if (PAIR) { *(LAS f32x4*)(rw + 512 + fr * 16 + 4 * fq) = c10; *(LAS f32x4*)(rw + 512 + (16 + fr) * 16 + 4 * fq) = c11; }
        __syncthreads();
        float v0 = 0.f, v1 = 0.f;
#pragma unroll
        for (int w = 0; w < 8; ++w) { v0 += red[w * 1024 + tid]; if (PAIR) v1 += red[w * 1024 + 512 + tid]; }
        fn(32 * rb + (tid >> 4), cb * 16 + (tid & 15), cb, v0, v1);
        __syncthreads();
    }
}
__device__ __forceinline__ float red16(float s) { s += __shfl_xor(s, 1); s += __shfl_xor(s, 2); s += __shfl_xor(s, 4); s += __shfl_xor(s, 8); return s; }
__device__ __forceinline__ float rstd_s(const float* p, int row, int ci) {
    const float* q = p + row * 64 + ci; return 1.0f / sqrtf(red16((q[0] + q[16]) + (q[32] + q[48])) * (1.0f / DM) + EPS);
}
struct SkRaw { float* O; int ld; __device__ __forceinline__ void operator()(int row, int col, int, float v0, float) const { O[(size_t)row * ld + col] = v0; } };
struct SkRes { const float* resid; float* xout; bf16* xb; float* ssq;
    __device__ __forceinline__ void operator()(int row, int col, int cb, float v0, float) const {
        const size_t off = (size_t)row * DM + col; const float x = resid[off] + v0; xout[off] = x; if (xb) xb[off] = (bf16)f2bf(x);
        const float ss = red16(x * x); if ((col & 15) == 0) ssq[row * 64 + cb] = ss; } };
struct SkQ { const float* ssq; bf16* Q; __device__ __forceinline__ void operator()(int row, int col, int, float v0, float) const {
        const float rs = rstd_s(ssq, row, col & 15) * QSCALE; Q[(size_t)row * DM + col] = (bf16)f2bf(v0 * rs); } };
struct SkGU { const float* ssq; bf16* F; __device__ __forceinline__ void operator()(int row, int col, int, float v0, float v1) const {
        const float rs = rstd_s(ssq, row, col & 15); const float g = v0 * rs; F[(size_t)row * FF + col] = (bf16)f2bf(g * sigm(g) * (v1 * rs)); } };

constexpr int MX_YC = 0, MX_D = 65536, MX_DSTRIDE = 1040;
template <int W> __device__ __forceinline__ void pool_half(const bf16* AP, int b, int t0, int r0, int tid, LAS unsigned char* lds) {
    float in[16 + W - 1];
#pragma unroll
    for (int i = 0; i < 16 + W - 1; ++i) { const int t = t0 + r0 - (W - 1) + i; const int tt = t < 0 ? 0 : t; const float v = bf2f(AP[(size_t)(b * SEQ + tt) * 512 + tid]); in[i] = t >= 0 ? v : 0.f; }
#pragma unroll
    for (int r = 0; r < 16; ++r) { float s = 0.f;
#pragma unroll
        for (int j = 0; j < W; ++j) s += in[r + j];
        const int t = t0 + r0 + r; const int cnt = (t + 1 < W) ? (t + 1) : W;
        const float d = s / (float)cnt - in[r + W - 1];
        *(LAS bf16*)(lds + MX_D + (r0 + r) * MX_DSTRIDE + tid * 2) = (bf16)f2bf(d); }
}
__device__ __forceinline__ void mixer_finish(const Args& a, LAS unsigned char* lds, int crow0, int tid, int lane, int wave) {
    bf16* C = (bf16*)(a.ws + WS_C);
    const LAS float* yc = (const LAS float*)(lds + MX_YC);
    { const f32x4 g0 = *(const f32x4*)(a.in[14] + lane * 8), g1 = *(const f32x4*)(a.in[14] + lane * 8 + 4), b0 = *(const f32x4*)(a.in[15] + lane * 8), b1 = *(const f32x4*)(a.in[15] + lane * 8 + 4);
#pragma unroll
      for (int i = 0; i < 4; ++i) { const int r = 4 * wave + i;
        const f32x4 y0 = *(const LAS f32x4*)(yc + r * 512 + lane * 8), y1 = *(const LAS f32x4*)(yc + r * 512 + lane * 8 + 4);
        const float mu = wave_sum((y0.x + y0.y) + (y0.z + y0.w) + (y1.x + y1.y) + (y1.z + y1.w)) * (1.0f / 512.0f);
        const f32x4 d0 = y0 - mu, d1 = y1 - mu;
        const float var = wave_sum((d0.x * d0.x + d0.y * d0.y) + (d0.z * d0.z + d0.w * d0.w) + (d1.x * d1.x + d1.y * d1.y) + (d1.z * d1.z + d1.w * d1.w)) * (1.0f / 512.0f);
        const float rs = 1.0f / sqrtf(var + EPS);
        f32x4 n0 = d0 * rs * g0 + b0, n1 = d1 * rs * g1 + b1;
#pragma unroll
        for (int j = 0; j < 4; ++j) { n0[j] = n0[j] * sigm(n0[j]); n1[j] = n1[j] * sigm(n1[j]); }
        u32x4 o; o.x = pk2(n0.x, n0.y); o.y = pk2(n0.z, n0.w); o.z = pk2(n1.x, n1.y); o.w = pk2(n1.z, n1.w);
        *(u32x4*)(C + (size_t)(crow0 + r) * DM + 512 + lane * 8) = o; } }
    { const int g = wave >> 1, nh = wave & 1, fr = lane & 15, fq = lane >> 4;
      const bf16* WT = (const bf16*)(a.ws + WS_WMAP) + (size_t)g * 16384;
      f32x4 acc[2][4];
#pragma unroll
      for (int mb = 0; mb < 2; ++mb)
#pragma unroll
          for (int nb = 0; nb < 4; ++nb) acc[mb][nb] = (f32x4){0.f, 0.f, 0.f, 0.f};
#pragma unroll
      for (int kc = 0; kc < 4; ++kc) {
          bf16x8 af[2];
#pragma unroll
          for (int mb = 0; mb < 2; ++mb) af[mb] = *(const LAS bf16x8*)(lds + MX_D + (16 * mb + fr) * MX_DSTRIDE + (g * 128 + 32 * kc + 8 * fq) * 2);
#pragma unroll
          for (int nb = 0; nb < 4; ++nb) { const bf16x8 bf = *(const bf16x8*)(WT + (size_t)(64 * nh + 16 * nb + fr) * 128 + 32 * kc + 8 * fq);
#pragma unroll
              for (int mb = 0; mb < 2; ++mb) acc[mb][nb] = __builtin_amdgcn_mfma_f32_16x16x32_bf16(bf, af[mb], acc[mb][nb], 0, 0, 0); }
      }
#pragma unroll
      for (int nb = 0; nb < 4; ++nb) { const int ch = g * 128 + 64 * nh + 16 * nb + 4 * fq;
          const f32x4 bm = *(const f32x4*)(a.in[10] + ch), sc = *(const f32x4*)(a.in[11] + ch);
#pragma unroll
          for (int mb = 0; mb < 2; ++mb) { const f32x4 y = (acc[mb][nb] + bm) * sc; u32x2 o; o.x = pk2(y.x, y.y); o.y = pk2(y.z, y.w);
              *(u32x2*)(C + (size_t)(crow0 + 16 * mb + fr) * DM + ch) = o; } } }
}
__device__ __forceinline__ void mixer_prompt_unit(const Args& a, LAS unsigned char* lds, int u, int tid, int lane, int wave) {
    const int b = u >> 6, t0 = (u & 63) * 32;
    const bf16* GLU = (const bf16*)(a.ws + WS_GLU); const bf16* AP = (const bf16*)(a.ws + WS_AP);
    LAS float* yc = (LAS float*)(lds + MX_YC);
    { float w[31];
#pragma unroll
      for (int j = 0; j < 31; ++j) w[j] = a.in[12][j * 512 + tid];
      const float bias = a.in[13][tid];
#pragma unroll 1
      for (int h = 0; h < 2; ++h) { const int r0 = 16 * h; float in[46];
#pragma unroll
          for (int i = 0; i < 46; ++i) { const int t = t0 + r0 - 30 + i; const int tt = t < 0 ? 0 : t; const float v = bf2f(GLU[(size_t)(b * SEQ + tt) * 512 + tid]); in[i] = t >= 0 ? v : 0.f; }
#pragma unroll
          for (int r = 0; r < 16; ++r) { float acc = bias;
#pragma unroll
              for (int j = 0; j < 31; ++j) acc += w[j] * in[r + j];
              yc[(r0 + r) * 512 + tid] = acc; } } }
    { const int g = tid >> 7;
#pragma unroll 1
      for (int h = 0; h < 2; ++h) {
          if (g == 0) pool_half<2>(AP, b, t0, 16 * h, tid, lds); else if (g == 1) pool_half<4>(AP, b, t0, 16 * h, tid, lds);
          else if (g == 2) pool_half<8>(AP, b, t0, 16 * h, tid, lds); else pool_half<16>(AP, b, t0, 16 * h, tid, lds); } }
    __syncthreads();
    mixer_finish(a, lds, b * SEQ + t0, tid, lane, wave);
    __syncthreads();
}
__device__ __forceinline__ void mixer_sample_unit(const Args& a, LAS unsigned char* lds, int su, int tid, int lane, int wave) {
    const float* US = (const float*)(a.ws + WS_US); const float* HC = (const float*)(a.ws + WS_HC); const float* HP = (const float*)(a.ws + WS_HP);
    LAS float* yc = (LAS float*)(lds + MX_YC);
    const float w30 = a.in[12][30 * 512 + tid]; const int wdt = 2 << (tid >> 7); const float invw = 1.0f / (float)wdt;
    const int gcol = 512 + (tid >> 7) * 256 + (tid & 127);
#pragma unroll 4
    for (int s = 0; s < 32; ++s) { const int bs = 32 * su + s;
        const float val = US[(size_t)bs * 1536 + gcol], gate = US[(size_t)bs * 1536 + gcol + 128], av = US[(size_t)bs * 1536 + tid];
        const float glu = val * sigm(gate);
        a.out[O_CS + (size_t)(bs * 30 + 29) * 512 + tid] = glu; a.out[O_PS + (size_t)(bs * 15 + 14) * 512 + tid] = av;
        yc[s * 512 + tid] = HC[bs * 512 + tid] + w30 * glu;
        const float d = (av + HP[bs * 512 + tid]) * invw - av;
        *(LAS bf16*)(lds + MX_D + s * MX_DSTRIDE + tid * 2) = (bf16)f2bf(d); }
    __syncthreads();
    mixer_finish(a, lds, MP + 32 * su, tid, lane, wave);
    __syncthreads();
}

constexpr int AT_K = 0, AT_KSTR = 528, AT_V = 64 * AT_KSTR, AT_VSTR = 144;
__device__ __forceinline__ float fexp2(float x) { return __builtin_amdgcn_exp2f(x); }
__device__ __forceinline__ void attn_prompt_unit(const Args& a, LAS unsigned char* lds, int u, int tid, int lane, int wave) {
    const int qb = u & 15, h = (u >> 4) & 3, b = u >> 6, fr = lane & 15, fq = lane >> 4;
    const bf16* Q = (const bf16*)(a.ws + WS_Q); const bf16* KB = (const bf16*)(a.ws + WS_KB); const bf16* VT = (const bf16*)(a.ws + WS_VT); bf16* O = (bf16*)(a.ws + WS_O);
    const size_t rowq = (size_t)b * SEQ + qb * 128 + wave * 16 + fr;
    bf16x8 qf[8];
#pragma unroll
    for (int kd = 0; kd < 8; ++kd) qf[kd] = *(const bf16x8*)(Q + rowq * DM + h * 256 + 32 * kd + 8 * fq);
    f32x4 o[16];
#pragma unroll
    for (int i = 0; i < 16; ++i) o[i] = (f32x4){0.f, 0.f, 0.f, 0.f};
    float mrun = -INFINITY, lrun = 0.f;
    u32x4 kr[4], vr[4];
#define AT_LOAD(c) do { _Pragma("unroll") for (int i = 0; i < 4; ++i) { const int p = tid + 512 * i; \
        kr[i] = *(const u32x4*)(KB + (size_t)(b * 256 + 64 * (c) + (p >> 5)) * DM + h * 256 + (p & 31) * 8); \
        vr[i] = *(const u32x4*)(VT + (size_t)(h * 256 + (p >> 3)) * 2048 + b * 256 + 64 * (c) + (p & 7) * 8); } } while (0)
    AT_LOAD(0);
#pragma unroll 1
    for (int c = 0; c < 4; ++c) {
        __syncthreads();
#pragma unroll
        for (int i = 0; i < 4; ++i) { const int p = tid + 512 * i;
            *(LAS u32x4*)(lds + AT_K + (p >> 5) * AT_KSTR + (p & 31) * 16) = kr[i];
            *(LAS u32x4*)(lds + AT_V + (p >> 3) * AT_VSTR + (p & 7) * 16) = vr[i]; }
        __syncthreads();
        if (c < 3) AT_LOAD(c + 1);
        f32x4 s[4];
#pragma unroll
        for (int nb = 0; nb < 4; ++nb) { s[nb] = (f32x4){0.f, 0.f, 0.f, 0.f};
#pragma unroll
            for (int kd = 0; kd < 8; ++kd) { const bf16x8 kf = *(const LAS bf16x8*)(lds + AT_K + (16 * nb + fr) * AT_KSTR + kd * 64 + fq * 16);
                s[nb] = __builtin_amdgcn_mfma_f32_16x16x32_bf16(kf, qf[kd], s[nb], 0, 0, 0); } }
        float mx = s[0][0];
#pragma unroll
        for (int nb = 0; nb < 4; ++nb)
#pragma unroll
            for (int j = 0; j < 4; ++j) mx = fmaxf(mx, s[nb][j]);
        mx = fmaxf(mx, __shfl_xor(mx, 16)); mx = fmaxf(mx, __shfl_xor(mx, 32));
        const float mnew = fmaxf(mrun, mx), alpha = fexp2(mrun - mnew);
        float ps = 0.f;
#pragma unroll
        for (int nb = 0; nb < 4; ++nb)
#pragma unroll
            for (int j = 0; j < 4; ++j) { s[nb][j] = fexp2(s[nb][j] - mnew); ps += s[nb][j]; }
        ps += __shfl_xor(ps, 16); ps += __shfl_xor(ps, 32);
        lrun = lrun * alpha + ps; mrun = mnew;
#pragma unroll
        for (int i = 0; i < 16; ++i) o[i] = o[i] * alpha;
#pragma unroll
        for (int kb = 0; kb < 2; ++kb) {
            u32x4 pw; pw.x = pg8::cvt_pk_bf16(s[2 * kb][0], s[2 * kb][1]); pw.y = pg8::cvt_pk_bf16(s[2 * kb][2], s[2 * kb][3]);
            pw.z = pg8::cvt_pk_bf16(s[2 * kb + 1][0], s[2 * kb + 1][1]); pw.w = pg8::cvt_pk_bf16(s[2 * kb + 1][2], s[2 * kb + 1][3]);
            const bf16x8 pf = __builtin_bit_cast(bf16x8, pw);
#pragma unroll
            for (int db = 0; db < 16; ++db) {
                const u32x2 v0 = *(const LAS u32x2*)(lds + AT_V + (16 * db + fr) * AT_VSTR + kb * 64 + fq * 8), v1 = *(const LAS u32x2*)(lds + AT_V + (16 * db + fr) * AT_VSTR + kb * 64 + 32 + fq * 8);
                u32x4 vw; vw.x = v0.x; vw.y = v0.y; vw.z = v1.x; vw.w = v1.y;
                o[db] = __builtin_amdgcn_mfma_f32_16x16x32_bf16(__builtin_bit_cast(bf16x8, vw), pf, o[db], 0, 0, 0); }
        }
    }
#undef AT_LOAD
    const float inv = 1.0f / lrun;
#pragma unroll
    for (int db = 0; db < 16; ++db) { const f32x4 y = o[db] * inv; u32x2 w; w.x = pg8::cvt_pk_bf16(y.x, y.y); w.y = pg8::cvt_pk_bf16(y.z, y.w);
        *(u32x2*)(O + rowq * DM + h * 256 + 16 * db + 4 * fq) = w; }
}
__device__ __forceinline__ void attn_sample_unit(const Args& a, LAS unsigned char* lds, int u, int tid, int lane, int wave) {
    const int b = u >> 2, h = u & 3;
    const bf16* Q = (const bf16*)(a.ws + WS_Q) + (size_t)(MP + b) * DM + h * 256; bf16* O = (bf16*)(a.ws + WS_O) + (size_t)(MP + b) * DM + h * 256;
    const float* ck = a.in[5] + ((size_t)b * 256 * 4 + h) * 256 + lane * 4; const float* cv = a.in[6] + ((size_t)b * 256 * 4 + h) * 256 + lane * 4;
    LAS float* sc = (LAS float*)lds; LAS float* pn = sc + 256; LAS float* red = sc + 512;
    const u32x2 qw = *(const u32x2*)(Q + lane * 4);
    const f32x4 q = {__builtin_bit_cast(float, qw.x << 16), __builtin_bit_cast(float, qw.x & 0xffff0000u), __builtin_bit_cast(float, qw.y << 16), __builtin_bit_cast(float, qw.y & 0xffff0000u)};
    float mine = 0.f;
#pragma unroll 16
    for (int i = 0; i < 32; ++i) { const f32x4 kv = *(const f32x4*)(ck + (size_t)(32 * wave + i) * 1024);
        const float sdot = wave_sum((kv.x * q.x + kv.y * q.y) + (kv.z * q.z + kv.w * q.w)); mine = (lane == i) ? sdot : mine; }
    __syncthreads();
    if (lane < 32) sc[32 * wave + lane] = mine;
    __syncthreads();
    { const f32x4 sv = *(const LAS f32x4*)(sc + lane * 4); const float mx = wave_max(fmaxf(fmaxf(sv.x, sv.y), fmaxf(sv.z, sv.w)));
      f32x4 e; e.x = fexp2(sv.x - mx); e.y = fexp2(sv.y - mx); e.z = fexp2(sv.z - mx); e.w = fexp2(sv.w - mx);
      const float inv = 1.0f / wave_sum((e.x + e.y) + (e.z + e.w));
      if (wave == 0) *(LAS f32x4*)(pn + lane * 4) = e * inv; }
    __syncthreads();
    f32x4 acc = {0.f, 0.f, 0.f, 0.f};
#pragma unroll 16
    for (int i = 0; i < 32; ++i) { const f32x4 vv = *(const f32x4*)(cv + (size_t)(32 * wave + i) * 1024); const float p = pn[32 * wave + i]; acc += vv * p; }
    *(LAS f32x4*)(red + wave * 256 + lane * 4) = acc;
    __syncthreads();
    if (tid < 256) { float s = 0.f;
#pragma unroll
        for (int w = 0; w < 8; ++w) s += red[w * 256 + tid];
        O[tid] = (bf16)f2bf(s); }
    __syncthreads();
}

#define XB_TMO      128
#define XB_XCNT(j)  (256  + 64 * (j))
#define XB_XSUB(j)  (1280 + 64 * (j))
#define XB_XGEN(j)  (2304 + 64 * (j))
#define XB_TOP      3328
#define XB_TOPGEN   3392
#define XCD_BAR_WORDS 3456
#define XB_SPIN_CAP (1u << 18)

__device__ __forceinline__ unsigned xb_ld(unsigned* p)              { return __hip_atomic_load(p, __ATOMIC_RELAXED, __HIP_MEMORY_SCOPE_AGENT); }
__device__ __forceinline__ unsigned xb_add(unsigned* p, unsigned v) { return __hip_atomic_fetch_add(p, v, __ATOMIC_RELAXED, __HIP_MEMORY_SCOPE_AGENT); }
__device__ __forceinline__ unsigned xb_xcc_id() { return (unsigned)__builtin_amdgcn_s_getreg((3 << 11) | 20) & 0xFu; }
#define XB_SPIN(cond, bar) do { unsigned _sp = 0; while (cond) { __builtin_amdgcn_s_sleep(1); \
    if ((++_sp & 255u) == 0u) { if (xb_ld(&(bar)[XB_TMO])) break; if (_sp > XB_SPIN_CAP) { atomicAdd(&(bar)[XB_TMO], 1u); break; } } } } while (0)

struct XcdBarrier {
    unsigned* bar; unsigned x;
    volatile LAS unsigned* st;
};

__device__ __forceinline__ XcdBarrier xcd_barrier_post(unsigned* bar, volatile LAS unsigned* st) {
    XcdBarrier b; b.bar = bar; b.x = xb_xcc_id(); b.st = st;
    if (threadIdx.x == 0) (void)xb_add(&bar[XB_XCNT(b.x)], 1u);
    return b;
}
__device__ __forceinline__ void xcd_barrier_complete(unsigned* bar, unsigned x, unsigned& nloc, unsigned& nx) {
    const unsigned G = gridDim.x * gridDim.y * gridDim.z;
    unsigned sum, cnt, mine, sp = 0u;
    for (;;) {
        sum = 0u; cnt = 0u; mine = 0u;
#pragma unroll
        for (unsigned j = 0; j < 16; ++j) { const unsigned c = xb_ld(&bar[XB_XCNT(j)]); sum += c; cnt += (c > 0u) ? 1u : 0u; mine = (j == x) ? c : mine; }
        if (sum == G) break;
        __builtin_amdgcn_s_sleep(1);
        if ((++sp & 255u) == 0u) { if (xb_ld(&bar[XB_TMO])) break; if (sp > XB_SPIN_CAP) { atomicAdd(&bar[XB_TMO], 1u); break; } }
    }
    nloc = mine > 0u ? mine : 1u; nx = cnt > 0u ? cnt : 1u;
}

__device__ __forceinline__ void xcd_barrier(const XcdBarrier& b) {
    asm volatile("s_waitcnt vmcnt(0)" ::: "memory");
    __syncthreads();
    if (threadIdx.x == 0) {
        unsigned* bar = b.bar;
        __builtin_amdgcn_s_waitcnt(0);
        unsigned nloc = b.st[0], nx = b.st[1];
        if (nloc == 0u) { xcd_barrier_complete(bar, b.x, nloc, nx); b.st[0] = nloc; b.st[1] = nx; }
        const unsigned old = xb_add(&bar[XB_XSUB(b.x)], 1u);
        const unsigned gen = old / nloc;
        if (old + 1u == (gen + 1u) * nloc) {
            __builtin_amdgcn_fence(__ATOMIC_RELEASE, "agent");
            asm volatile("s_waitcnt vmcnt(0)" ::: "memory");
            const unsigned og = xb_add(&bar[XB_TOP], 1u);
            const unsigned tg = og / nx;
            if (og + 1u == (tg + 1u) * nx) xb_add(&bar[XB_TOPGEN], 1u);
            else XB_SPIN(xb_ld(&bar[XB_TOPGEN]) == tg, bar);
            __builtin_amdgcn_fence(__ATOMIC_ACQUIRE, "agent");
            xb_add(&bar[XB_XGEN(b.x)], 1u);
            asm volatile("s_waitcnt vmcnt(0)" ::: "memory");
        } else {
            XB_SPIN(xb_ld(&bar[XB_XGEN(b.x)]) == gen, bar);
            __builtin_amdgcn_fence(__ATOMIC_ACQUIRE, "agent");
            asm volatile("s_waitcnt vmcnt(0)" ::: "memory");
        }
    }
    __syncthreads();
}

constexpr int CW_BAR = 4096;
constexpr int MISC_OFF = 131072 + 320;
__global__ void __launch_bounds__(512, 2) fwd_kernel(Args a) {
    extern __shared__ __attribute__((aligned(16))) unsigned char lds_raw[];
    LAS unsigned char* lds = (LAS unsigned char*)lds_raw;
    const int tid = threadIdx.x, lane = tid & 63, wave = __builtin_amdgcn_readfirstlane(tid >> 6);
    const int G = gridDim.x, bid = blockIdx.x;
    unsigned char* ws = a.ws;
    const int lo = a.ph_lo, hi = a.ph_hi;
    cg::grid_group grid = cg::this_grid();
    for (int u = tid; u < (LDS_BYTES - 131072) / 4; u += 512) ((LAS unsigned*)(lds + 131072))[u] = 0u;
    __syncthreads();
    volatile LAS unsigned* MISC = (volatile LAS unsigned*)(lds + MISC_OFF);
    XcdBarrier bar; bar.bar = (unsigned*)(ws + WS_CTL) + CW_BAR; bar.x = 0; bar.st = nullptr;
    if (hi - lo > 1) bar = xcd_barrier_post((unsigned*)(ws + WS_CTL) + CW_BAR, MISC + 8);
    if (lo < 0) grid.sync();
#define IN(k) (lo <= (k) && (k) < hi)
#define SEAM(k) do { if (lo <= (k) && (k) + 1 < hi) xcd_barrier(bar); } while (0)
    bf16* HB = (bf16*)(ws + WS_HB); bf16* C = (bf16*)(ws + WS_C); float* X1 = (float*)(ws + WS_X1); bf16* X1B = (bf16*)(ws + WS_X1B); bf16* Qb = (bf16*)(ws + WS_Q);
    bf16* Ob = (bf16*)(ws + WS_O); bf16* X2B = (bf16*)(ws + WS_X2B); bf16* Fb = (bf16*)(ws + WS_F);
    float* SSQ1 = (float*)(ws + WS_SSQ1); float* SSQ2 = (float*)(ws + WS_SSQ2); float* SSQ3 = (float*)(ws + WS_SSQ3);
    float* SSQ1S = (float*)(ws + WS_SSQS); float* SSQ2S = SSQ1S + NS * 64; float* SSQ3S = SSQ2S + NS * 64;
    LAS float* red = (LAS float*)lds;

    if (IN(0)) { p0_prologue(a, lds, bid, G, tid, lane, wave); }
    SEAM(0);
    if (IN(1)) {
        { pg8::Gemm g{HB, (const bf16*)(ws + WS_WIN), MP, 1536, 1024}; pg8::StaticOrder S; S.init(MP, 1536, G, bid);
          pg8::EpiIn E{(bf16*)(ws + WS_AP), (bf16*)(ws + WS_GLU), a.out + O_PP, a.out + O_CP};
          pg8::gemm_phase<pg8::EpiIn, pg8::StaticOrder, true, true>(lds, g, S, E); }
        { pg8::Gemm g{(const bf16*)(ws + WS_MB), (const bf16*)(ws + WS_WKV), MMEM, 2048, 1024}; pg8::StaticOrder S; S.init(MMEM, 2048, G, (bid + G - (128 % G)) % G);
          pg8::EpiKV E{a.out + O_MK, a.out + O_MV, (bf16*)(ws + WS_KB)};
          pg8::gemm_phase<pg8::EpiKV, pg8::StaticOrder, true, true>(lds, g, S, E); }
        { pg8::Gemm g{(const bf16*)(ws + WS_WKV) + (size_t)1024 * 1024, (const bf16*)(ws + WS_MB), 1024, MMEM, 1024}; pg8::StaticOrder S; S.init(1024, MMEM, G, (bid + G - (192 % G)) % G);
          pg8::EpiPlain E{(bf16*)(ws + WS_VT), 2048};
          pg8::gemm_phase<pg8::EpiPlain, pg8::StaticOrder, true, true>(lds, g, S, E); }
        __syncthreads();
        { SkRaw f{(float*)(ws + WS_US), 1536}; const int ge = G > 32 ? 32 : G, cc = (bid + G - (224 % G)) % G; if (cc < ge) skinny<false>(HB + (size_t)MP * DM, (const bf16*)(ws + WS_WIN), 1024, 96, cc, ge, red, tid, f); }
    }
    SEAM(1);
    if (IN(2)) {
        for (int u = bid; u < 512 + 4; u += G) { if (u < 512) mixer_prompt_unit(a, lds, u, tid, lane, wave); else mixer_sample_unit(a, lds, u - 512, tid, lane, wave); }
    }
    SEAM(2);
    if (IN(3)) {
        { pg8::Gemm g{C, (const bf16*)(ws + WS_WOUT), MP, 1024, 1024}; pg8::StaticOrder S; S.init(MP, 1024, G, bid);
          pg8::EpiRes E{a.in[0], X1, X1B, SSQ1};
          pg8::gemm_phase<pg8::EpiRes, pg8::StaticOrder, false, true>(lds, g, S, E); }
        __syncthreads();
        { SkRes f{a.in[1], X1 + (size_t)MP * DM, X1B + (size_t)MP * DM, SSQ1S}; skinny<false>(C + (size_t)MP * DM, (const bf16*)(ws + WS_WOUT), 1024, 64, bid, G, red, tid, f); }
    }
    SEAM(3);
    if (IN(4)) {
        { pg8::Gemm g{X1B, (const bf16*)(ws + WS_WQ), MP, 1024, 1024}; pg8::StaticOrder S; S.init(MP, 1024, G, bid);
          pg8::EpiQ E{SSQ1, Qb, QSCALE};
          pg8::gemm_phase<pg8::EpiQ, pg8::StaticOrder, false, true>(lds, g, S, E); }
        __syncthreads();
        { SkQ f{SSQ1S, Qb + (size_t)MP * DM}; skinny<false>(X1B + (size_t)MP * DM, (const bf16*)(ws + WS_WQ), 1024, 64, bid, G, red, tid, f); }
    }
    SEAM(4);
    if (IN(5)) {
        for (int u = bid; u < 512; u += G) attn_prompt_unit(a, lds, u, tid, lane, wave);
        __syncthreads();
        for (int u = bid; u < 512; u += G) attn_sample_unit(a, lds, u, tid, lane, wave);
    }
    SEAM(5);
    if (IN(6)) {
        { pg8::Gemm g{Ob, (const bf16*)(ws + WS_WO), MP, 1024, 1024}; pg8::StaticOrder S; S.init(MP, 1024, G, bid);
          pg8::EpiRes E{X1, X1, X2B, SSQ2};
          pg8::gemm_phase<pg8::EpiRes, pg8::StaticOrder, false, true>(lds, g, S, E); }
        __syncthreads();
        { SkRes f{X1 + (size_t)MP * DM, X1 + (size_t)MP * DM, X2B + (size_t)MP * DM, SSQ2S}; skinny<false>(Ob + (size_t)MP * DM, (const bf16*)(ws + WS_WO), 1024, 64, bid, G, red, tid, f); }
    }
    SEAM(6);
    if (IN(7)) {
        { pg8::Gemm g{X2B, (const bf16*)(ws + WS_WGU), MP, FF2, 1024}; pg8::StaticOrder S; S.init(MP, FF2, G, bid);
          pg8::EpiGU E{SSQ2, Fb};
          pg8::gemm_phase<pg8::EpiGU, pg8::StaticOrder, true, true>(lds, g, S, E); }
        __syncthreads();
        { SkGU f{SSQ2S, Fb + (size_t)MP * FF}; const int half = G >= 2 ? G / 2 : 1;
          if (bid >= G - half) skinny<true>(X2B + (size_t)MP * DM, (const bf16*)(ws + WS_WGU), 1024, 176, bid - (G - half), half, red, tid, f); }
    }
    SEAM(7);
    if (IN(8)) {
        { pg8::Gemm g{Fb, (const bf16*)(ws + WS_WD), MP, 1024, FF}; pg8::StaticOrder S; S.init(MP, 1024, G, bid);
          pg8::EpiRes E{X1, a.out + O_Y, nullptr, SSQ3};
          pg8::gemm_phase<pg8::EpiRes, pg8::StaticOrder, false, true>(lds, g, S, E); }
        __syncthreads();
        { SkRes f{X1 + (size_t)MP * DM, a.out + O_YS, nullptr, SSQ3S}; skinny<false>(Fb + (size_t)MP * FF, (const bf16*)(ws + WS_WD), FF, 64, bid, G, red, tid, f); }
    }
    SEAM(8);
    if (IN(9)) {
        const int gw = bid * 8 + wave, NGW = G * 8;
        const f32x4* gf = (const f32x4*)a.in[27] + lane;
        for (int m = gw; m < MALL; m += NGW) {
            float* xrow; float ssum;
            if (m < MP) { xrow = a.out + O_Y + (size_t)m * DM; const float v = (lane < 16) ? SSQ3[(size_t)m * 16 + lane] : 0.f; ssum = wave_sum(v); }
            else { xrow = a.out + O_YS + (size_t)(m - MP) * DM; ssum = wave_sum(SSQ3S[(m - MP) * 64 + lane]); }
            const float rstd = 1.0f / sqrtf(ssum * (1.0f / DM) + EPS);
            f32x4* xr = (f32x4*)xrow + lane;
#pragma unroll
            for (int j = 0; j < 4; ++j) { const f32x4 v = xr[64 * j]; xr[64 * j] = v * rstd * gf[64 * j]; }
        }
    }
#undef IN
#undef SEAM
}

#ifndef MK_MULTI
#define MK_MULTI 0
#endif
extern "C" void kernel_launch(void* const* d_in, const int* in_sizes, int n_in, void* d_out, int out_size, void* d_ws, size_t ws_size, hipStream_t stream) {
    static int grid = 0;
    if (grid == 0) {
        if (n_in != 28 || ws_size < WS_END) { fprintf(stderr, "kernel_launch: unexpected n_in %d / ws_size %zu\n", n_in, ws_size); grid = -1; return; }
        int dev = 0, cus = 0, per_cu = 0;
        (void)hipGetDevice(&dev); (void)hipDeviceGetAttribute(&cus, hipDeviceAttributeMultiprocessorCount, dev);
        if (hipFuncSetAttribute((const void*)fwd_kernel, hipFuncAttributeMaxDynamicSharedMemorySize, LDS_BYTES) != hipSuccess) { fprintf(stderr, "kernel_launch: hipFuncSetAttribute failed\n"); grid = -1; return; }
        if (hipOccupancyMaxActiveBlocksPerMultiprocessor(&per_cu, (const void*)fwd_kernel, 512, LDS_BYTES) != hipSuccess || per_cu < 1) { fprintf(stderr, "kernel_launch: occupancy query says %d\n", per_cu); per_cu = 1; }
        (void)hipGetLastError();
        grid = cus;
    }
    if (grid < 0) return;
    (void)hipMemsetAsync((char*)d_ws + WS_CTL, 0, CTL_ZERO_BYTES, stream);
    Args a{};
    for (int i = 0; i < 28; ++i) a.in[i] = (const float*)d_in[i];
    a.out = (float*)d_out; a.ws = (unsigned char*)d_ws;
#if MK_MULTI
    for (int p = 0; p < NPHASE; ++p) { a.ph_lo = p; a.ph_hi = p + 1; hipLaunchKernelGGL(fwd_kernel, dim3(grid), dim3(512), LDS_BYTES, stream, a); }
#else
    a.ph_lo = 0; a.ph_hi = NPHASE;
    void* args[] = {&a};
    hipError_t e = hipLaunchCooperativeKernel((const void*)fwd_kernel, dim3(grid), dim3(512), args, LDS_BYTES, stream);
    if (e != hipSuccess) fprintf(stderr, "cooperative launch failed: %s (grid %d)\n", hipGetErrorString(e), grid);
#endif
}
```

```cpp
#include <hip/hip_runtime.h>
#include <hip/hip_cooperative_groups.h>
#include <cstdio>
#include <cstdint>
namespace cg = cooperative_groups;
namespace pg8 {
#define PG8_LAS __attribute__((address_space(3)))
typedef unsigned short bf16_t;
typedef short bf16x8 __attribute__((ext_vector_type(8)));
typedef float f32x4 __attribute__((ext_vector_type(4)));
typedef unsigned u32x4 __attribute__((ext_vector_type(4)));
constexpr int BM = 256, BK = 64, HALF = 128, HTB = HALF * BK * 2  , STAGE_BYTES = 8 * HTB, NXCD = 8, WGM = 8;

__host__ __device__ __forceinline__ int lds_byte(int r, int c) { const int st = (r >> 4) * 2 + (c >> 5), rr = r & 15, cc = c & 31, ob = rr * 64 + cc * 2; return st * 1024 + (ob ^ (((ob >> 9) & 1) << 5)); }
__host__ __device__ __forceinline__ void stage_rc(int b, int& R, int& C) { const int st = b / 1024, sb = b % 1024, swz = sb ^ (((sb >> 9) & 1) << 5); R = (st >> 1) * 16 + swz / 64; C = (st & 1) * 32 + (swz % 64) / 2; }
__host__ __device__ __forceinline__ int perm32(int rho) { const int n = rho >> 4, i = rho & 15; return 8 * (i >> 2) + 4 * n + (i & 3); }

struct Unit { int pm, pn; };
struct Gemm { const bf16_t* A; const bf16_t* Bt; int M, N, K; };

struct StaticOrder {
    int nM, nN, nwg, G, c;
    __host__ __device__ void init(int M, int N, int G_, int c_) { nM = M / BM; nN = N / BM; nwg = nM * nN; G = G_; c = c_; }
    __host__ __device__ bool next(int i, Unit& u) const {
        const long L = (long)i * G + c; if (L >= nwg) return false;
        int wgid = (int)L; { const int q = nwg / NXCD, r = nwg % NXCD, xcd = wgid % NXCD, off = wgid / NXCD; wgid = (xcd < r ? xcd * (q + 1) : r * (q + 1) + (xcd - r) * q) + off; }
        const int nig = WGM * nN, gid = wgid / nig, fm = gid * WGM, gsz = (nM - fm) < WGM ? (nM - fm) : WGM;
        u.pm = fm + ((wgid % nig) % gsz); u.pn = (wgid % nig) / gsz; return true;
    }
    __device__ __forceinline__ void a_ready(const Unit&) const {}
    __device__ __forceinline__ void done(const Unit&) const {}
};
typedef unsigned u32x4 __attribute__((ext_vector_type(4)));
constexpr float EPSF = 1e-6f;
__device__ __forceinline__ unsigned cvt_pk_bf16(float lo, float hi) { unsigned r; asm volatile("v_cvt_pk_bf16_f32 %0, %1, %2" : "=v"(r) : "v"(lo), "v"(hi)); return r; }
__device__ __forceinline__ u32x4 pack8(const f32x4 a, const f32x4 b) { u32x4 w; w.x = cvt_pk_bf16(a[0], a[1]); w.y = cvt_pk_bf16(a[2], a[3]); w.z = cvt_pk_bf16(b[0], b[1]); w.w = cvt_pk_bf16(b[2], b[3]); return w; }
__device__ __forceinline__ float sigm(float x) { return __builtin_amdgcn_rcpf(1.0f + __builtin_amdgcn_exp2f(-1.4426950408889634f * x)); }
__device__ __forceinline__ float rstd16(const float* p) {
    const f32x4 a = ((const f32x4*)p)[0], b = ((const f32x4*)p)[1], c = ((const f32x4*)p)[2], d = ((const f32x4*)p)[3];
    const float s = ((a[0] + a[1]) + (a[2] + a[3])) + ((b[0] + b[1]) + (b[2] + b[3])) + ((c[0] + c[1]) + (c[2] + c[3])) + ((d[0] + d[1]) + (d[2] + d[3]));
    return 1.0f / sqrtf(s * (1.0f / 1024.0f) + EPSF);
}
struct EpiIn {
    static constexpr bool PERM = true, AFTER_DRAIN = false;
    bf16_t* AP; bf16_t* GLU; float* outPP; float* outCP;
    __device__ __forceinline__ void operator()(const f32x4 (&acc)[2][2][4][2], const Unit& u, int wr, int wc, int fr, int fq) const {
        const int row0 = u.pm * BM + wr * 64 + fr, cl = wc * 32 + 8 * fq;
        if (u.pn < 2) {
#pragma unroll
            for (int ai = 0; ai < 2; ++ai)
#pragma unroll
                for (int m = 0; m < 4; ++m) { const int row = row0 + ai * HALF + m * 16, t = row & 2047, b = row >> 11;
#pragma unroll
                    for (int bj = 0; bj < 2; ++bj) { const int col = u.pn * 256 + bj * HALF + cl; const f32x4 v0 = acc[ai][bj][m][0], v1 = acc[ai][bj][m][1];
                        *(u32x4*)(AP + (size_t)row * 512 + col) = pack8(v0, v1);
                        if (t >= 2033) { float* o = outPP + ((size_t)(b * 15 + t - 2033) * 512 + col); *(f32x4*)o = v0; *(f32x4*)(o + 4) = v1; } } }
        } else {
            const int ch = (u.pn - 2) * 128 + cl;
#pragma unroll
            for (int ai = 0; ai < 2; ++ai)
#pragma unroll
                for (int m = 0; m < 4; ++m) { const int row = row0 + ai * HALF + m * 16, t = row & 2047, b = row >> 11;
                    f32x4 o0, o1;
#pragma unroll
                    for (int j = 0; j < 4; ++j) { o0[j] = acc[ai][0][m][0][j] * sigm(acc[ai][1][m][0][j]); o1[j] = acc[ai][0][m][1][j] * sigm(acc[ai][1][m][1][j]); }
                    *(u32x4*)(GLU + (size_t)row * 512 + ch) = pack8(o0, o1);
                    if (t >= 2018) { float* o = outCP + ((size_t)(b * 30 + t - 2018) * 512 + ch); *(f32x4*)o = o0; *(f32x4*)(o + 4) = o1; } }
        }
    }
};
struct EpiKV {
    static constexpr bool PERM = true, AFTER_DRAIN = false;
    float* outK; float* outV; bf16_t* KB;
    __device__ __forceinline__ void operator()(const f32x4 (&acc)[2][2][4][2], const Unit& u, int wr, int wc, int fr, int fq) const {
        const int row0 = u.pm * BM + wr * 64 + fr, cl = wc * 32 + 8 * fq;
#pragma unroll
        for (int ai = 0; ai < 2; ++ai)
#pragma unroll
            for (int m = 0; m < 4; ++m) { const int row = row0 + ai * HALF + m * 16;
#pragma unroll
                for (int bj = 0; bj < 2; ++bj) { const int col = u.pn * 256 + bj * HALF + cl; const f32x4 v0 = acc[ai][bj][m][0], v1 = acc[ai][bj][m][1];
                    if (u.pn < 4) { float* o = outK + (size_t)row * 1024 + col; *(f32x4*)o = v0; *(f32x4*)(o + 4) = v1; *(u32x4*)(KB + (size_t)row * 1024 + col) = pack8(v0, v1); }
                    else { float* o = outV + (size_t)row * 1024 + (col - 1024); *(f32x4*)o = v0; *(f32x4*)(o + 4) = v1; } } }
    }
};
struct EpiPlain {
    static constexpr bool PERM = true, AFTER_DRAIN = false;
    bf16_t* O; int ldc;
    __device__ __forceinline__ void operator()(const f32x4 (&acc)[2][2][4][2], const Unit& u, int wr, int wc, int fr, int fq) const {
        const int row0 = u.pm * BM + wr * 64 + fr, cl = wc * 32 + 8 * fq;
#pragma unroll
        for (int ai = 0; ai < 2; ++ai)
#pragma unroll
            for (int m = 0; m < 4; ++m) { const int row = row0 + ai * HALF + m * 16;
#pragma unroll
                for (int bj = 0; bj < 2; ++bj) { const int col = u.pn * 256 + bj * HALF + cl; *(u32x4*)(O + (size_t)row * ldc + col) = pack8(acc[ai][bj][m][0], acc[ai][bj][m][1]); } }
    }
};
template <bool RES_BF16> struct EpiRes {
    static constexpr bool PERM = true, AFTER_DRAIN = false;
    const void* resid; bf16_t* xb; float* ssq;
    __device__ __forceinline__ void operator()(const f32x4 (&acc)[2][2][4][2], const Unit& u, int wr, int wc, int fr, int fq) const {
        const int row0 = u.pm * BM + wr * 64 + fr, cl = wc * 32 + 8 * fq;
#pragma unroll
        for (int ai = 0; ai < 2; ++ai)
#pragma unroll
            for (int m = 0; m < 4; ++m) { const int row = row0 + ai * HALF + m * 16; float ss = 0.f;
#pragma unroll
                for (int bj = 0; bj < 2; ++bj) { const size_t off = (size_t)row * 1024 + u.pn * 256 + bj * HALF + cl;
                    f32x4 r0, r1;
                    if (RES_BF16) { const u32x4 w = *(const u32x4*)((const bf16_t*)resid + off);
                        r0 = (f32x4){__builtin_bit_cast(float, w.x << 16), __builtin_bit_cast(float, w.x & 0xffff0000u), __builtin_bit_cast(float, w.y << 16), __builtin_bit_cast(float, w.y & 0xffff0000u)};
                        r1 = (f32x4){__builtin_bit_cast(float, w.z << 16), __builtin_bit_cast(float, w.z & 0xffff0000u), __builtin_bit_cast(float, w.w << 16), __builtin_bit_cast(float, w.w & 0xffff0000u)}; }
                    else { r0 = *(const f32x4*)((const float*)resid + off); r1 = *(const f32x4*)((const float*)resid + off + 4); }
                    const f32x4 x0 = r0 + acc[ai][bj][m][0], x1 = r1 + acc[ai][bj][m][1];
                    *(u32x4*)(xb + off) = pack8(x0, x1);
                    ss += ((x0[0] * x0[0] + x0[1] * x0[1]) + (x0[2] * x0[2] + x0[3] * x0[3])) + ((x1[0] * x1[0] + x1[1] * x1[1]) + (x1[2] * x1[2] + x1[3] * x1[3])); }
                ss += __shfl_xor(ss, 16); ss += __shfl_xor(ss, 32);
                if (fq == 0) ssq[(size_t)row * 16 + u.pn * 4 + wc] = ss; }
    }
};
struct EpiQ {
    static constexpr bool PERM = true, AFTER_DRAIN = false;
    const float* ssq; bf16_t* Q; float scale;
    __device__ __forceinline__ void operator()(const f32x4 (&acc)[2][2][4][2], const Unit& u, int wr, int wc, int fr, int fq) const {
        const int row0 = u.pm * BM + wr * 64 + fr, cl = wc * 32 + 8 * fq;
#pragma unroll
        for (int ai = 0; ai < 2; ++ai)
#pragma unroll
            for (int m = 0; m < 4; ++m) { const int row = row0 + ai * HALF + m * 16; const float rs = rstd16(ssq + (size_t)row * 16) * scale;
#pragma unroll
                for (int bj = 0; bj < 2; ++bj) { const size_t off = (size_t)row * 1024 + u.pn * 256 + bj * HALF + cl;
                    *(u32x4*)(Q + off) = pack8(acc[ai][bj][m][0] * rs, acc[ai][bj][m][1] * rs); } }
    }
};
struct EpiGU {
    static constexpr bool PERM = true, AFTER_DRAIN = false;
    const float* ssq; bf16_t* F;
    __device__ __forceinline__ void operator()(const f32x4 (&acc)[2][2][4][2], const Unit& u, int wr, int wc, int fr, int fq) const {
        const int row0 = u.pm * BM + wr * 64 + fr, cl = wc * 32 + 8 * fq;
#pragma unroll
        for (int ai = 0; ai < 2; ++ai)
#pragma unroll
            for (int m = 0; m < 4; ++m) { const int row = row0 + ai * HALF + m * 16; const float rs = rstd16(ssq + (size_t)row * 16);
                f32x4 o0, o1;
#pragma unroll
                for (int j = 0; j < 4; ++j) { const float g0 = acc[ai][0][m][0][j] * rs, g1 = acc[ai][0][m][1][j] * rs;
                    o0[j] = g0 * sigm(g0) * (acc[ai][1][m][0][j] * rs); o1[j] = g1 * sigm(g1) * (acc[ai][1][m][1][j] * rs); }
                *(u32x4*)(F + (size_t)row * 2816 + u.pn * 128 + cl) = pack8(o0, o1); }
    }
};
template <class Epi, class Sched, bool ALIGN_EPI = false, bool SP2 = false>
__device__ __forceinline__ void gemm_phase(PG8_LAS unsigned char* lds, const Gemm g, const Sched& S, const Epi& E) {
    const int tid = threadIdx.x, wid = __builtin_amdgcn_readfirstlane(tid >> 6), lane = tid & 63, wr = wid >> 2, wc = wid & 3, fr = lane & 15, fq = lane >> 4;
    const int K = g.K, nt = K / BK;
    unsigned voffA[2], voffB[2];
#pragma unroll
    for (int i = 0; i < 2; ++i) { int R, C; stage_rc(tid * 16 + i * 8192, R, C); const int Rb = Epi::PERM ? ((R & ~31) + perm32(R & 31)) : R;
        voffA[i] = (unsigned)(R * K + C) * 2u; voffB[i] = (unsigned)(Rb * K + C) * 2u; }
    const size_t kstep = (size_t)(BK * 2);
    const size_t hstep = (size_t)HALF * K * 2;
    const size_t tstep = 2 * hstep;
    const unsigned ldsw = (unsigned)wid * 1024u;
    const int aoff = lds_byte(wr * 64 + fr, fq * 8), boff = lds_byte(wc * 32 + fr, fq * 8);
#define PG8_SA(b, h) (((b) * 2 + (h)) * HTB)
#define PG8_SB(b, h) ((4 + (b) * 2 + (h)) * HTB)
#define PG8_STAGE(bufoff, gbase, voff) do { _Pragma("unroll") for (int _i = 0; _i < 2; ++_i) \
        __builtin_amdgcn_global_load_lds((const unsigned*)((const char*)(gbase) + (voff)[_i]), (PG8_LAS unsigned*)(lds + (bufoff) + ldsw + _i * 8192), 16, 0, 0); } while (0)
#define PG8_LDA(dst, b, h) do { _Pragma("unroll") for (int m = 0; m < 4; ++m) _Pragma("unroll") for (int k = 0; k < 2; ++k) dst[m][k] = *(const PG8_LAS bf16x8*)(lds + PG8_SA(b, h) + aoff + m * 2048 + k * 1024); } while (0)
#define PG8_LDB(dst, b, h) do { _Pragma("unroll") for (int n = 0; n < 2; ++n) _Pragma("unroll") for (int k = 0; k < 2; ++k) dst[n][k] = *(const PG8_LAS bf16x8*)(lds + PG8_SB(b, h) + boff + n * 2048 + k * 1024); } while (0)
#define PG8_MMA(ai, bj, At, Bt) do { __builtin_amdgcn_s_setprio(1); _Pragma("unroll") for (int m = 0; m < 4; ++m) _Pragma("unroll") for (int n = 0; n < 2; ++n) _Pragma("unroll") for (int k = 0; k < 2; ++k) \
        acc[ai][bj][m][n] = __builtin_amdgcn_mfma_f32_16x16x32_bf16(Bt[n][k], At[m][k], acc[ai][bj][m][n], 0, 0, 0); __builtin_amdgcn_s_setprio(0); } while (0)
#define PG8_WAIT_V(n) asm volatile("s_waitcnt vmcnt(" #n ")" ::: "memory")
#define PG8_WAIT_L(n) asm volatile("s_waitcnt lgkmcnt(" #n ")" ::: "memory")
#define PG8_BAR __builtin_amdgcn_s_barrier()
#define PG8_SCHED __builtin_amdgcn_sched_barrier(0)
    Unit cur, nxt; int ui = 0;
    if (!S.next(0, cur)) return;
    f32x4 acc[2][2][4][2];
#pragma unroll
    for (int a = 0; a < 2; ++a)
#pragma unroll
        for (int b = 0; b < 2; ++b)
#pragma unroll
            for (int m = 0; m < 4; ++m)
#pragma unroll
                for (int n = 0; n < 2; ++n) acc[a][b][m][n] = (f32x4){0.f, 0.f, 0.f, 0.f};
    bf16x8 At[4][2], B0[2][2], B1[2][2];
    const char* cA = (const char*)g.A + (size_t)cur.pm * tstep; const char* cB = (const char*)g.Bt + (size_t)cur.pn * tstep;
    S.a_ready(cur);
    if constexpr (SP2) {
        PG8_STAGE(PG8_SB(0, 0), cB, voffB); PG8_STAGE(PG8_SB(0, 1), cB + hstep, voffB); PG8_STAGE(PG8_SA(0, 0), cA, voffA); PG8_STAGE(PG8_SA(0, 1), cA + hstep, voffA);
        if (wr == 1) PG8_BAR;
        PG8_WAIT_V(2); PG8_BAR;
        PG8_STAGE(PG8_SB(1, 0), cB + kstep, voffB); PG8_STAGE(PG8_SA(1, 0), cA + kstep, voffA); PG8_STAGE(PG8_SB(1, 1), cB + hstep + kstep, voffB);
        PG8_WAIT_V(6); PG8_BAR;
    } else {
        PG8_STAGE(PG8_SB(0, 0), cB, voffB); PG8_STAGE(PG8_SA(0, 0), cA, voffA); PG8_STAGE(PG8_SB(0, 1), cB + hstep, voffB); PG8_STAGE(PG8_SA(0, 1), cA + hstep, voffA);
        if (wr == 1) PG8_BAR;
        PG8_WAIT_V(4); PG8_BAR;
        PG8_STAGE(PG8_SB(1, 0), cB + kstep, voffB); PG8_STAGE(PG8_SA(1, 0), cA + kstep, voffA); PG8_STAGE(PG8_SB(1, 1), cB + hstep + kstep, voffB);
        PG8_WAIT_V(6); PG8_BAR;
    }
    for (;;) {
        const bool has_next = S.next(ui + 1, nxt);
        const char* nA = has_next ? (const char*)g.A + (size_t)nxt.pm * tstep : cA; const char* nB = has_next ? (const char*)g.Bt + (size_t)nxt.pn * tstep : cB;
        for (int t = 0; t < nt; t += 2) {
            const bool last = (t == nt - 2);
            const char* a1 = cA + (size_t)(t + 1) * kstep;
            const char* a2 = last ? nA : cA + (size_t)(t + 2) * kstep; const char* b2 = last ? nB : cB + (size_t)(t + 2) * kstep;
            const char* a3 = a2 + kstep; const char* b3 = b2 + kstep;
            if (last && has_next) S.a_ready(nxt);
            if constexpr (SP2) {
            PG8_LDB(B0, 0, 0); PG8_LDB(B1, 0, 1); PG8_SCHED; PG8_LDA(At, 0, 0); PG8_STAGE(PG8_SA(1, 1), a1 + hstep, voffA);
            PG8_WAIT_V(8); PG8_WAIT_L(0); PG8_BAR; PG8_MMA(0, 0, At, B0); PG8_MMA(0, 1, At, B1); PG8_BAR; PG8_SCHED;
            PG8_LDA(At, 0, 1); PG8_STAGE(PG8_SB(0, 0), b2, voffB); PG8_STAGE(PG8_SB(0, 1), b2 + hstep, voffB); PG8_STAGE(PG8_SA(0, 0), a2, voffA);
            PG8_WAIT_V(8); PG8_WAIT_L(0); PG8_BAR; PG8_MMA(1, 0, At, B0); PG8_MMA(1, 1, At, B1); PG8_BAR; PG8_SCHED;
            PG8_LDB(B0, 1, 0); PG8_LDB(B1, 1, 1); PG8_SCHED; PG8_LDA(At, 1, 0); PG8_STAGE(PG8_SA(0, 1), a2 + hstep, voffA);
            PG8_WAIT_V(8); PG8_WAIT_L(0); PG8_BAR; PG8_MMA(0, 0, At, B0); PG8_MMA(0, 1, At, B1); PG8_BAR; PG8_SCHED;
            PG8_LDA(At, 1, 1); PG8_STAGE(PG8_SB(1, 0), b3, voffB); PG8_STAGE(PG8_SB(1, 1), b3 + hstep, voffB); PG8_STAGE(PG8_SA(1, 0), a3, voffA);
            PG8_WAIT_V(8); PG8_WAIT_L(0); PG8_BAR; PG8_MMA(1, 0, At, B0); PG8_MMA(1, 1, At, B1); PG8_BAR; PG8_SCHED;
            } else {
            PG8_LDB(B0, 0, 0); PG8_SCHED; PG8_LDA(At, 0, 0); PG8_STAGE(PG8_SA(1, 1), a1 + hstep, voffA);
            PG8_WAIT_L(8); PG8_BAR; PG8_WAIT_L(0); PG8_MMA(0, 0, At, B0); PG8_BAR; PG8_SCHED;
            PG8_LDB(B1, 0, 1); PG8_STAGE(PG8_SB(0, 0), b2, voffB);
            PG8_BAR; PG8_WAIT_L(0); PG8_MMA(0, 1, At, B1); PG8_BAR;
            PG8_LDA(At, 0, 1); PG8_STAGE(PG8_SA(0, 0), a2, voffA);
            PG8_BAR; PG8_WAIT_L(0); PG8_MMA(1, 0, At, B0); PG8_BAR; PG8_SCHED;
            PG8_STAGE(PG8_SB(0, 1), b2 + hstep, voffB);
            PG8_WAIT_V(6); PG8_BAR; PG8_MMA(1, 1, At, B1); PG8_BAR;
            PG8_LDB(B0, 1, 0); PG8_SCHED; PG8_LDA(At, 1, 0); PG8_STAGE(PG8_SA(0, 1), a2 + hstep, voffA);
            PG8_WAIT_L(8); PG8_BAR; PG8_WAIT_L(0); PG8_MMA(0, 0, At, B0); PG8_BAR; PG8_SCHED;
            PG8_LDB(B1, 1, 1); PG8_STAGE(PG8_SB(1, 0), b3, voffB);
            PG8_BAR; PG8_WAIT_L(0); PG8_MMA(0, 1, At, B1); PG8_BAR;
            PG8_LDA(At, 1, 1); PG8_STAGE(PG8_SA(1, 0), a3, voffA);
            PG8_BAR; PG8_WAIT_L(0); PG8_MMA(1, 0, At, B0); PG8_BAR; PG8_SCHED;
            PG8_STAGE(PG8_SB(1, 1), b3 + hstep, voffB);
            PG8_WAIT_V(6); PG8_BAR; PG8_MMA(1, 1, At, B1); PG8_BAR;
            }
        }
        if constexpr (ALIGN_EPI) { if (wr == 0) PG8_BAR; }
        if constexpr (!Epi::AFTER_DRAIN) { E(acc, cur, wr, wc, fr, fq); S.done(cur); }
        if (!has_next) break;
#pragma unroll
        for (int a = 0; a < 2; ++a)
#pragma unroll
            for (int b = 0; b < 2; ++b)
#pragma unroll
                for (int m = 0; m < 4; ++m)
#pragma unroll
                    for (int n = 0; n < 2; ++n) acc[a][b][m][n] = (f32x4){0.f, 0.f, 0.f, 0.f};
        cur = nxt; cA = nA; cB = nB; ++ui;
        if constexpr (ALIGN_EPI) { if (wr == 1) PG8_BAR; }
    }
    PG8_WAIT_V(0);
    if constexpr (!ALIGN_EPI) { if (wr == 0) PG8_BAR; }
    PG8_BAR;
    if constexpr (Epi::AFTER_DRAIN) { E.fused(acc, cur, wr, wc, fr, fq, lds, wid, lane); S.done(cur); }
#undef PG8_SA
#undef PG8_SB
#undef PG8_STAGE
#undef PG8_LDA
#undef PG8_LDB
#undef PG8_MMA
#undef PG8_WAIT_V
#undef PG8_WAIT_L
#undef PG8_BAR
#undef PG8_SCHED
}
}

#define LAS __attribute__((address_space(3)))
typedef unsigned short bf16;
typedef float f32x4 __attribute__((ext_vector_type(4)));
typedef short bf16x8 __attribute__((ext_vector_type(8)));
typedef unsigned u32x4 __attribute__((ext_vector_type(4)));
typedef unsigned u32x2 __attribute__((ext_vector_type(2)));
constexpr int DM = 1024, NB = 8, SEQ = 2048, MP = NB * SEQ, NS = 128, MALL = MP + NS, NMEM = 256, FF = 2816, FF2 = 5632, MMEM = NB * NMEM;
constexpr float EPS = 1e-6f;
constexpr float QSCALE = 0.0625f * 1.4426950408889634f;
constexpr size_t O_Y = 0, O_YS = 16777216, O_PP = O_YS + 131072, O_PS = O_PP + 61440, O_CP = O_PS + 983040, O_CS = O_CP + 122880, O_MK = O_CS + 1966080, O_MV = O_MK + 2097152;
constexpr size_t MiB = 1u << 20;
constexpr size_t WS_CTL = 0, CTL_ZERO_BYTES = MiB;
constexpr size_t WS_WIN = 1 * MiB, WS_WKV = 4 * MiB, WS_WOUT = 8 * MiB, WS_WQ = 10 * MiB, WS_WO = 12 * MiB, WS_WGU = 14 * MiB, WS_WD = 25 * MiB, WS_WMAP = 31 * MiB;
constexpr size_t WS_HB = 32 * MiB, WS_AP = 65 * MiB, WS_GLU = 82 * MiB, WS_C = 99 * MiB, WS_X1 = 132 * MiB, WS_X1B = 197 * MiB, WS_Q = 230 * MiB, WS_KB = 263 * MiB, WS_VT = 267 * MiB;
constexpr size_t WS_O = 271 * MiB, WS_X2B = 304 * MiB, WS_F = 337 * MiB, WS_MB = 426 * MiB, WS_SSQ1 = 430 * MiB, WS_SSQ2 = 431 * MiB, WS_SSQ3 = 432 * MiB, WS_SSQS = 433 * MiB, WS_US = 434 * MiB, WS_HC = 435 * MiB;
constexpr size_t WS_HP = WS_HC + 512 * 1024, WS_END = 436 * MiB;
constexpr int LDS_BYTES = 147456;
constexpr int NPHASE = 10;

__device__ __forceinline__ float wave_sum(float v) {
#pragma unroll
    for (int o = 1; o < 64; o <<= 1) v += __shfl_xor(v, o);
    return v;
}
__device__ __forceinline__ float wave_max(float v) {
#pragma unroll
    for (int o = 1; o < 64; o <<= 1) v = fmaxf(v, __shfl_xor(v, o));
    return v;
}
__device__ __forceinline__ unsigned f2bf(float f) { unsigned u = __builtin_bit_cast(unsigned, f); return (u + 0x7fffu + ((u >> 16) & 1u)) >> 16; }
__device__ __forceinline__ unsigned pk2(float lo, float hi) { return f2bf(lo) | (f2bf(hi) << 16); }
__device__ __forceinline__ float bf2f(bf16 v) { return __builtin_bit_cast(float, (unsigned)v << 16); }
__device__ __forceinline__ float sigm(float x) { return __builtin_amdgcn_rcpf(1.0f + __builtin_amdgcn_exp2f(-1.4426950408889634f * x)); }
#define LDS_WAIT() asm volatile("s_waitcnt lgkmcnt(0)" ::: "memory")

__device__ __forceinline__ void transpose_item(const float* W, int K, int N, const float* gk, bf16* WT, int dst_row0, LAS float* scr, int k0, int n0, int lane) {
    f32x4 v[8];
#pragma unroll
    for (int i = 0; i < 8; ++i) { const int kk = (lane >> 3) + 8 * i; v[i] = *(const f32x4*)(W + (size_t)(k0 + kk) * N + n0 + 4 * (lane & 7)); }
    if (gk) {
#pragma unroll
        for (int i = 0; i < 8; ++i) v[i] = v[i] * gk[k0 + (lane >> 3) + 8 * i]; }
#pragma unroll
    for (int i = 0; i < 8; ++i) { LAS float* d = scr + ((lane >> 3) + 8 * i) * 33 + 4 * (lane & 7); d[0] = v[i].x; d[1] = v[i].y; d[2] = v[i].z; d[3] = v[i].w; }
    LDS_WAIT();
    const int c = lane & 7;
#pragma unroll
    for (int j = 0; j < 4; ++j) { const int n = (lane >> 3) + 8 * j; const LAS float* s = scr + (8 * c) * 33 + n;
        u32x4 o; o.x = pk2(s[0 * 33], s[1 * 33]); o.y = pk2(s[2 * 33], s[3 * 33]); o.z = pk2(s[4 * 33], s[5 * 33]); o.w = pk2(s[6 * 33], s[7 * 33]);
        *(u32x4*)(WT + (size_t)(dst_row0 + n) * K + k0 + 8 * c) = o; }
    LDS_WAIT();
}
__device__ __forceinline__ void rms_load(const float* xrow, int lane, f32x4 (&v)[4]) {
    const f32x4* xr = (const f32x4*)xrow + lane;
#pragma unroll
    for (int j = 0; j < 4; ++j) v[j] = xr[64 * j];
}
__device__ __forceinline__ void rms_finish(const f32x4 (&v)[4], const float* g, bf16* orow, int lane) {
    const f32x4* gr = (const f32x4*)g + lane; float s = 0.f;
#pragma unroll
    for (int j = 0; j < 4; ++j) s += (v[j].x * v[j].x + v[j].y * v[j].y) + (v[j].z * v[j].z + v[j].w * v[j].w);
    const float rstd = 1.0f / sqrtf(wave_sum(s) * (1.0f / DM) + EPS);
    unsigned long long* o8 = (unsigned long long*)orow + lane;
#pragma unroll
    for (int j = 0; j < 4; ++j) { const f32x4 gg = gr[64 * j]; const f32x4 o = v[j] * rstd * gg;
        o8[64 * j] = (unsigned long long)pk2(o.x, o.y) | ((unsigned long long)pk2(o.z, o.w) << 32); }
}

struct Args { const float* in[28]; float* out; unsigned char* ws; int ph_lo, ph_hi; };

__device__ __forceinline__ void p0_prologue(const Args& a, LAS unsigned char* lds, int bid, int G, int tid, int lane, int wave) {
    unsigned char* ws = a.ws;
    LAS float* scr = (LAS float*)(lds + wave * 16384);
    const int gw = bid * 8 + wave, NGW = G * 8;
    constexpr int I_IN = 16 * 48, I_SQ = 16 * 32, I_GU = 16 * 88, I_D = 44 * 32, I_PM = 2 * 4;
    constexpr int NITEMS = I_IN + 5 * I_SQ + 2 * I_GU + I_D + 4 * I_PM;
    for (int it = gw; it < NITEMS; it += NGW) {
        int r = it;
        if (r < I_IN) { const int kb = r / 48, n0 = (r % 48) * 32; int dr;
            if (n0 < 512) dr = n0; else { int j = n0 - 512; int hi = 0; if (j >= 512) { j -= 512; hi = 128; } dr = 512 + (j >> 7) * 256 + hi + (j & 127); }
            transpose_item(a.in[8], 1024, 1536, nullptr, (bf16*)(ws + WS_WIN), dr, scr, 64 * kb, n0, lane); continue; } r -= I_IN;
        if (r < I_SQ) { transpose_item(a.in[20], 1024, 1024, nullptr, (bf16*)(ws + WS_WKV), (r % 32) * 32, scr, 64 * (r / 32), (r % 32) * 32, lane); continue; } r -= I_SQ;
        if (r < I_SQ) { transpose_item(a.in[21], 1024, 1024, nullptr, (bf16*)(ws + WS_WKV), 1024 + (r % 32) * 32, scr, 64 * (r / 32), (r % 32) * 32, lane); continue; } r -= I_SQ;
        if (r < I_SQ) { transpose_item(a.in[16], 1024, 1024, nullptr, (bf16*)(ws + WS_WOUT), (r % 32) * 32, scr, 64 * (r / 32), (r % 32) * 32, lane); continue; } r -= I_SQ;
        if (r < I_SQ) { transpose_item(a.in[19], 1024, 1024, a.in[17], (bf16*)(ws + WS_WQ), (r % 32) * 32, scr, 64 * (r / 32), (r % 32) * 32, lane); continue; } r -= I_SQ;
        if (r < I_SQ) { transpose_item(a.in[22], 1024, 1024, nullptr, (bf16*)(ws + WS_WO), (r % 32) * 32, scr, 64 * (r / 32), (r % 32) * 32, lane); continue; } r -= I_SQ;
        if (r < I_GU) { const int n0 = (r % 88) * 32; transpose_item(a.in[24], 1024, FF, a.in[23], (bf16*)(ws + WS_WGU), (n0 >> 7) * 256 + (n0 & 127), scr, 64 * (r / 88), n0, lane); continue; } r -= I_GU;
        if (r < I_GU) { const int n0 = (r % 88) * 32; transpose_item(a.in[25], 1024, FF, a.in[23], (bf16*)(ws + WS_WGU), (n0 >> 7) * 256 + 128 + (n0 & 127), scr, 64 * (r / 88), n0, lane); continue; } r -= I_GU;
        if (r < I_D) { transpose_item(a.in[26], FF, 1024, nullptr, (bf16*)(ws + WS_WD), (r % 32) * 32, scr, 64 * (r / 32), (r % 32) * 32, lane); continue; } r -= I_D;
        { const int g = r / I_PM, q = r % I_PM; transpose_item(a.in[9] + (size_t)g * 16384, 128, 128, nullptr, (bf16*)(ws + WS_WMAP) + (size_t)g * 16384, (q % 4) * 32, scr, 64 * (q / 4), (q % 4) * 32, lane); }
    }
#define ROW_SRC(m) ((m) < MP ? a.in[0] + (size_t)(m) * DM : ((m) < MALL ? a.in[1] + (size_t)((m) - MP) * DM : a.in[2] + (size_t)((m) - MALL) * DM))
    { f32x4 cur[4], nxt[4]; int m = gw;
      if (m < MALL + MMEM) rms_load(ROW_SRC(m), lane, cur);
      for (; m < MALL + MMEM; m += NGW) { const int mn = m + NGW;
          if (mn < MALL + MMEM) rms_load(ROW_SRC(mn), lane, nxt);
          if (m < MALL) rms_finish(cur, a.in[7], (bf16*)(ws + WS_HB) + (size_t)m * DM, lane);
          else rms_finish(cur, a.in[18], (bf16*)(ws + WS_MB) + (size_t)(m - MALL) * DM, lane);
#pragma unroll
          for (int j = 0; j < 4; ++j) cur[j] = nxt[j]; } }
#undef ROW_SRC
    const float* spool = a.in[3]; const float* sconv = a.in[4]; const float* wdw = a.in[12]; const float* bdw = a.in[13];
    float* HC = (float*)(ws + WS_HC); float* HP = (float*)(ws + WS_HP);
    for (int e2 = bid * 512 + tid; e2 < 2 * NS * 512; e2 += G * 512) {
        const int e = e2 & (NS * 512 - 1), b = e >> 9, ch = e & 511;
        if (e2 < NS * 512) {
            float v[30];
#pragma unroll
            for (int j = 0; j < 30; ++j) v[j] = sconv[(size_t)(b * 30 + j) * 512 + ch];
            float acc = bdw[ch];
#pragma unroll
            for (int j = 0; j < 30; ++j) { acc += wdw[j * 512 + ch] * v[j]; if (j >= 1) a.out[O_CS + (size_t)(b * 30 + j - 1) * 512 + ch] = v[j]; }
            HC[e] = acc;
        } else {
            float v[15];
#pragma unroll
            for (int j = 0; j < 15; ++j) v[j] = spool[(size_t)(b * 15 + j) * 512 + ch];
            const int w = 2 << (ch >> 7); float sacc = 0.f;
#pragma unroll
            for (int j = 0; j < 15; ++j) { if (j >= 1) a.out[O_PS + (size_t)(b * 15 + j - 1) * 512 + ch] = v[j]; if (j >= 16 - w) sacc += v[j]; }
            HP[e] = sacc;
        }
    }
}

template <bool PAIR, class Fn>
__device__ __forceinline__ void skinny(const bf16* A, const bf16* Bt, int K, int nColBlk, int c, int G, LAS float* red, int tid, const Fn& fn) {
    const int lane = tid & 63, wave = __builtin_amdgcn_readfirstlane(tid >> 6), fr = lane & 15, fq = lane >> 4;
    const int nItems = nColBlk * 4, kw = K >> 3;
    for (int it = c; it < nItems; it += G) {
        const int rb = it & 3, cb = it >> 2;
        const int n0 = PAIR ? ((cb >> 3) * 256 + (cb & 7) * 16) : cb * 16;
        const bf16* ap = A + (size_t)(32 * rb + fr) * K + wave * kw + 8 * fq;
        const bf16* bp = Bt + (size_t)(n0 + fr) * K + wave * kw + 8 * fq;
        f32x4 c00 = {0.f, 0.f, 0.f, 0.f}, c01 = c00, c10 = c00, c11 = c00;
        for (int ks = 0; ks < kw; ks += 32) {
            const bf16x8 b0 = *(const bf16x8*)(bp + ks), a0 = *(const bf16x8*)(ap + ks), a1 = *(const bf16x8*)(ap + (size_t)16 * K + ks);
            c00 = __builtin_amdgcn_mfma_f32_16x16x32_bf16(b0, a0, c00, 0, 0, 0); c01 = __builtin_amdgcn_mfma_f32_16x16x32_bf16(b0, a1, c01, 0, 0, 0);
            if (PAIR) { const bf16x8 b1 = *(const bf16x8*)(bp + (size_t)128 * K + ks);
                c10 = __builtin_amdgcn_mfma_f32_16x16x32_bf16(b1, a0, c10, 0, 0, 0); c11 = __builtin_amdgcn_mfma_f32_16x16x32_bf16(b1, a1, c11, 0, 0, 0); }
        }
        LAS float* rw = red + wave * 1024;
        *(LAS f32x4*)(rw + fr * 16 + 4 * fq) = c00; *(LAS f32x4*)(rw + (16 + fr) * 16 + 4 * fq) = c01;
        if (PAIR) { *(LAS f32x4*)(rw + 512 + fr * 16 + 4 * fq) = c10; *(LAS f32x4*)(rw + 512 + (16 + fr) * 16 + 4 * fq) = c11; }
        __syncthreads();
        float v0 = 0.f, v1 = 0.f;
#pragma unroll
        for (int w = 0; w < 8; ++w) { v0 += red[w * 1024 + tid]; if (PAIR) v1 += red[w * 1024 + 512 + tid]; }
        fn(32 * rb + (tid >> 4), cb * 16 + (tid & 15), cb, v0, v1);
        __syncthreads();
    }
}
__device__ __forceinline__ float red16(float s) { s += __shfl_xor(s, 1); s += __shfl_xor(s, 2); s += __shfl_xor(s, 4); s += __shfl_xor(s, 8); return s; }
__device__ __forceinline__ float rstd_s(const float* p, int row, int ci) {
    const float* q = p + row * 64 + ci; return 1.0f / sqrtf(red16((q[0] + q[16]) + (q[32] + q[48])) * (1.0f / DM) + EPS);
}
struct SkRaw { float* O; int ld; __device__ __forceinline__ void operator()(int row, int col, int, float v0, float) const { O[(size_t)row * ld + col] = v0; } };
template <bool RES_BF16> struct SkRes { const void* resid; bf16* xb; float* ssq;
    __device__ __forceinline__ void operator()(int row, int col, int cb, float v0, float) const {
        const size_t off = (size_t)row * DM + col; const float r = RES_BF16 ? bf2f(((const bf16*)resid)[off]) : ((const float*)resid)[off];
        const float x = r + v0; xb[off] = (bf16)f2bf(x);
        const float ss = red16(x * x); if ((col & 15) == 0) ssq[row * 64 + cb] = ss; } };
struct SkQ { const float* ssq; bf16* Q; __device__ __forceinline__ void operator()(int row, int col, int, float v0, float) const {
        const float rs = rstd_s(ssq, row, col & 15) * QSCALE; Q[(size_t)row * DM + col] = (bf16)f2bf(v0 * rs); } };
struct SkGU { const float* ssq; bf16* F; __device__ __forceinline__ void operator()(int row, int col, int, float v0, float v1) const {
        const float rs = rstd_s(ssq, row, col & 15); const float g = v0 * rs; F[(size_t)row * FF + col] = (bf16)f2bf(g * sigm(g) * (v1 * rs)); } };

constexpr int MX_YC = 0, MX_D = 65536, MX_DSTRIDE = 1040;
template <int W> __device__ __forceinline__ void pool_half(const bf16* AP, int b, int t0, int r0, int tid, LAS unsigned char* lds) {
    float in[16 + W - 1];
#pragma unroll
    for (int i = 0; i < 16 + W - 1; ++i) { const int t = t0 + r0 - (W - 1) + i; const int tt = t < 0 ? 0 : t; const float v = bf2f(AP[(size_t)(b * SEQ + tt) * 512 + tid]); in[i] = t >= 0 ? v : 0.f; }
#pragma unroll
    for (int r = 0; r < 16; ++r) { float s = 0.f;
#pragma unroll
        for (int j = 0; j < W; ++j) s += in[r + j];
        const int t = t0 + r0 + r; const int cnt = (t + 1 < W) ? (t + 1) : W;
        const float d = s / (float)cnt - in[r + W - 1];
        *(LAS bf16*)(lds + MX_D + (r0 + r) * MX_DSTRIDE + tid * 2) = (bf16)f2bf(d); }
}
__device__ __forceinline__ void mixer_finish(const Args& a, LAS unsigned char* lds, int crow0, int tid, int lane, int wave) {
    bf16* C = (bf16*)(a.ws + WS_C);
    const LAS float* yc = (const LAS float*)(lds + MX_YC);
    { const f32x4 g0 = *(const f32x4*)(a.in[14] + lane * 8), g1 = *(const f32x4*)(a.in[14] + lane * 8 + 4), b0 = *(const f32x4*)(a.in[15] + lane * 8), b1 = *(const f32x4*)(a.in[15] + lane * 8 + 4);
#pragma unroll
      for (int i = 0; i < 4; ++i) { const int r = 4 * wave + i;
        const f32x4 y0 = *(const LAS f32x4*)(yc + r * 512 + lane * 8), y1 = *(const LAS f32x4*)(yc + r * 512 + lane * 8 + 4);
        const float mu = wave_sum((y0.x + y0.y) + (y0.z + y0.w) + (y1.x + y1.y) + (y1.z + y1.w)) * (1.0f / 512.0f);
        const f32x4 d0 = y0 - mu, d1 = y1 - mu;
        const float var = wave_sum((d0.x * d0.x + d0.y * d0.y) + (d0.z * d0.z + d0.w * d0.w) + (d1.x * d1.x + d1.y * d1.y) + (d1.z * d1.z + d1.w * d1.w)) * (1.0f / 512.0f);
        const float rs = 1.0f / sqrtf(var + EPS);
        f32x4 n0 = d0 * rs * g0 + b0, n1 = d1 * rs * g1 + b1;
#pragma unroll
        for (int j = 0; j < 4; ++j) { n0[j] = n0[j] * sigm(n0[j]); n1[j] = n1[j] * sigm(n1[j]); }
        u32x4 o; o.x = pk2(n0.x, n0.y); o.y = pk2(n0.z, n0.w); o.z = pk2(n1.x, n1.y); o.w = pk2(n1.z, n1.w);
        *(u32x4*)(C + (size_t)(crow0 + r) * DM + 512 + lane * 8) = o; } }
    { const int g = wave >> 1, nh = wave & 1, fr = lane & 15, fq = lane >> 4;
      const bf16* WT = (const bf16*)(a.ws + WS_WMAP) + (size_t)g * 16384;
      f32x4 acc[2][4];
#pragma unroll
      for (int mb = 0; mb < 2; ++mb)
#pragma unroll
          for (int nb = 0; nb < 4; ++nb) acc[mb][nb] = (f32x4){0.f, 0.f, 0.f, 0.f};
#pragma unroll
      for (int kc = 0; kc < 4; ++kc) {
          bf16x8 af[2];
#pragma unroll
          for (int mb = 0; mb < 2; ++mb) af[mb] = *(const LAS bf16x8*)(lds + MX_D + (16 * mb + fr) * MX_DSTRIDE + (g * 128 + 32 * kc + 8 * fq) * 2);
#pragma unroll
          for (int nb = 0; nb < 4; ++nb) { const bf16x8 bf = *(const bf16x8*)(WT + (size_t)(64 * nh + 16 * nb + fr) * 128 + 32 * kc + 8 * fq);
#pragma unroll
              for (int mb = 0; mb < 2; ++mb) acc[mb][nb] = __builtin_amdgcn_mfma_f32_16x16x32_bf16(bf, af[mb], acc[mb][nb], 0, 0, 0); }
      }
#pragma unroll
      for (int nb = 0; nb < 4; ++nb) { const int ch = g * 128 + 64 * nh + 16 * nb + 4 * fq;
          const f32x4 bm = *(const f32x4*)(a.in[10] + ch), sc = *(const f32x4*)(a.in[11] + ch);
#pragma unroll
          for (int mb = 0; mb < 2; ++mb) { const f32x4 y = (acc[mb][nb] + bm) * sc; u32x2 o; o.x = pk2(y.x, y.y); o.y = pk2(y.z, y.w);
              *(u32x2*)(C + (size_t)(crow0 + 16 * mb + fr) * DM + ch) = o; } } }
}
__device__ __forceinline__ void mixer_prompt_unit(const Args& a, LAS unsigned char* lds, int u, int tid, int lane, int wave) {
    const int b = u >> 6, t0 = (u & 63) * 32;
    const bf16* GLU = (const bf16*)(a.ws + WS_GLU); const bf16* AP = (const bf16*)(a.ws + WS_AP);
    LAS float* yc = (LAS float*)(lds + MX_YC);
    { float w[31];
#pragma unroll
      for (int j = 0; j < 31; ++j) w[j] = a.in[12][j * 512 + tid];
      const float bias = a.in[13][tid];
#pragma unroll 1
      for (int h = 0; h < 2; ++h) { const int r0 = 16 * h; float in[46];
#pragma unroll
          for (int i = 0; i < 46; ++i) { const int t = t0 + r0 - 30 + i; const int tt = t < 0 ? 0 : t; const float v = bf2f(GLU[(size_t)(b * SEQ + tt) * 512 + tid]); in[i] = t >= 0 ? v : 0.f; }
#pragma unroll
          for (int r = 0; r < 16; ++r) { float acc = bias;
#pragma unroll
              for (int j = 0; j < 31; ++j) acc += w[j] * in[r + j];
              yc[(r0 + r) * 512 + tid] = acc; } } }
    { const int g = tid >> 7;
#pragma unroll 1
      for (int h = 0; h < 2; ++h) {
          if (g == 0) pool_half<2>(AP, b, t0, 16 * h, tid, lds); else if (g == 1) pool_half<4>(AP, b, t0, 16 * h, tid, lds);
          else if (g == 2) pool_half<8>(AP, b, t0, 16 * h, tid, lds); else pool_half<16>(AP, b, t0, 16 * h, tid, lds); } }
    __syncthreads();
    mixer_finish(a, lds, b * SEQ + t0, tid, lane, wave);
    __syncthreads();
}
__device__ __forceinline__ void mixer_sample_unit(const Args& a, LAS unsigned char* lds, int su, int tid, int lane, int wave) {
    const float* US = (const float*)(a.ws + WS_US); const float* HC = (const float*)(a.ws + WS_HC); const float* HP = (const float*)(a.ws + WS_HP);
    LAS float* yc = (LAS float*)(lds + MX_YC);
    const float w30 = a.in[12][30 * 512 + tid]; const int wdt = 2 << (tid >> 7); const float invw = 1.0f / (float)wdt;
    const int gcol = 512 + (tid >> 7) * 256 + (tid & 127);
#pragma unroll 4
    for (int s = 0; s < 32; ++s) { const int bs = 32 * su + s;
        const float val = US[(size_t)bs * 1536 + gcol], gate = US[(size_t)bs * 1536 + gcol + 128], av = US[(size_t)bs * 1536 + tid];
        const float glu = val * sigm(gate);
        a.out[O_CS + (size_t)(bs * 30 + 29) * 512 + tid] = glu; a.out[O_PS + (size_t)(bs * 15 + 14) * 512 + tid] = av;
        yc[s * 512 + tid] = HC[bs * 512 + tid] + w30 * glu;
        const float d = (av + HP[bs * 512 + tid]) * invw - av;
        *(LAS bf16*)(lds + MX_D + s * MX_DSTRIDE + tid * 2) = (bf16)f2bf(d); }
    __syncthreads();
    mixer_finish(a, lds, MP + 32 * su, tid, lane, wave);
    __syncthreads();
}

constexpr int AT_K = 0, AT_KSTR = 528, AT_V = 64 * AT_KSTR, AT_VSTR = 144;
__device__ __forceinline__ float fexp2(float x) { return __builtin_amdgcn_exp2f(x); }
__device__ __forceinline__ void attn_prompt_unit(const Args& a, LAS unsigned char* lds, int u, int tid, int lane, int wave) {
    const int qb = u & 15, h = (u >> 4) & 3, b = u >> 6, fr = lane & 15, fq = lane >> 4;
    const bf16* Q = (const bf16*)(a.ws + WS_Q); const bf16* KB = (const bf16*)(a.ws + WS_KB); const bf16* VT = (const bf16*)(a.ws + WS_VT); bf16* O = (bf16*)(a.ws + WS_O);
    const size_t rowq = (size_t)b * SEQ + qb * 128 + wave * 16 + fr;
    bf16x8 qf[8];
#pragma unroll
    for (int kd = 0; kd < 8; ++kd) qf[kd] = *(const bf16x8*)(Q + rowq * DM + h * 256 + 32 * kd + 8 * fq);
    f32x4 o[16];
#pragma unroll
    for (int i = 0; i < 16; ++i) o[i] = (f32x4){0.f, 0.f, 0.f, 0.f};
    float mrun = -INFINITY, lrun = 0.f;
    u32x4 kr[4], vr[4];
#define AT_LOAD(c) do { _Pragma("unroll") for (int i = 0; i < 4; ++i) { const int p = tid + 512 * i; \
        kr[i] = *(const u32x4*)(KB + (size_t)(b * 256 + 64 * (c) + (p >> 5)) * DM + h * 256 + (p & 31) * 8); \
        vr[i] = *(const u32x4*)(VT + (size_t)(h * 256 + (p >> 3)) * 2048 + b * 256 + 64 * (c) + (p & 7) * 8); } } while (0)
    AT_LOAD(0);
#pragma unroll 1
    for (int c = 0; c < 4; ++c) {
        __syncthreads();
#pragma unroll
        for (int i = 0; i < 4; ++i) { const int p = tid + 512 * i;
            *(LAS u32x4*)(lds + AT_K + (p >> 5) * AT_KSTR + (p & 31) * 16) = kr[i];
            *(LAS u32x4*)(lds + AT_V + (p >> 3) * AT_VSTR + (p & 7) * 16) = vr[i]; }
        __syncthreads();
        if (c < 3) AT_LOAD(c + 1);
        f32x4 s[4];
#pragma unroll
        for (int nb = 0; nb < 4; ++nb) { s[nb] = (f32x4){0.f, 0.f, 0.f, 0.f};
#pragma unroll
            for (int kd = 0; kd < 8; ++kd) { const bf16x8 kf = *(const LAS bf16x8*)(lds + AT_K + (16 * nb + fr) * AT_KSTR + kd * 64 + fq * 16);
                s[nb] = __builtin_amdgcn_mfma_f32_16x16x32_bf16(kf, qf[kd], s[nb], 0, 0, 0); } }
        float mx = s[0][0];
#pragma unroll
        for (int nb = 0; nb < 4; ++nb)
#pragma unroll
            for (int j = 0; j < 4; ++j) mx = fmaxf(mx, s[nb][j]);
        mx = fmaxf(mx, __shfl_xor(mx, 16)); mx = fmaxf(mx, __shfl_xor(mx, 32));
        const float mnew = fmaxf(mrun, mx), alpha = fexp2(mrun - mnew);
        float ps = 0.f;
#pragma unroll
        for (int nb = 0; nb < 4; ++nb)
#pragma unroll
            for (int j = 0; j < 4; ++j) { s[nb][j] = fexp2(s[nb][j] - mnew); ps += s[nb][j]; }
        ps += __shfl_xor(ps, 16); ps += __shfl_xor(ps, 32);
        lrun = lrun * alpha + ps; mrun = mnew;
#pragma unroll
        for (int i = 0; i < 16; ++i) o[i] = o[i] * alpha;
#pragma unroll
        for (int kb = 0; kb < 2; ++kb) {
            u32x4 pw; pw.x = pg8::cvt_pk_bf16(s[2 * kb][0], s[2 * kb][1]); pw.y = pg8::cvt_pk_bf16(s[2 * kb][2], s[2 * kb][3]);
            pw.z = pg8::cvt_pk_bf16(s[2 * kb + 1][0], s[2 * kb + 1][1]); pw.w = pg8::cvt_pk_bf16(s[2 * kb + 1][2], s[2 * kb + 1][3]);
            const bf16x8 pf = __builtin_bit_cast(bf16x8, pw);
#pragma unroll
            for (int db = 0; db < 16; ++db) {
                const u32x2 v0 = *(const LAS u32x2*)(lds + AT_V + (16 * db + fr) * AT_VSTR + kb * 64 + fq * 8), v1 = *(const LAS u32x2*)(lds + AT_V + (16 * db + fr) * AT_VSTR + kb * 64 + 32 + fq * 8);
                u32x4 vw; vw.x = v0.x; vw.y = v0.y; vw.z = v1.x; vw.w = v1.y;
                o[db] = __builtin_amdgcn_mfma_f32_16x16x32_bf16(__builtin_bit_cast(bf16x8, vw), pf, o[db], 0, 0, 0); }
        }
    }
#undef AT_LOAD
    const float inv = 1.0f / lrun;
#pragma unroll
    for (int db = 0; db < 16; ++db) { const f32x4 y = o[db] * inv; u32x2 w; w.x = pg8::cvt_pk_bf16(y.x, y.y); w.y = pg8::cvt_pk_bf16(y.z, y.w);
        *(u32x2*)(O + rowq * DM + h * 256 + 16 * db + 4 * fq) = w; }
}
__device__ __forceinline__ void attn_sample_unit(const Args& a, LAS unsigned char* lds, int u, int tid, int lane, int wave) {
    const int b = u >> 2, h = u & 3;
    const bf16* Q = (const bf16*)(a.ws + WS_Q) + (size_t)(MP + b) * DM + h * 256; bf16* O = (bf16*)(a.ws + WS_O) + (size_t)(MP + b) * DM + h * 256;
    const float* ck = a.in[5] + ((size_t)b * 256 * 4 + h) * 256 + lane * 4; const float* cv = a.in[6] + ((size_t)b * 256 * 4 + h) * 256 + lane * 4;
    LAS float* sc = (LAS float*)lds; LAS float* pn = sc + 256; LAS float* red = sc + 512;
    const u32x2 qw = *(const u32x2*)(Q + lane * 4);
    const f32x4 q = {__builtin_bit_cast(float, qw.x << 16), __builtin_bit_cast(float, qw.x & 0xffff0000u), __builtin_bit_cast(float, qw.y << 16), __builtin_bit_cast(float, qw.y & 0xffff0000u)};
    float mine = 0.f;
#pragma unroll 16
    for (int i = 0; i < 32; ++i) { const f32x4 kv = *(const f32x4*)(ck + (size_t)(32 * wave + i) * 1024);
        const float sdot = wave_sum((kv.x * q.x + kv.y * q.y) + (kv.z * q.z + kv.w * q.w)); mine = (lane == i) ? sdot : mine; }
    __syncthreads();
    if (lane < 32) sc[32 * wave + lane] = mine;
    __syncthreads();
    { const f32x4 sv = *(const LAS f32x4*)(sc + lane * 4); const float mx = wave_max(fmaxf(fmaxf(sv.x, sv.y), fmaxf(sv.z, sv.w)));
      f32x4 e; e.x = fexp2(sv.x - mx); e.y = fexp2(sv.y - mx); e.z = fexp2(sv.z - mx); e.w = fexp2(sv.w - mx);
      const float inv = 1.0f / wave_sum((e.x + e.y) + (e.z + e.w));
      if (wave == 0) *(LAS f32x4*)(pn + lane * 4) = e * inv; }
    __syncthreads();
    f32x4 acc = {0.f, 0.f, 0.f, 0.f};
#pragma unroll 16
    for (int i = 0; i < 32; ++i) { const f32x4 vv = *(const f32x4*)(cv + (size_t)(32 * wave + i) * 1024); const float p = pn[32 * wave + i]; acc += vv * p; }
    *(LAS f32x4*)(red + wave * 256 + lane * 4) = acc;
    __syncthreads();
    if (tid < 256) { float s = 0.f;
#pragma unroll
        for (int w = 0; w < 8; ++w) s += red[w * 256 + tid];
        O[tid] = (bf16)f2bf(s); }
    __syncthreads();
}

#define XB_TMO      128
#define XB_XCNT(j)  (256  + 64 * (j))
#define XB_XSUB(j)  (1280 + 64 * (j))
#define XB_XGEN(j)  (2304 + 64 * (j))
#define XB_TOP      3328
#define XB_TOPGEN   3392
#define XCD_BAR_WORDS 3456
#define XB_SPIN_CAP (1u << 18)

__device__ __forceinline__ unsigned xb_ld(unsigned* p)              { return __hip_atomic_load(p, __ATOMIC_RELAXED, __HIP_MEMORY_SCOPE_AGENT); }
__device__ __forceinline__ unsigned xb_add(unsigned* p, unsigned v) { return __hip_atomic_fetch_add(p, v, __ATOMIC_RELAXED, __HIP_MEMORY_SCOPE_AGENT); }
__device__ __forceinline__ unsigned xb_xcc_id() { return (unsigned)__builtin_amdgcn_s_getreg((3 << 11) | 20) & 0xFu; }
#define XB_SPIN(cond, bar) do { unsigned _sp = 0; while (cond) { __builtin_amdgcn_s_sleep(1); \
    if ((++_sp & 255u) == 0u) { if (xb_ld(&(bar)[XB_TMO])) break; if (_sp > XB_SPIN_CAP) { atomicAdd(&(bar)[XB_TMO], 1u); break; } } } } while (0)

struct XcdBarrier {
    unsigned* bar; unsigned x;
    volatile LAS unsigned* st;
};

__device__ __forceinline__ XcdBarrier xcd_barrier_post(unsigned* bar, volatile LAS unsigned* st) {
    XcdBarrier b; b.bar = bar; b.x = xb_xcc_id(); b.st = st;
    if (threadIdx.x == 0) (void)xb_add(&bar[XB_XCNT(b.x)], 1u);
    return b;
}
__device__ __forceinline__ void xcd_barrier_complete(unsigned* bar, unsigned x, unsigned& nloc, unsigned& nx) {
    const unsigned G = gridDim.x * gridDim.y * gridDim.z;
    unsigned sum, cnt, mine, sp = 0u;
    for (;;) {
        sum = 0u; cnt = 0u; mine = 0u;
#pragma unroll
        for (unsigned j = 0; j < 16; ++j) { const unsigned c = xb_ld(&bar[XB_XCNT(j)]); sum += c; cnt += (c > 0u) ? 1u : 0u; mine = (j == x) ? c : mine; }
        if (sum == G) break;
        __builtin_amdgcn_s_sleep(1);
        if ((++sp & 255u) == 0u) { if (xb_ld(&bar[XB_TMO])) break; if (sp > XB_SPIN_CAP) { atomicAdd(&bar[XB_TMO], 1u); break; } }
    }
    nloc = mine > 0u ? mine : 1u; nx = cnt > 0u ? cnt : 1u;
}

__device__ __forceinline__ void xcd_barrier(const XcdBarrier& b) {
    asm volatile("s_waitcnt vmcnt(0)" ::: "memory");
    __syncthreads();
    if (threadIdx.x == 0) {
        unsigned* bar = b.bar;
        __builtin_amdgcn_s_waitcnt(0);
        unsigned nloc = b.st[0], nx = b.st[1];
        if (nloc == 0u) { xcd_barrier_complete(bar, b.x, nloc, nx); b.st[0] = nloc; b.st[1] = nx; }
        const unsigned old = xb_add(&bar[XB_XSUB(b.x)], 1u);
        const unsigned gen = old / nloc;
        if (old + 1u == (gen + 1u) * nloc) {
            __builtin_amdgcn_fence(__ATOMIC_RELEASE, "agent");
            asm volatile("s_waitcnt vmcnt(0)" ::: "memory");
            const unsigned og = xb_add(&bar[XB_TOP], 1u);
            const unsigned tg = og / nx;
            if (og + 1u == (tg + 1u) * nx) xb_add(&bar[XB_TOPGEN], 1u);
            else XB_SPIN(xb_ld(&bar[XB_TOPGEN]) == tg, bar);
            __builtin_amdgcn_fence(__ATOMIC_ACQUIRE, "agent");
            xb_add(&bar[XB_XGEN(b.x)], 1u);
            asm volatile("s_waitcnt vmcnt(0)" ::: "memory");
        } else {
            XB_SPIN(xb_ld(&bar[XB_XGEN(b.x)]) == gen, bar);
            __builtin_amdgcn_fence(__ATOMIC_ACQUIRE, "agent");
            asm volatile("s_waitcnt vmcnt(0)" ::: "memory");
        }
    }
    __syncthreads();
}

constexpr int CW_BAR = 4096;
constexpr int MISC_OFF = 131072 + 320;
__global__ void __launch_bounds__(512, 2) fwd_kernel(Args a) {
    extern __shared__ __attribute__((aligned(16))) unsigned char lds_raw[];
    LAS unsigned char* lds = (LAS unsigned char*)lds_raw;
    const int tid = threadIdx.x, lane = tid & 63, wave = __builtin_amdgcn_readfirstlane(tid >> 6);
    const int G = gridDim.x, bid = blockIdx.x;
    unsigned char* ws = a.ws;
    const int lo = a.ph_lo, hi = a.ph_hi;
    cg::grid_group grid = cg::this_grid();
    for (int u = tid; u < (LDS_BYTES - 131072) / 4; u += 512) ((LAS unsigned*)(lds + 131072))[u] = 0u;
    __syncthreads();
    volatile LAS unsigned* MISC = (volatile LAS unsigned*)(lds + MISC_OFF);
    XcdBarrier bar; bar.bar = (unsigned*)(ws + WS_CTL) + CW_BAR; bar.x = 0; bar.st = nullptr;
    if (hi - lo > 1) bar = xcd_barrier_post((unsigned*)(ws + WS_CTL) + CW_BAR, MISC + 8);
    if (lo < 0) grid.sync();
#define IN(k) (lo <= (k) && (k) < hi)
#define SEAM(k) do { if (lo <= (k) && (k) + 1 < hi) xcd_barrier(bar); } while (0)
    bf16* HB = (bf16*)(ws + WS_HB); bf16* C = (bf16*)(ws + WS_C); bf16* X3B = (bf16*)(ws + WS_X1); bf16* X1B = (bf16*)(ws + WS_X1B); bf16* Qb = (bf16*)(ws + WS_Q);
    bf16* Ob = (bf16*)(ws + WS_O); bf16* X2B = (bf16*)(ws + WS_X2B); bf16* Fb = (bf16*)(ws + WS_F);
    float* SSQ1 = (float*)(ws + WS_SSQ1); float* SSQ2 = (float*)(ws + WS_SSQ2); float* SSQ3 = (float*)(ws + WS_SSQ3);
    float* SSQ1S = (float*)(ws + WS_SSQS); float* SSQ2S = SSQ1S + NS * 64; float* SSQ3S = SSQ2S + NS * 64;
    LAS float* red = (LAS float*)lds;

    if (IN(0)) { p0_prologue(a, lds, bid, G, tid, lane, wave); }
    SEAM(0);
    if (IN(1)) {
        { pg8::Gemm g{HB, (const bf16*)(ws + WS_WIN), MP, 1536, 1024}; pg8::StaticOrder S; S.init(MP, 1536, G, bid);
          pg8::EpiIn E{(bf16*)(ws + WS_AP), (bf16*)(ws + WS_GLU), a.out + O_PP, a.out + O_CP};
          pg8::gemm_phase<pg8::EpiIn, pg8::StaticOrder, true, true>(lds, g, S, E); }
        { pg8::Gemm g{(const bf16*)(ws + WS_MB), (const bf16*)(ws + WS_WKV), MMEM, 2048, 1024}; pg8::StaticOrder S; S.init(MMEM, 2048, G, (bid + G - (128 % G)) % G);
          pg8::EpiKV E{a.out + O_MK, a.out + O_MV, (bf16*)(ws + WS_KB)};
          pg8::gemm_phase<pg8::EpiKV, pg8::StaticOrder, true, true>(lds, g, S, E); }
        { pg8::Gemm g{(const bf16*)(ws + WS_WKV) + (size_t)1024 * 1024, (const bf16*)(ws + WS_MB), 1024, MMEM, 1024}; pg8::StaticOrder S; S.init(1024, MMEM, G, (bid + G - (192 % G)) % G);
          pg8::EpiPlain E{(bf16*)(ws + WS_VT), 2048};
          pg8::gemm_phase<pg8::EpiPlain, pg8::StaticOrder, true, true>(lds, g, S, E); }
        __syncthreads();
        { SkRaw f{(float*)(ws + WS_US), 1536}; const int ge = G > 32 ? 32 : G, cc = (bid + G - (224 % G)) % G; if (cc < ge) skinny<false>(HB + (size_t)MP * DM, (const bf16*)(ws + WS_WIN), 1024, 96, cc, ge, red, tid, f); }
    }
    SEAM(1);
    if (IN(2)) {
        for (int u = bid; u < 512 + 4; u += G) { if (u < 512) mixer_prompt_unit(a, lds, u, tid, lane, wave); else mixer_sample_unit(a, lds, u - 512, tid, lane, wave); }
    }
    SEAM(2);
    if (IN(3)) {
        { pg8::Gemm g{C, (const bf16*)(ws + WS_WOUT), MP, 1024, 1024}; pg8::StaticOrder S; S.init(MP, 1024, G, bid);
          pg8::EpiRes<false> E{a.in[0], X1B, SSQ1};
          pg8::gemm_phase<pg8::EpiRes<false>, pg8::StaticOrder, false, true>(lds, g, S, E); }
        __syncthreads();
        { SkRes<false> f{a.in[1], X1B + (size_t)MP * DM, SSQ1S}; skinny<false>(C + (size_t)MP * DM, (const bf16*)(ws + WS_WOUT), 1024, 64, bid, G, red, tid, f); }
    }
    SEAM(3);
    if (IN(4)) {
        { pg8::Gemm g{X1B, (const bf16*)(ws + WS_WQ), MP, 1024, 1024}; pg8::StaticOrder S; S.init(MP, 1024, G, bid);
          pg8::EpiQ E{SSQ1, Qb, QSCALE};
          pg8::gemm_phase<pg8::EpiQ, pg8::StaticOrder, false, true>(lds, g, S, E); }
        __syncthreads();
        { SkQ f{SSQ1S, Qb + (size_t)MP * DM}; skinny<false>(X1B + (size_t)MP * DM, (const bf16*)(ws + WS_WQ), 1024, 64, bid, G, red, tid, f); }
    }
    SEAM(4);
    if (IN(5)) {
        for (int u = bid; u < 512; u += G) attn_prompt_unit(a, lds, u, tid, lane, wave);
        __syncthreads();
        for (int u = bid; u < 512; u += G) attn_sample_unit(a, lds, u, tid, lane, wave);
    }
    SEAM(5);
    if (IN(6)) {
        { pg8::Gemm g{Ob, (const bf16*)(ws + WS_WO), MP, 1024, 1024}; pg8::StaticOrder S; S.init(MP, 1024, G, bid);
          pg8::EpiRes<true> E{X1B, X2B, SSQ2};
          pg8::gemm_phase<pg8::EpiRes<true>, pg8::StaticOrder, false, true>(lds, g, S, E); }
        __syncthreads();
        { SkRes<true> f{X1B + (size_t)MP * DM, X2B + (size_t)MP * DM, SSQ2S}; skinny<false>(Ob + (size_t)MP * DM, (const bf16*)(ws + WS_WO), 1024, 64, bid, G, red, tid, f); }
    }
    SEAM(6);
    if (IN(7)) {
        { pg8::Gemm g{X2B, (const bf16*)(ws + WS_WGU), MP, FF2, 1024}; pg8::StaticOrder S; S.init(MP, FF2, G, bid);
          pg8::EpiGU E{SSQ2, Fb};
          pg8::gemm_phase<pg8::EpiGU, pg8::StaticOrder, true, true>(lds, g, S, E); }
        __syncthreads();
        { SkGU f{SSQ2S, Fb + (size_t)MP * FF}; const int half = G >= 2 ? G / 2 : 1;
          if (bid >= G - half) skinny<true>(X2B + (size_t)MP * DM, (const bf16*)(ws + WS_WGU), 1024, 176, bid - (G - half), half, red, tid, f); }
    }
    SEAM(7);
    if (IN(8)) {
        { pg8::Gemm g{Fb, (const bf16*)(ws + WS_WD), MP, 1024, FF}; pg8::StaticOrder S; S.init(MP, 1024, G, bid);
          pg8::EpiRes<true> E{X2B, X3B, SSQ3};
          pg8::gemm_phase<pg8::EpiRes<true>, pg8::StaticOrder, false, true>(lds, g, S, E); }
        __syncthreads();
        { SkRes<true> f{X2B + (size_t)MP * DM, X3B + (size_t)MP * DM, SSQ3S}; skinny<false>(Fb + (size_t)MP * FF, (const bf16*)(ws + WS_WD), FF, 64, bid, G, red, tid, f); }
    }
    SEAM(8);
    if (IN(9)) {
        const int gw = bid * 8 + wave, NGW = G * 8;
        const f32x4* gf = (const f32x4*)a.in[27] + lane;
        for (int m = gw; m < MALL; m += NGW) {
            float* yrow; float ssum;
            if (m < MP) { yrow = a.out + O_Y + (size_t)m * DM; const float v = (lane < 16) ? SSQ3[(size_t)m * 16 + lane] : 0.f; ssum = wave_sum(v); }
            else { yrow = a.out + O_YS + (size_t)(m - MP) * DM; ssum = wave_sum(SSQ3S[(m - MP) * 64 + lane]); }
            const float rstd = 1.0f / sqrtf(ssum * (1.0f / DM) + EPS);
            const u32x2* xr = (const u32x2*)(X3B + (size_t)m * DM) + lane; f32x4* yr = (f32x4*)yrow + lane;
#pragma unroll
            for (int j = 0; j < 4; ++j) { const u32x2 w = xr[64 * j];
                const f32x4 v = {__builtin_bit_cast(float, w.x << 16), __builtin_bit_cast(float, w.x & 0xffff0000u), __builtin_bit_cast(float, w.y << 16), __builtin_bit_cast(float, w.y & 0xffff0000u)};
                yr[64 * j] = v * rstd * gf[64 * j]; }
        }
    }
#undef IN
#undef SEAM
}

#ifndef MK_MULTI
#define MK_MULTI 0
#endif
extern "C" void kernel_launch(void* const* d_in, const int* in_sizes, int n_in, void* d_out, int out_size, void* d_ws, size_t ws_size, hipStream_t stream) {
    static int grid = 0;
    if (grid == 0) {
        if (n_in != 28 || ws_size < WS_END) { fprintf(stderr, "kernel_launch: unexpected n_in %d / ws_size %zu\n", n_in, ws_size); grid = -1; return; }
        int dev = 0, cus = 0, per_cu = 0;
        (void)hipGetDevice(&dev); (void)hipDeviceGetAttribute(&cus, hipDeviceAttributeMultiprocessorCount, dev);
        if (hipFuncSetAttribute((const void*)fwd_kernel, hipFuncAttributeMaxDynamicSharedMemorySize, LDS_BYTES) != hipSuccess) { fprintf(stderr, "kernel_launch: hipFuncSetAttribute failed\n"); grid = -1; return; }
        if (hipOccupancyMaxActiveBlocksPerMultiprocessor(&per_cu, (const void*)fwd_kernel, 512, LDS_BYTES) != hipSuccess || per_cu < 1) { fprintf(stderr, "kernel_launch: occupancy query says %d\n", per_cu); per_cu = 1; }
        (void)hipGetLastError();
        grid = cus;
    }
    if (grid < 0) return;
    (void)hipMemsetAsync((char*)d_ws + WS_CTL, 0, CTL_ZERO_BYTES, stream);
    Args a{};
    for (int i = 0; i < 28; ++i) a.in[i] = (const float*)d_in[i];
    a.out = (float*)d_out; a.ws = (unsigned char*)d_ws;
#if MK_MULTI
    for (int p = 0; p < NPHASE; ++p) { a.ph_lo = p; a.ph_hi = p + 1; hipLaunchKernelGGL(fwd_kernel, dim3(grid), dim3(512), LDS_BYTES, stream, a); }
#else
    a.ph_lo = 0; a.ph_hi = NPHASE;
    void* args[] = {&a};
    hipError_t e = hipLaunchCooperativeKernel((const void*)fwd_kernel, dim3(grid), dim3(512), args, LDS_BYTES, stream);
    if (e != hipSuccess) fprintf(stderr, "cooperative launch failed: %s (grid %d)\n", hipGetErrorString(e), grid);
#endif
}
```

```cpp
#include <hip/hip_runtime.h>
#include <hip/hip_cooperative_groups.h>
#include <cstdio>
#include <cstdint>
namespace cg = cooperative_groups;
namespace pg8 {
#define PG8_LAS __attribute__((address_space(3)))
typedef unsigned short bf16_t;
typedef short bf16x8 __attribute__((ext_vector_type(8)));
typedef float f32x4 __attribute__((ext_vector_type(4)));
typedef unsigned u32x4 __attribute__((ext_vector_type(4)));
constexpr int BM = 256, BK = 64, HALF = 128, HTB = HALF * BK * 2  , STAGE_BYTES = 8 * HTB, NXCD = 8, WGM = 8;

__host__ __device__ __forceinline__ int lds_byte(int r, int c) { const int st = (r >> 4) * 2 + (c >> 5), rr = r & 15, cc = c & 31, ob = rr * 64 + cc * 2; return st * 1024 + (ob ^ (((ob >> 9) & 1) << 5)); }
__host__ __device__ __forceinline__ void stage_rc(int b, int& R, int& C) { const int st = b / 1024, sb = b % 1024, swz = sb ^ (((sb >> 9) & 1) << 5); R = (st >> 1) * 16 + swz / 64; C = (st & 1) * 32 + (swz % 64) / 2; }
__host__ __device__ __forceinline__ int perm32(int rho) { const int n = rho >> 4, i = rho & 15; return 8 * (i >> 2) + 4 * n + (i & 3); }

struct Unit { int pm, pn; };
struct Gemm { const bf16_t* A; const bf16_t* Bt; int M, N, K; };

struct StaticOrder {
    int nM, nN, nwg, G, c;
    __host__ __device__ void init(int M, int N, int G_, int c_) { nM = M / BM; nN = N / BM; nwg = nM * nN; G = G_; c = c_; }
    __host__ __device__ bool next(int i, Unit& u) const {
        const long L = (long)i * G + c; if (L >= nwg) return false;
        int wgid = (int)L; { const int q = nwg / NXCD, r = nwg % NXCD, xcd = wgid % NXCD, off = wgid / NXCD; wgid = (xcd < r ? xcd * (q + 1) : r * (q + 1) + (xcd - r) * q) + off; }
        const int nig = WGM * nN, gid = wgid / nig, fm = gid * WGM, gsz = (nM - fm) < WGM ? (nM - fm) : WGM;
        u.pm = fm + ((wgid % nig) % gsz); u.pn = (wgid % nig) / gsz; return true;
    }
    __device__ __forceinline__ void a_ready(const Unit&) const {}
    __device__ __forceinline__ void done(const Unit&) const {}
};
typedef unsigned u32x4 __attribute__((ext_vector_type(4)));
constexpr float EPSF = 1e-6f;
__device__ __forceinline__ unsigned cvt_pk_bf16(float lo, float hi) { unsigned r; asm volatile("v_cvt_pk_bf16_f32 %0, %1, %2" : "=v"(r) : "v"(lo), "v"(hi)); return r; }
__device__ __forceinline__ u32x4 pack8(const f32x4 a, const f32x4 b) { u32x4 w; w.x = cvt_pk_bf16(a[0], a[1]); w.y = cvt_pk_bf16(a[2], a[3]); w.z = cvt_pk_bf16(b[0], b[1]); w.w = cvt_pk_bf16(b[2], b[3]); return w; }
__device__ __forceinline__ float sigm(float x) { return __builtin_amdgcn_rcpf(1.0f + __builtin_amdgcn_exp2f(-1.4426950408889634f * x)); }
__device__ __forceinline__ float rstd16(const float* p) {
    const f32x4 a = ((const f32x4*)p)[0], b = ((const f32x4*)p)[1], c = ((const f32x4*)p)[2], d = ((const f32x4*)p)[3];
    const float s = ((a[0] + a[1]) + (a[2] + a[3])) + ((b[0] + b[1]) + (b[2] + b[3])) + ((c[0] + c[1]) + (c[2] + c[3])) + ((d[0] + d[1]) + (d[2] + d[3]));
    return 1.0f / sqrtf(s * (1.0f / 1024.0f) + EPSF);
}
struct EpiIn {
    static constexpr bool PERM = true, AFTER_DRAIN = false;
    bf16_t* AP; bf16_t* GLU; float* outPP; float* outCP;
    __device__ __forceinline__ void operator()(const f32x4 (&acc)[2][2][4][2], const Unit& u, int wr, int wc, int fr, int fq) const {
        const int row0 = u.pm * BM + wr * 64 + fr, cl = wc * 32 + 8 * fq;
        if (u.pn < 2) {
#pragma unroll
            for (int ai = 0; ai < 2; ++ai)
#pragma unroll
                for (int m = 0; m < 4; ++m) { const int row = row0 + ai * HALF + m * 16, t = row & 2047, b = row >> 11;
#pragma unroll
                    for (int bj = 0; bj < 2; ++bj) { const int col = u.pn * 256 + bj * HALF + cl; const f32x4 v0 = acc[ai][bj][m][0], v1 = acc[ai][bj][m][1];
                        *(u32x4*)(AP + (size_t)row * 512 + col) = pack8(v0, v1);
                        if (t >= 2033) { float* o = outPP + ((size_t)(b * 15 + t - 2033) * 512 + col); *(f32x4*)o = v0; *(f32x4*)(o + 4) = v1; } } }
        } else {
            const int ch = (u.pn - 2) * 128 + cl;
#pragma unroll
            for (int ai = 0; ai < 2; ++ai)
#pragma unroll
                for (int m = 0; m < 4; ++m) { const int row = row0 + ai * HALF + m * 16, t = row & 2047, b = row >> 11;
                    f32x4 o0, o1;
#pragma unroll
                    for (int j = 0; j < 4; ++j) { o0[j] = acc[ai][0][m][0][j] * sigm(acc[ai][1][m][0][j]); o1[j] = acc[ai][0][m][1][j] * sigm(acc[ai][1][m][1][j]); }
                    *(u32x4*)(GLU + (size_t)row * 512 + ch) = pack8(o0, o1);
                    if (t >= 2018) { float* o = outCP + ((size_t)(b * 30 + t - 2018) * 512 + ch); *(f32x4*)o = o0; *(f32x4*)(o + 4) = o1; } }
        }
    }
};
struct EpiKV {
    static constexpr bool PERM = true, AFTER_DRAIN = false;
    float* outK; float* outV; bf16_t* KB;
    __device__ __forceinline__ void operator()(const f32x4 (&acc)[2][2][4][2], const Unit& u, int wr, int wc, int fr, int fq) const {
        const int row0 = u.pm * BM + wr * 64 + fr, cl = wc * 32 + 8 * fq;
#pragma unroll
        for (int ai = 0; ai < 2; ++ai)
#pragma unroll
            for (int m = 0; m < 4; ++m) { const int row = row0 + ai * HALF + m * 16;
#pragma unroll
                for (int bj = 0; bj < 2; ++bj) { const int col = u.pn * 256 + bj * HALF + cl; const f32x4 v0 = acc[ai][bj][m][0], v1 = acc[ai][bj][m][1];
                    if (u.pn < 4) { float* o = outK + (size_t)row * 1024 + col; *(f32x4*)o = v0; *(f32x4*)(o + 4) = v1; *(u32x4*)(KB + (size_t)row * 1024 + col) = pack8(v0, v1); }
                    else { float* o = outV + (size_t)row * 1024 + (col - 1024); *(f32x4*)o = v0; *(f32x4*)(o + 4) = v1; } } }
    }
};
struct EpiPlain {
    static constexpr bool PERM = true, AFTER_DRAIN = false;
    bf16_t* O; int ldc;
    __device__ __forceinline__ void operator()(const f32x4 (&acc)[2][2][4][2], const Unit& u, int wr, int wc, int fr, int fq) const {
        const int row0 = u.pm * BM + wr * 64 + fr, cl = wc * 32 + 8 * fq;
#pragma unroll
        for (int ai = 0; ai < 2; ++ai)
#pragma unroll
            for (int m = 0; m < 4; ++m) { const int row = row0 + ai * HALF + m * 16;
#pragma unroll
                for (int bj = 0; bj < 2; ++bj) { const int col = u.pn * 256 + bj * HALF + cl; *(u32x4*)(O + (size_t)row * ldc + col) = pack8(acc[ai][bj][m][0], acc[ai][bj][m][1]); } }
    }
};
template <bool RES_BF16> struct EpiRes {
    static constexpr bool PERM = true, AFTER_DRAIN = false;
    const void* resid; bf16_t* xb; float* ssq;
    __device__ __forceinline__ void operator()(const f32x4 (&acc)[2][2][4][2], const Unit& u, int wr, int wc, int fr, int fq) const {
        const int row0 = u.pm * BM + wr * 64 + fr, cl = wc * 32 + 8 * fq;
#pragma unroll
        for (int ai = 0; ai < 2; ++ai)
#pragma unroll
            for (int m = 0; m < 4; ++m) { const int row = row0 + ai * HALF + m * 16; float ss = 0.f;
#pragma unroll
                for (int bj = 0; bj < 2; ++bj) { const size_t off = (size_t)row * 1024 + u.pn * 256 + bj * HALF + cl;
                    f32x4 r0, r1;
                    if (RES_BF16) { const u32x4 w = *(const u32x4*)((const bf16_t*)resid + off);
                        r0 = (f32x4){__builtin_bit_cast(float, w.x << 16), __builtin_bit_cast(float, w.x & 0xffff0000u), __builtin_bit_cast(float, w.y << 16), __builtin_bit_cast(float, w.y & 0xffff0000u)};
                        r1 = (f32x4){__builtin_bit_cast(float, w.z << 16), __builtin_bit_cast(float, w.z & 0xffff0000u), __builtin_bit_cast(float, w.w << 16), __builtin_bit_cast(float, w.w & 0xffff0000u)}; }
                    else { r0 = *(const f32x4*)((const float*)resid + off); r1 = *(const f32x4*)((const float*)resid + off + 4); }
                    const f32x4 x0 = r0 + acc[ai][bj][m][0], x1 = r1 + acc[ai][bj][m][1];
                    *(u32x4*)(xb + off) = pack8(x0, x1);
                    ss += ((x0[0] * x0[0] + x0[1] * x0[1]) + (x0[2] * x0[2] + x0[3] * x0[3])) + ((x1[0] * x1[0] + x1[1] * x1[1]) + (x1[2] * x1[2] + x1[3] * x1[3])); }
                ss += __shfl_xor(ss, 16); ss += __shfl_xor(ss, 32);
                if (fq == 0) ssq[(size_t)row * 16 + u.pn * 4 + wc] = ss; }
    }
};
struct EpiQ {
    static constexpr bool PERM = true, AFTER_DRAIN = false;
    const float* ssq; bf16_t* Q; float scale;
    __device__ __forceinline__ void operator()(const f32x4 (&acc)[2][2][4][2], const Unit& u, int wr, int wc, int fr, int fq) const {
        const int row0 = u.pm * BM + wr * 64 + fr, cl = wc * 32 + 8 * fq;
#pragma unroll
        for (int ai = 0; ai < 2; ++ai)
#pragma unroll
            for (int m = 0; m < 4; ++m) { const int row = row0 + ai * HALF + m * 16; const float rs = rstd16(ssq + (size_t)row * 16) * scale;
#pragma unroll
                for (int bj = 0; bj < 2; ++bj) { const size_t off = (size_t)row * 1024 + u.pn * 256 + bj * HALF + cl;
                    *(u32x4*)(Q + off) = pack8(acc[ai][bj][m][0] * rs, acc[ai][bj][m][1] * rs); } }
    }
};
struct EpiGU {
    static constexpr bool PERM = true, AFTER_DRAIN = false;
    const float* ssq; bf16_t* F;
    __device__ __forceinline__ void operator()(const f32x4 (&acc)[2][2][4][2], const Unit& u, int wr, int wc, int fr, int fq) const {
        const int row0 = u.pm * BM + wr * 64 + fr, cl = wc * 32 + 8 * fq;
#pragma unroll
        for (int ai = 0; ai < 2; ++ai)
#pragma unroll
            for (int m = 0; m < 4; ++m) { const int row = row0 + ai * HALF + m * 16; const float rs = rstd16(ssq + (size_t)row * 16);
                f32x4 o0, o1;
#pragma unroll
                for (int j = 0; j < 4; ++j) { const float g0 = acc[ai][0][m][0][j] * rs, g1 = acc[ai][0][m][1][j] * rs;
                    o0[j] = g0 * sigm(g0) * (acc[ai][1][m][0][j] * rs); o1[j] = g1 * sigm(g1) * (acc[ai][1][m][1][j] * rs); }
                *(u32x4*)(F + (size_t)row * 2816 + u.pn * 128 + cl) = pack8(o0, o1); }
    }
};
template <class Epi, class Sched, bool ALIGN_EPI = false, bool SP2 = false>
__device__ __forceinline__ void gemm_phase(PG8_LAS unsigned char* lds, const Gemm g, const Sched& S, const Epi& E) {
    const int tid = threadIdx.x, wid = __builtin_amdgcn_readfirstlane(tid >> 6), lane = tid & 63, wr = wid >> 2, wc = wid & 3, fr = lane & 15, fq = lane >> 4;
    const int K = g.K, nt = K / BK;
    unsigned voffA[2], voffB[2];
#pragma unroll
    for (int i = 0; i < 2; ++i) { int R, C; stage_rc(tid * 16 + i * 8192, R, C); const int Rb = Epi::PERM ? ((R & ~31) + perm32(R & 31)) : R;
        voffA[i] = (unsigned)(R * K + C) * 2u; voffB[i] = (unsigned)(Rb * K + C) * 2u; }
    const size_t kstep = (size_t)(BK * 2);
    const size_t hstep = (size_t)HALF * K * 2;
    const size_t tstep = 2 * hstep;
    const unsigned ldsw = (unsigned)wid * 1024u;
    const int aoff = lds_byte(wr * 64 + fr, fq * 8), boff = lds_byte(wc * 32 + fr, fq * 8);
#define PG8_SA(b, h) (((b) * 2 + (h)) * HTB)
#define PG8_SB(b, h) ((4 + (b) * 2 + (h)) * HTB)
#define PG8_STAGE(bufoff, gbase, voff) do { _Pragma("unroll") for (int _i = 0; _i < 2; ++_i) \
        __builtin_amdgcn_global_load_lds((const unsigned*)((const char*)(gbase) + (voff)[_i]), (PG8_LAS unsigned*)(lds + (bufoff) + ldsw + _i * 8192), 16, 0, 0); } while (0)
#define PG8_LDA(dst, b, h) do { _Pragma("unroll") for (int m = 0; m < 4; ++m) _Pragma("unroll") for (int k = 0; k < 2; ++k) dst[m][k] = *(const PG8_LAS bf16x8*)(lds + PG8_SA(b, h) + aoff + m * 2048 + k * 1024); } while (0)
#define PG8_LDB(dst, b, h) do { _Pragma("unroll") for (int n = 0; n < 2; ++n) _Pragma("unroll") for (int k = 0; k < 2; ++k) dst[n][k] = *(const PG8_LAS bf16x8*)(lds + PG8_SB(b, h) + boff + n * 2048 + k * 1024); } while (0)
#define PG8_MMA(ai, bj, At, Bt) do { __builtin_amdgcn_s_setprio(1); _Pragma("unroll") for (int m = 0; m < 4; ++m) _Pragma("unroll") for (int n = 0; n < 2; ++n) _Pragma("unroll") for (int k = 0; k < 2; ++k) \
        acc[ai][bj][m][n] = __builtin_amdgcn_mfma_f32_16x16x32_bf16(Bt[n][k], At[m][k], acc[ai][bj][m][n], 0, 0, 0); __builtin_amdgcn_s_setprio(0); } while (0)
#define PG8_WAIT_V(n) asm volatile("s_waitcnt vmcnt(" #n ")" ::: "memory")
#define PG8_WAIT_L(n) asm volatile("s_waitcnt lgkmcnt(" #n ")" ::: "memory")
#define PG8_BAR __builtin_amdgcn_s_barrier()
#define PG8_SCHED __builtin_amdgcn_sched_barrier(0)
    Unit cur, nxt; int ui = 0;
    if (!S.next(0, cur)) return;
    f32x4 acc[2][2][4][2];
#pragma unroll
    for (int a = 0; a < 2; ++a)
#pragma unroll
        for (int b = 0; b < 2; ++b)
#pragma unroll
            for (int m = 0; m < 4; ++m)
#pragma unroll
                for (int n = 0; n < 2; ++n) acc[a][b][m][n] = (f32x4){0.f, 0.f, 0.f, 0.f};
    bf16x8 At[4][2], B0[2][2], B1[2][2];
    const char* cA = (const char*)g.A + (size_t)cur.pm * tstep; const char* cB = (const char*)g.Bt + (size_t)cur.pn * tstep;
    S.a_ready(cur);
    if constexpr (SP2) {
        PG8_STAGE(PG8_SB(0, 0), cB, voffB); PG8_STAGE(PG8_SB(0, 1), cB + hstep, voffB); PG8_STAGE(PG8_SA(0, 0), cA, voffA); PG8_STAGE(PG8_SA(0, 1), cA + hstep, voffA);
        if (wr == 1) PG8_BAR;
        PG8_WAIT_V(2); PG8_BAR;
        PG8_STAGE(PG8_SB(1, 0), cB + kstep, voffB); PG8_STAGE(PG8_SA(1, 0), cA + kstep, voffA); PG8_STAGE(PG8_SB(1, 1), cB + hstep + kstep, voffB);
        PG8_WAIT_V(6); PG8_BAR;
    } else {
        PG8_STAGE(PG8_SB(0, 0), cB, voffB); PG8_STAGE(PG8_SA(0, 0), cA, voffA); PG8_STAGE(PG8_SB(0, 1), cB + hstep, voffB); PG8_STAGE(PG8_SA(0, 1), cA + hstep, voffA);
        if (wr == 1) PG8_BAR;
        PG8_WAIT_V(4); PG8_BAR;
        PG8_STAGE(PG8_SB(1, 0), cB + kstep, voffB); PG8_STAGE(PG8_SA(1, 0), cA + kstep, voffA); PG8_STAGE(PG8_SB(1, 1), cB + hstep + kstep, voffB);
        PG8_WAIT_V(6); PG8_BAR;
    }
    for (;;) {
        const bool has_next = S.next(ui + 1, nxt);
        const char* nA = has_next ? (const char*)g.A + (size_t)nxt.pm * tstep : cA; const char* nB = has_next ? (const char*)g.Bt + (size_t)nxt.pn * tstep : cB;
        for (int t = 0; t < nt; t += 2) {
            const bool last = (t == nt - 2);
            const char* a1 = cA + (size_t)(t + 1) * kstep;
            const char* a2 = last ? nA : cA + (size_t)(t + 2) * kstep; const char* b2 = last ? nB : cB + (size_t)(t + 2) * kstep;
            const char* a3 = a2 + kstep; const char* b3 = b2 + kstep;
            if (last && has_next) S.a_ready(nxt);
            if constexpr (SP2) {
            PG8_LDB(B0, 0, 0); PG8_LDB(B1, 0, 1); PG8_SCHED; PG8_LDA(At, 0, 0); PG8_STAGE(PG8_SA(1, 1), a1 + hstep, voffA);
            PG8_WAIT_V(8); PG8_WAIT_L(0); PG8_BAR; PG8_MMA(0, 0, At, B0); PG8_MMA(0, 1, At, B1); PG8_BAR; PG8_SCHED;
            PG8_LDA(At, 0, 1); PG8_STAGE(PG8_SB(0, 0), b2, voffB); PG8_STAGE(PG8_SB(0, 1), b2 + hstep, voffB); PG8_STAGE(PG8_SA(0, 0), a2, voffA);
            PG8_WAIT_V(8); PG8_WAIT_L(0); PG8_BAR; PG8_MMA(1, 0, At, B0); PG8_MMA(1, 1, At, B1); PG8_BAR; PG8_SCHED;
            PG8_LDB(B0, 1, 0); PG8_LDB(B1, 1, 1); PG8_SCHED; PG8_LDA(At, 1, 0); PG8_STAGE(PG8_SA(0, 1), a2 + hstep, voffA);
            PG8_WAIT_V(8); PG8_WAIT_L(0); PG8_BAR; PG8_MMA(0, 0, At, B0); PG8_MMA(0, 1, At, B1); PG8_BAR; PG8_SCHED;
            PG8_LDA(At, 1, 1); PG8_STAGE(PG8_SB(1, 0), b3, voffB); PG8_STAGE(PG8_SB(1, 1), b3 + hstep, voffB); PG8_STAGE(PG8_SA(1, 0), a3, voffA);
            PG8_WAIT_V(8); PG8_WAIT_L(0); PG8_BAR; PG8_MMA(1, 0, At, B0); PG8_MMA(1, 1, At, B1); PG8_BAR; PG8_SCHED;
            } else {
            PG8_LDB(B0, 0, 0); PG8_SCHED; PG8_LDA(At, 0, 0); PG8_STAGE(PG8_SA(1, 1), a1 + hstep, voffA);
            PG8_WAIT_L(8); PG8_BAR; PG8_WAIT_L(0); PG8_MMA(0, 0, At, B0); PG8_BAR; PG8_SCHED;
            PG8_LDB(B1, 0, 1); PG8_STAGE(PG8_SB(0, 0), b2, voffB);
            PG8_BAR; PG8_WAIT_L(0); PG8_MMA(0, 1, At, B1); PG8_BAR;
            PG8_LDA(At, 0, 1); PG8_STAGE(PG8_SA(0, 0), a2, voffA);
            PG8_BAR; PG8_WAIT_L(0); PG8_MMA(1, 0, At, B0); PG8_BAR; PG8_SCHED;
            PG8_STAGE(PG8_SB(0, 1), b2 + hstep, voffB);
            PG8_WAIT_V(6); PG8_BAR; PG8_MMA(1, 1, At, B1); PG8_BAR;
            PG8_LDB(B0, 1, 0); PG8_SCHED; PG8_LDA(At, 1, 0); PG8_STAGE(PG8_SA(0, 1), a2 + hstep, voffA);
            PG8_WAIT_L(8); PG8_BAR; PG8_WAIT_L(0); PG8_MMA(0, 0, At, B0); PG8_BAR; PG8_SCHED;
            PG8_LDB(B1, 1, 1); PG8_STAGE(PG8_SB(1, 0), b3, voffB);
            PG8_BAR; PG8_WAIT_L(0); PG8_MMA(0, 1, At, B1); PG8_BAR;
            PG8_LDA(At, 1, 1); PG8_STAGE(PG8_SA(1, 0), a3, voffA);
            PG8_BAR; PG8_WAIT_L(0); PG8_MMA(1, 0, At, B0); PG8_BAR; PG8_SCHED;
            PG8_STAGE(PG8_SB(1, 1), b3 + hstep, voffB);
            PG8_WAIT_V(6); PG8_BAR; PG8_MMA(1, 1, At, B1); PG8_BAR;
            }
        }
        if constexpr (ALIGN_EPI) { if (wr == 0) PG8_BAR; }
        if constexpr (!Epi::AFTER_DRAIN) { E(acc, cur, wr, wc, fr, fq); S.done(cur); }
        if (!has_next) break;
#pragma unroll
        for (int a = 0; a < 2; ++a)
#pragma unroll
            for (int b = 0; b < 2; ++b)
#pragma unroll
                for (int m = 0; m < 4; ++m)
#pragma unroll
                    for (int n = 0; n < 2; ++n) acc[a][b][m][n] = (f32x4){0.f, 0.f, 0.f, 0.f};
        cur = nxt; cA = nA; cB = nB; ++ui;
        if constexpr (ALIGN_EPI) { if (wr == 1) PG8_BAR; }
    }
    PG8_WAIT_V(0);
    if constexpr (!ALIGN_EPI) { if (wr == 0) PG8_BAR; }
    PG8_BAR;
    if constexpr (Epi::AFTER_DRAIN) { E.fused(acc, cur, wr, wc, fr, fq, lds, wid, lane); S.done(cur); }
#undef PG8_SA
#undef PG8_SB
#undef PG8_STAGE
#undef PG8_LDA
#undef PG8_LDB
#undef PG8_MMA
#undef PG8_WAIT_V
#undef PG8_WAIT_L
#undef PG8_BAR
#undef PG8_SCHED
}
}

#define LAS __attribute__((address_space(3)))
typedef unsigned short bf16;
typedef float f32x4 __attribute__((ext_vector_type(4)));
typedef short bf16x8 __attribute__((ext_vector_type(8)));
typedef unsigned u32x4 __attribute__((ext_vector_type(4)));
typedef unsigned u32x2 __attribute__((ext_vector_type(2)));
constexpr int DM = 1024, NB = 8, SEQ = 2048, MP = NB * SEQ, NS = 128, MALL = MP + NS, NMEM = 256, FF = 2816, FF2 = 5632, MMEM = NB * NMEM;
constexpr float EPS = 1e-6f;
constexpr float QSCALE = 0.0625f * 1.4426950408889634f;
constexpr size_t O_Y = 0, O_YS = 16777216, O_PP = O_YS + 131072, O_PS = O_PP + 61440, O_CP = O_PS + 983040, O_CS = O_CP + 122880, O_MK = O_CS + 1966080, O_MV = O_MK + 2097152;
constexpr size_t MiB = 1u << 20;
constexpr size_t WS_CTL = 0, CTL_ZERO_BYTES = MiB;
constexpr size_t WS_WIN = 1 * MiB, WS_WKV = 4 * MiB, WS_WOUT = 8 * MiB, WS_WQ = 10 * MiB, WS_WO = 12 * MiB, WS_WGU = 14 * MiB, WS_WD = 25 * MiB, WS_WMAP = 31 * MiB;
constexpr size_t WS_HB = 32 * MiB, WS_AP = 65 * MiB, WS_GLU = 82 * MiB, WS_C = 99 * MiB, WS_X1 = 132 * MiB, WS_X1B = 197 * MiB, WS_Q = 230 * MiB, WS_KB = 263 * MiB, WS_VT = 267 * MiB;
constexpr size_t WS_O = 271 * MiB, WS_X2B = 304 * MiB, WS_F = 337 * MiB, WS_MB = 426 * MiB, WS_SSQ1 = 430 * MiB, WS_SSQ2 = 431 * MiB, WS_SSQ3 = 432 * MiB, WS_SSQS = 433 * MiB, WS_US = 434 * MiB, WS_HC = 435 * MiB;
constexpr size_t WS_HP = WS_HC + 512 * 1024, WS_END = 436 * MiB;
constexpr int LDS_BYTES = 147456;
constexpr int NPHASE = 10;

__device__ __forceinline__ float wave_sum(float v) {
#pragma unroll
    for (int o = 1; o < 64; o <<= 1) v += __shfl_xor(v, o);
    return v;
}
__device__ __forceinline__ float wave_max(float v) {
#pragma unroll
    for (int o = 1; o < 64; o <<= 1) v = fmaxf(v, __shfl_xor(v, o));
    return v;
}
__device__ __forceinline__ unsigned f2bf(float f) { unsigned u = __builtin_bit_cast(unsigned, f); return (u + 0x7fffu + ((u >> 16) & 1u)) >> 16; }
__device__ __forceinline__ unsigned pk2(float lo, float hi) { return f2bf(lo) | (f2bf(hi) << 16); }
__device__ __forceinline__ float bf2f(bf16 v) { return __builtin_bit_cast(float, (unsigned)v << 16); }
__device__ __forceinline__ float sigm(float x) { return __builtin_amdgcn_rcpf(1.0f + __builtin_amdgcn_exp2f(-1.4426950408889634f * x)); }
#define LDS_WAIT() asm volatile("s_waitcnt lgkmcnt(0)" ::: "memory")

__device__ __forceinline__ void transpose_item(const float* W, int K, int N, const float* gk, bf16* WT, int dst_row0, LAS float* scr, int k0, int n0, int lane) {
    f32x4 v[8];
#pragma unroll
    for (int i = 0; i < 8; ++i) { const int kk = (lane >> 3) + 8 * i; v[i] = *(const f32x4*)(W + (size_t)(k0 + kk) * N + n0 + 4 * (lane & 7)); }
    if (gk) {
#pragma unroll
        for (int i = 0; i < 8; ++i) v[i] = v[i] * gk[k0 + (lane >> 3) + 8 * i]; }
#pragma unroll
    for (int i = 0; i < 8; ++i) { LAS float* d = scr + ((lane >> 3) + 8 * i) * 33 + 4 * (lane & 7); d[0] = v[i].x; d[1] = v[i].y; d[2] = v[i].z; d[3] = v[i].w; }
    LDS_WAIT();
    const int c = lane & 7;
#pragma unroll
    for (int j = 0; j < 4; ++j) { const int n = (lane >> 3) + 8 * j; const LAS float* s = scr + (8 * c) * 33 + n;
        u32x4 o; o.x = pk2(s[0 * 33], s[1 * 33]); o.y = pk2(s[2 * 33], s[3 * 33]); o.z = pk2(s[4 * 33], s[5 * 33]); o.w = pk2(s[6 * 33], s[7 * 33]);
        *(u32x4*)(WT + (size_t)(dst_row0 + n) * K + k0 + 8 * c) = o; }
    LDS_WAIT();
}
__device__ __forceinline__ void rms_load(const float* xrow, int lane, f32x4 (&v)[4]) {
    const f32x4* xr = (const f32x4*)xrow + lane;
#pragma unroll
    for (int j = 0; j < 4; ++j) v[j] = xr[64 * j];
}
__device__ __forceinline__ void rms_finish(const f32x4 (&v)[4], const float* g, bf16* orow, int lane) {
    const f32x4* gr = (const f32x4*)g + lane; float s = 0.f;
#pragma unroll
    for (int j = 0; j < 4; ++j) s += (v[j].x * v[j].x + v[j].y * v[j].y) + (v[j].z * v[j].z + v[j].w * v[j].w);
    const float rstd = 1.0f / sqrtf(wave_sum(s) * (1.0f / DM) + EPS);
    unsigned long long* o8 = (unsigned long long*)orow + lane;
#pragma unroll
    for (int j = 0; j < 4; ++j) { const f32x4 gg = gr[64 * j]; const f32x4 o = v[j] * rstd * gg;
        o8[64 * j] = (unsigned long long)pk2(o.x, o.y) | ((unsigned long long)pk2(o.z, o.w) << 32); }
}

struct Args { const float* in[28]; float* out; unsigned char* ws; int ph_lo, ph_hi; };

__device__ __forceinline__ void p0_prologue(const Args& a, LAS unsigned char* lds, int bid, int G, int tid, int lane, int wave) {
    unsigned char* ws = a.ws;
    LAS float* scr = (LAS float*)(lds + wave * 16384);
    const int gw = bid * 8 + wave, NGW = G * 8;
    constexpr int I_IN = 16 * 48, I_SQ = 16 * 32, I_GU = 16 * 88, I_D = 44 * 32, I_PM = 2 * 4;
    constexpr int NITEMS = I_IN + 5 * I_SQ + 2 * I_GU + I_D + 4 * I_PM;
    for (int it = gw; it < NITEMS; it += NGW) {
        int r = it;
        if (r < I_IN) { const int kb = r / 48, n0 = (r % 48) * 32; int dr;
            if (n0 < 512) dr = n0; else { int j = n0 - 512; int hi = 0; if (j >= 512) { j -= 512; hi = 128; } dr = 512 + (j >> 7) * 256 + hi + (j & 127); }
            transpose_item(a.in[8], 1024, 1536, nullptr, (bf16*)(ws + WS_WIN), dr, scr, 64 * kb, n0, lane); continue; } r -= I_IN;
        if (r < I_SQ) { transpose_item(a.in[20], 1024, 1024, nullptr, (bf16*)(ws + WS_WKV), (r % 32) * 32, scr, 64 * (r / 32), (r % 32) * 32, lane); continue; } r -= I_SQ;
        if (r < I_SQ) { transpose_item(a.in[21], 1024, 1024, nullptr, (bf16*)(ws + WS_WKV), 1024 + (r % 32) * 32, scr, 64 * (r / 32), (r % 32) * 32, lane); continue; } r -= I_SQ;
        if (r < I_SQ) { transpose_item(a.in[16], 1024, 1024, nullptr, (bf16*)(ws + WS_WOUT), (r % 32) * 32, scr, 64 * (r / 32), (r % 32) * 32, lane); continue; } r -= I_SQ;
        if (r < I_SQ) { transpose_item(a.in[19], 1024, 1024, a.in[17], (bf16*)(ws + WS_WQ), (r % 32) * 32, scr, 64 * (r / 32), (r % 32) * 32, lane); continue; } r -= I_SQ;
        if (r < I_SQ) { transpose_item(a.in[22], 1024, 1024, nullptr, (bf16*)(ws + WS_WO), (r % 32) * 32, scr, 64 * (r / 32), (r % 32) * 32, lane); continue; } r -= I_SQ;
        if (r < I_GU) { const int n0 = (r % 88) * 32; transpose_item(a.in[24], 1024, FF, a.in[23], (bf16*)(ws + WS_WGU), (n0 >> 7) * 256 + (n0 & 127), scr, 64 * (r / 88), n0, lane); continue; } r -= I_GU;
        if (r < I_GU) { const int n0 = (r % 88) * 32; transpose_item(a.in[25], 1024, FF, a.in[23], (bf16*)(ws + WS_WGU), (n0 >> 7) * 256 + 128 + (n0 & 127), scr, 64 * (r / 88), n0, lane); continue; } r -= I_GU;
        if (r < I_D) { transpose_item(a.in[26], FF, 1024, nullptr, (bf16*)(ws + WS_WD), (r % 32) * 32, scr, 64 * (r / 32), (r % 32) * 32, lane); continue; } r -= I_D;
        { const int g = r / I_PM, q = r % I_PM; transpose_item(a.in[9] + (size_t)g * 16384, 128, 128, nullptr, (bf16*)(ws + WS_WMAP) + (size_t)g * 16384, (q % 4) * 32, scr, 64 * (q / 4), (q % 4) * 32, lane); }
    }
#define ROW_SRC(m) ((m) < MP ? a.in[0] + (size_t)(m) * DM : ((m) < MALL ? a.in[1] + (size_t)((m) - MP) * DM : a.in[2] + (size_t)((m) - MALL) * DM))
    { f32x4 cur[4], nxt[4]; int m = gw;
      if (m < MALL + MMEM) rms_load(ROW_SRC(m), lane, cur);
      for (; m < MALL + MMEM; m += NGW) { const int mn = m + NGW;
          if (mn < MALL + MMEM) rms_load(ROW_SRC(mn), lane, nxt);
          if (m < MALL) rms_finish(cur, a.in[7], (bf16*)(ws + WS_HB) + (size_t)m * DM, lane);
          else rms_finish(cur, a.in[18], (bf16*)(ws + WS_MB) + (size_t)(m - MALL) * DM, lane);
#pragma unroll
          for (int j = 0; j < 4; ++j) cur[j] = nxt[j]; } }
#undef ROW_SRC
    const float* spool = a.in[3]; const float* sconv = a.in[4]; const float* wdw = a.in[12]; const float* bdw = a.in[13];
    float* HC = (float*)(ws + WS_HC); float* HP = (float*)(ws + WS_HP);
    for (int e2 = bid * 512 + tid; e2 < 2 * NS * 512; e2 += G * 512) {
        const int e = e2 & (NS * 512 - 1), b = e >> 9, ch = e & 511;
        if (e2 < NS * 512) {
            float v[30];
#pragma unroll
            for (int j = 0; j < 30; ++j) v[j] = sconv[(size_t)(b * 30 + j) * 512 + ch];
            float acc = bdw[ch];
#pragma unroll
            for (int j = 0; j < 30; ++j) { acc += wdw[j * 512 + ch] * v[j]; if (j >= 1) a.out[O_CS + (size_t)(b * 30 + j - 1) * 512 + ch] = v[j]; }
            HC[e] = acc;
        } else {
            float v[15];
#pragma unroll
            for (int j = 0; j < 15; ++j) v[j] = spool[(size_t)(b * 15 + j) * 512 + ch];
            const int w = 2 << (ch >> 7); float sacc = 0.f;
#pragma unroll
            for (int j = 0; j < 15; ++j) { if (j >= 1) a.out[O_PS + (size_t)(b * 15 + j - 1) * 512 + ch] = v[j]; if (j >= 16 - w) sacc += v[j]; }
            HP[e] = sacc;
        }
    }
}

template <bool PAIR, class Fn>
__device__ __forceinline__ void skinny(const bf16* A, const bf16* Bt, int K, int nColBlk, int c, int G, LAS float* red, int tid, const Fn& fn) {
    const int lane = tid & 63, wave = __builtin_amdgcn_readfirstlane(tid >> 6), fr = lane & 15, fq = lane >> 4;
    const int nItems = nColBlk * 4, kw = K >> 3;
    for (int it = c; it < nItems; it += G) {
        const int rb = it & 3, cb = it >> 2;
        const int n0 = PAIR ? ((cb >> 3) * 256 + (cb & 7) * 16) : cb * 16;
        const bf16* ap = A + (size_t)(32 * rb + fr) * K + wave * kw + 8 * fq;
        const bf16* bp = Bt + (size_t)(n0 + fr) * K + wave * kw + 8 * fq;
        f32x4 c00 = {0.f, 0.f, 0.f, 0.f}, c01 = c00, c10 = c00, c11 = c00;
        for (int ks = 0; ks < kw; ks += 32) {
            const bf16x8 b0 = *(const bf16x8*)(bp + ks), a0 = *(const bf16x8*)(ap + ks), a1 = *(const bf16x8*)(ap + (size_t)16 * K + ks);
            c00 = __builtin_amdgcn_mfma_f32_16x16x32_bf16(b0, a0, c00, 0, 0, 0); c01 = __builtin_amdgcn_mfma_f32_16x16x32_bf16(b0, a1, c01, 0, 0, 0);
            if (PAIR) { const bf16x8 b1 = *(const bf16x8*)(bp + (size_t)128 * K + ks);
                c10 = __builtin_amdgcn_mfma_f32_16x16x32_bf16(b1, a0, c10, 0, 0, 0); c11 = __builtin_amdgcn_mfma_f32_16x16x32_bf16(b1, a1, c11, 0, 0, 0); }
        }
        LAS float* rw = red + wave * 1024;
        *(LAS f32x4*)(rw + fr * 16 + 4 * fq) = c00; *(LAS f32x4*)(rw + (16 + fr) * 16 + 4 * fq) = c01;
        if (PAIR) { *(LAS f32x4*)(rw + 512 + fr * 16 + 4 * fq) = c10; *(LAS f32x4*)(rw + 512 + (16 + fr) * 16 + 4 * fq) = c11; }
        __syncthreads();
        float v0 = 0.f, v1 = 0.f;
#pragma unroll
        for (int w = 0; w < 8; ++w) { v0 += red[w * 1024 + tid]; if (PAIR) v1 += red[w * 1024 + 512 + tid]; }
        fn(32 * rb + (tid >> 4), cb * 16 + (tid & 15), cb, v0, v1);
        __syncthreads();
    }
}
__device__ __forceinline__ float red16(float s) { s += __shfl_xor(s, 1); s += __shfl_xor(s, 2); s += __shfl_xor(s, 4); s += __shfl_xor(s, 8); return s; }
__device__ __forceinline__ float rstd_s(const float* p, int row, int ci) {
    const float* q = p + row * 64 + ci; return 1.0f / sqrtf(red16((q[0] + q[16]) + (q[32] + q[48])) * (1.0f / DM) + EPS);
}
struct SkRaw { float* O; int ld; __device__ __forceinline__ void operator()(int row, int col, int, float v0, float) const { O[(size_t)row * ld + col] = v0; } };
template <bool RES_BF16> struct SkRes { const void* resid; bf16* xb; float* ssq;
    __device__ __forceinline__ void operator()(int row, int col, int cb, float v0, float) const {
        const size_t off = (size_t)row * DM + col; const float r = RES_BF16 ? bf2f(((const bf16*)resid)[off]) : ((const float*)resid)[off];
        const float x = r + v0; xb[off] = (bf16)f2bf(x);
        const float ss = red16(x * x); if ((col & 15) == 0) ssq[row * 64 + cb] = ss; } };
struct SkQ { const float* ssq; bf16* Q; __device__ __forceinline__ void operator()(int row, int col, int, float v0, float) const {
        const float rs = rstd_s(ssq, row, col & 15) * QSCALE; Q[(size_t)row * DM + col] = (bf16)f2bf(v0 * rs); } };
struct SkGU { const float* ssq; bf16* F; __device__ __forceinline__ void operator()(int row, int col, int, float v0, float v1) const {
        const float rs = rstd_s(ssq, row, col & 15); const float g = v0 * rs; F[(size_t)row * FF + col] = (bf16)f2bf(g * sigm(g) * (v1 * rs)); } };

constexpr int MX_TG = 0, MX_TA = 46 * 1024, MX_YC = MX_TA + 31 * 1024, MX_D = MX_YC + 16 * 2048, MX_DSTRIDE = 1040, MX_NPIECE = (46 + 31) * 64;
static_assert(MX_D + 16 * MX_DSTRIDE <= 131072, "mixer LDS");
template <int W> __device__ __forceinline__ void pool16(int t0, int tid, LAS unsigned char* lds) {
    float in[16 + W - 1];
#pragma unroll
    for (int i = 0; i < 16 + W - 1; ++i) in[i] = bf2f(*(const LAS bf16*)(lds + MX_TA + (16 - W + i) * 1024 + tid * 2));
#pragma unroll
    for (int r = 0; r < 16; ++r) { float s = 0.f;
#pragma unroll
        for (int j = 0; j < W; ++j) s += in[r + j];
        const int t = t0 + r; const int cnt = (t + 1 < W) ? (t + 1) : W;
        const float d = s / (float)cnt - in[r + W - 1];
        *(LAS bf16*)(lds + MX_D + r * MX_DSTRIDE + tid * 2) = (bf16)f2bf(d); }
}
__device__ __forceinline__ void mixer_finish(const Args& a, LAS unsigned char* lds, int crow0, int tid, int lane, int wave) {
    bf16* C = (bf16*)(a.ws + WS_C);
    const LAS float* yc = (const LAS float*)(lds + MX_YC);
    { const f32x4 g0 = *(const f32x4*)(a.in[14] + lane * 8), g1 = *(const f32x4*)(a.in[14] + lane * 8 + 4), b0 = *(const f32x4*)(a.in[15] + lane * 8), b1 = *(const f32x4*)(a.in[15] + lane * 8 + 4);
#pragma unroll
      for (int i = 0; i < 2; ++i) { const int r = 2 * wave + i;
        const f32x4 y0 = *(const LAS f32x4*)(yc + r * 512 + lane * 8), y1 = *(const LAS f32x4*)(yc + r * 512 + lane * 8 + 4);
        const float mu = wave_sum((y0.x + y0.y) + (y0.z + y0.w) + (y1.x + y1.y) + (y1.z + y1.w)) * (1.0f / 512.0f);
        const f32x4 d0 = y0 - mu, d1 = y1 - mu;
        const float var = wave_sum((d0.x * d0.x + d0.y * d0.y) + (d0.z * d0.z + d0.w * d0.w) + (d1.x * d1.x + d1.y * d1.y) + (d1.z * d1.z + d1.w * d1.w)) * (1.0f / 512.0f);
        const float rs = 1.0f / sqrtf(var + EPS);
        f32x4 n0 = d0 * rs * g0 + b0, n1 = d1 * rs * g1 + b1;
#pragma unroll
        for (int j = 0; j < 4; ++j) { n0[j] = n0[j] * sigm(n0[j]); n1[j] = n1[j] * sigm(n1[j]); }
        u32x4 o; o.x = pk2(n0.x, n0.y); o.y = pk2(n0.z, n0.w); o.z = pk2(n1.x, n1.y); o.w = pk2(n1.z, n1.w);
        *(u32x4*)(C + (size_t)(crow0 + r) * DM + 512 + lane * 8) = o; } }
    { const int g = wave >> 1, nh = wave & 1, fr = lane & 15, fq = lane >> 4;
      const bf16* WT = (const bf16*)(a.ws + WS_WMAP) + (size_t)g * 16384;
      f32x4 acc[4];
#pragma unroll
      for (int nb = 0; nb < 4; ++nb) acc[nb] = (f32x4){0.f, 0.f, 0.f, 0.f};
#pragma unroll
      for (int kc = 0; kc < 4; ++kc) {
          const bf16x8 af = *(const LAS bf16x8*)(lds + MX_D + fr * MX_DSTRIDE + (g * 128 + 32 * kc + 8 * fq) * 2);
#pragma unroll
          for (int nb = 0; nb < 4; ++nb) { const bf16x8 bf = *(const bf16x8*)(WT + (size_t)(64 * nh + 16 * nb + fr) * 128 + 32 * kc + 8 * fq);
              acc[nb] = __builtin_amdgcn_mfma_f32_16x16x32_bf16(bf, af, acc[nb], 0, 0, 0); }
      }
#pragma unroll
      for (int nb = 0; nb < 4; ++nb) { const int ch = g * 128 + 64 * nh + 16 * nb + 4 * fq;
          const f32x4 bm = *(const f32x4*)(a.in[10] + ch), sc = *(const f32x4*)(a.in[11] + ch);
          const f32x4 y = (acc[nb] + bm) * sc; u32x2 o; o.x = pk2(y.x, y.y); o.y = pk2(y.z, y.w);
          *(u32x2*)(C + (size_t)(crow0 + fr) * DM + ch) = o; } }
}
__device__ __forceinline__ void mixer_phase(const Args& a, LAS unsigned char* lds, int bid, int G, int tid, int lane, int wave) {
    const bf16* GLU = (const bf16*)(a.ws + WS_GLU); const bf16* AP = (const bf16*)(a.ws + WS_AP);
    LAS float* yc = (LAS float*)(lds + MX_YC);
    u32x4 pr[10];
#define MX_LOAD(u) do { const int b_ = (u) >> 7, t0_ = ((u) & 127) * 16; _Pragma("unroll") for (int i = 0; i < 10; ++i) { const int p = tid + 512 * i; \
        if (p < MX_NPIECE) { const bool isg = p < 46 * 64; const int q = isg ? p : p - 46 * 64; const int t = t0_ - (isg ? 30 : 15) + (q >> 6); const int tt = t < 0 ? 0 : t; \
            const u32x4 v = *(const u32x4*)((isg ? GLU : AP) + (size_t)(b_ * SEQ + tt) * 512 + (q & 63) * 8); pr[i] = t >= 0 ? v : (u32x4){0u, 0u, 0u, 0u}; } } } while (0)
    int u = bid; bool have = u < 1024;
    if (have) MX_LOAD(u);
    float w[31];
#pragma unroll
    for (int j = 0; j < 31; ++j) w[j] = a.in[12][j * 512 + tid];
    const float bias = a.in[13][tid];
    while (have) {
        __syncthreads();
#pragma unroll
        for (int i = 0; i < 10; ++i) { const int p = tid + 512 * i; if (p < MX_NPIECE) *(LAS u32x4*)(lds + p * 16) = pr[i]; }
        __syncthreads();
        const int b = u >> 7, t0 = (u & 127) * 16;
        const int un = u + G; const bool hn = un < 1024;
        if (hn) MX_LOAD(un);
        { float in[46];
#pragma unroll
          for (int i = 0; i < 46; ++i) in[i] = bf2f(*(const LAS bf16*)(lds + MX_TG + i * 1024 + tid * 2));
#pragma unroll
          for (int r = 0; r < 16; ++r) { float acc = bias;
#pragma unroll
              for (int j = 0; j < 31; ++j) acc += w[j] * in[r + j];
              yc[r * 512 + tid] = acc; } }
        { const int g = tid >> 7;
          if (g == 0) pool16<2>(t0, tid, lds); else if (g == 1) pool16<4>(t0, tid, lds); else if (g == 2) pool16<8>(t0, tid, lds); else pool16<16>(t0, tid, lds); }
        __syncthreads();
        mixer_finish(a, lds, b * SEQ + t0, tid, lane, wave);
        u = un; have = hn;
    }
#undef MX_LOAD
    const float* US = (const float*)(a.ws + WS_US); const float* HC = (const float*)(a.ws + WS_HC); const float* HP = (const float*)(a.ws + WS_HP);
    for (int su = (bid + 8) % G; su < 8; su += G) {
        __syncthreads();
        const float w30 = w[30]; const int wdt = 2 << (tid >> 7); const float invw = 1.0f / (float)wdt;
        const int gcol = 512 + (tid >> 7) * 256 + (tid & 127);
#pragma unroll
        for (int s2 = 0; s2 < 16; ++s2) { const int bs = 16 * su + s2;
            const float val = US[(size_t)bs * 1536 + gcol], gate = US[(size_t)bs * 1536 + gcol + 128], av = US[(size_t)bs * 1536 + tid];
            const float glu = val * sigm(gate);
            a.out[O_CS + (size_t)(bs * 30 + 29) * 512 + tid] = glu; a.out[O_PS + (size_t)(bs * 15 + 14) * 512 + tid] = av;
            yc[s2 * 512 + tid] = HC[bs * 512 + tid] + w30 * glu;
            const float d = (av + HP[bs * 512 + tid]) * invw - av;
            *(LAS bf16*)(lds + MX_D + s2 * MX_DSTRIDE + tid * 2) = (bf16)f2bf(d); }
        __syncthreads();
        mixer_finish(a, lds, MP + 16 * su, tid, lane, wave);
    }
    __syncthreads();
}

constexpr int AT_K = 0, AT_KSTR = 528, AT_V = 64 * AT_KSTR, AT_VSTR = 144;
__device__ __forceinline__ float fexp2(float x) { return __builtin_amdgcn_exp2f(x); }
__device__ __forceinline__ void attn_prompt_unit(const Args& a, LAS unsigned char* lds, int u, int tid, int lane, int wave) {
    const int qb = u & 15, h = (u >> 4) & 3, b = u >> 6, fr = lane & 15, fq = lane >> 4;
    const bf16* Q = (const bf16*)(a.ws + WS_Q); const bf16* KB = (const bf16*)(a.ws + WS_KB); const bf16* VT = (const bf16*)(a.ws + WS_VT); bf16* O = (bf16*)(a.ws + WS_O);
    const size_t rowq = (size_t)b * SEQ + qb * 128 + wave * 16 + fr;
    bf16x8 qf[8];
#pragma unroll
    for (int kd = 0; kd < 8; ++kd) qf[kd] = *(const bf16x8*)(Q + rowq * DM + h * 256 + 32 * kd + 8 * fq);
    f32x4 o[16];
#pragma unroll
    for (int i = 0; i < 16; ++i) o[i] = (f32x4){0.f, 0.f, 0.f, 0.f};
    float mrun = -INFINITY, lrun = 0.f;
    u32x4 kr[4], vr[4];
#define AT_LOAD(c) do { _Pragma("unroll") for (int i = 0; i < 4; ++i) { const int p = tid + 512 * i; \
        kr[i] = *(const u32x4*)(KB + (size_t)(b * 256 + 64 * (c) + (p >> 5)) * DM + h * 256 + (p & 31) * 8); \
        vr[i] = *(const u32x4*)(VT + (size_t)(h * 256 + (p >> 3)) * 2048 + b * 256 + 64 * (c) + (p & 7) * 8); } } while (0)
    AT_LOAD(0);
#pragma unroll 1
    for (int c = 0; c < 4; ++c) {
        __syncthreads();
#pragma unroll
        for (int i = 0; i < 4; ++i) { const int p = tid + 512 * i;
            *(LAS u32x4*)(lds + AT_K + (p >> 5) * AT_KSTR + (p & 31) * 16) = kr[i];
            *(LAS u32x4*)(lds + AT_V + (p >> 3) * AT_VSTR + (p & 7) * 16) = vr[i]; }
        __syncthreads();
        if (c < 3) AT_LOAD(c + 1);
        f32x4 s[4];
#pragma unroll
        for (int nb = 0; nb < 4; ++nb) { s[nb] = (f32x4){0.f, 0.f, 0.f, 0.f};
#pragma unroll
            for (int kd = 0; kd < 8; ++kd) { const bf16x8 kf = *(const LAS bf16x8*)(lds + AT_K + (16 * nb + fr) * AT_KSTR + kd * 64 + fq * 16);
                s[nb] = __builtin_amdgcn_mfma_f32_16x16x32_bf16(kf, qf[kd], s[nb], 0, 0, 0); } }
        float mx = s[0][0];
#pragma unroll
        for (int nb = 0; nb < 4; ++nb)
#pragma unroll
            for (int j = 0; j < 4; ++j) mx = fmaxf(mx, s[nb][j]);
        mx = fmaxf(mx, __shfl_xor(mx, 16)); mx = fmaxf(mx, __shfl_xor(mx, 32));
        const float mnew = fmaxf(mrun, mx), alpha = fexp2(mrun - mnew);
        float ps = 0.f;
#pragma unroll
        for (int nb = 0; nb < 4; ++nb)
#pragma unroll
            for (int j = 0; j < 4; ++j) { s[nb][j] = fexp2(s[nb][j] - mnew); ps += s[nb][j]; }
        ps += __shfl_xor(ps, 16); ps += __shfl_xor(ps, 32);
        lrun = lrun * alpha + ps; mrun = mnew;
#pragma unroll
        for (int i = 0; i < 16; ++i) o[i] = o[i] * alpha;
#pragma unroll
        for (int kb = 0; kb < 2; ++kb) {
            u32x4 pw; pw.x = pg8::cvt_pk_bf16(s[2 * kb][0], s[2 * kb][1]); pw.y = pg8::cvt_pk_bf16(s[2 * kb][2], s[2 * kb][3]);
            pw.z = pg8::cvt_pk_bf16(s[2 * kb + 1][0], s[2 * kb + 1][1]); pw.w = pg8::cvt_pk_bf16(s[2 * kb + 1][2], s[2 * kb + 1][3]);
            const bf16x8 pf = __builtin_bit_cast(bf16x8, pw);
#pragma unroll
            for (int db = 0; db < 16; ++db) {
                const u32x2 v0 = *(const LAS u32x2*)(lds + AT_V + (16 * db + fr) * AT_VSTR + kb * 64 + fq * 8), v1 = *(const LAS u32x2*)(lds + AT_V + (16 * db + fr) * AT_VSTR + kb * 64 + 32 + fq * 8);
                u32x4 vw; vw.x = v0.x; vw.y = v0.y; vw.z = v1.x; vw.w = v1.y;
                o[db] = __builtin_amdgcn_mfma_f32_16x16x32_bf16(__builtin_bit_cast(bf16x8, vw), pf, o[db], 0, 0, 0); }
        }
    }
#undef AT_LOAD
    const float inv = 1.0f / lrun;
#pragma unroll
    for (int db = 0; db < 16; ++db) { const f32x4 y = o[db] * inv; u32x2 w; w.x = pg8::cvt_pk_bf16(y.x, y.y); w.y = pg8::cvt_pk_bf16(y.z, y.w);
        *(u32x2*)(O + rowq * DM + h * 256 + 16 * db + 4 * fq) = w; }
}
__device__ __forceinline__ float rdlane(float v, int l) { return __builtin_bit_cast(float, __builtin_amdgcn_readlane(__builtin_bit_cast(int, v), l)); }
__device__ __forceinline__ void attn_sample_item(const Args& a, LAS unsigned char* lds, int item, int tid, int lane, int wave) {
    const int u = 2 * item + (wave >> 2), qt = wave & 3, b = u >> 2, h = u & 3;
    const bf16* Q = (const bf16*)(a.ws + WS_Q) + (size_t)(MP + b) * DM + h * 256;
    const float* ck = a.in[5] + ((size_t)(b * 256 + 64 * qt) * 4 + h) * 256 + lane * 4; const float* cv = a.in[6] + ((size_t)(b * 256 + 64 * qt) * 4 + h) * 256 + lane * 4;
    const u32x2 qw = *(const u32x2*)(Q + lane * 4);
    const f32x4 q = {__builtin_bit_cast(float, qw.x << 16), __builtin_bit_cast(float, qw.x & 0xffff0000u), __builtin_bit_cast(float, qw.y << 16), __builtin_bit_cast(float, qw.y & 0xffff0000u)};
    f32x4 A[8], B[8];
#define SA_PTR(j) (((j) < 8 ? ck : cv) + (size_t)(((j) & 7) * 8) * 1024)
#define SA_LOAD(buf, j) do { const float* bp_ = SA_PTR(j); _Pragma("unroll") for (int i = 0; i < 8; ++i) buf[i] = __builtin_nontemporal_load((const f32x4*)(bp_ + (size_t)i * 1024)); } while (0)
#define SA_DOTS(buf, j) do { _Pragma("unroll") for (int i = 0; i < 8; ++i) { const float sd = wave_sum((buf[i].x * q.x + buf[i].y * q.y) + (buf[i].z * q.z + buf[i].w * q.w)); mine = (lane == 8 * (j) + i) ? sd : mine; } } while (0)
#define SA_ACC(buf, j) do { _Pragma("unroll") for (int i = 0; i < 8; ++i) { const float pi = pl[8 * (j) + i]; acc += buf[i] * pi; } } while (0)
    float mine = 0.f;
    SA_LOAD(A, 0); SA_LOAD(B, 1);
#pragma unroll 1
    for (int j = 0; j < 8; j += 2) { SA_DOTS(A, j); SA_LOAD(A, j + 2); SA_DOTS(B, j + 1); SA_LOAD(B, j + 3); }
    const float mloc = wave_max(mine); const float p = fexp2(mine - mloc); const float lloc = wave_sum(p);
    LAS float* pl = (LAS float*)(lds + 16384) + wave * 64;
    pl[lane] = p; LDS_WAIT();
    f32x4 acc = {0.f, 0.f, 0.f, 0.f};
#pragma unroll 1
    for (int j = 0; j < 8; j += 2) { SA_ACC(A, j); if (j + 2 < 8) SA_LOAD(A, j + 10); SA_ACC(B, j + 1); if (j + 2 < 8) SA_LOAD(B, j + 11); }
#undef SA_PTR
#undef SA_LOAD
#undef SA_DOTS
#undef SA_ACC
    LAS float* po = (LAS float*)lds; LAS float* ml = po + 8 * 256;
    __syncthreads();
    *(LAS f32x4*)(po + wave * 256 + lane * 4) = acc; if (lane == 0) { ml[2 * wave] = mloc; ml[2 * wave + 1] = lloc; }
    __syncthreads();
    { const int ul = tid >> 8, d = tid & 255;
      const float m0 = ml[8 * ul], m1 = ml[8 * ul + 2], m2 = ml[8 * ul + 4], m3 = ml[8 * ul + 6];
      const float M = fmaxf(fmaxf(m0, m1), fmaxf(m2, m3));
      const float e0 = fexp2(m0 - M), e1 = fexp2(m1 - M), e2 = fexp2(m2 - M), e3 = fexp2(m3 - M);
      const float den = (e0 * ml[8 * ul + 1] + e1 * ml[8 * ul + 3]) + (e2 * ml[8 * ul + 5] + e3 * ml[8 * ul + 7]);
      const float num = (e0 * po[(4 * ul) * 256 + d] + e1 * po[(4 * ul + 1) * 256 + d]) + (e2 * po[(4 * ul + 2) * 256 + d] + e3 * po[(4 * ul + 3) * 256 + d]);
      const int uu = 2 * item + ul;
      ((bf16*)(a.ws + WS_O))[(size_t)(MP + (uu >> 2)) * DM + (uu & 3) * 256 + d] = (bf16)f2bf(num / den); }
    __syncthreads();
}

#define XB_TMO      128
#define XB_XCNT(j)  (256  + 64 * (j))
#define XB_XSUB(j)  (1280 + 64 * (j))
#define XB_XGEN(j)  (2304 + 64 * (j))
#define XB_TOP      3328
#define XB_TOPGEN   3392
#define XCD_BAR_WORDS 3456
#define XB_SPIN_CAP (1u << 18)

__device__ __forceinline__ unsigned xb_ld(unsigned* p)              { return __hip_atomic_load(p, __ATOMIC_RELAXED, __HIP_MEMORY_SCOPE_AGENT); }
__device__ __forceinline__ unsigned xb_add(unsigned* p, unsigned v) { return __hip_atomic_fetch_add(p, v, __ATOMIC_RELAXED, __HIP_MEMORY_SCOPE_AGENT); }
__device__ __forceinline__ unsigned xb_xcc_id() { return (unsigned)__builtin_amdgcn_s_getreg((3 << 11) | 20) & 0xFu; }
#define XB_SPIN(cond, bar) do { unsigned _sp = 0; while (cond) { __builtin_amdgcn_s_sleep(1); \
    if ((++_sp & 255u) == 0u) { if (xb_ld(&(bar)[XB_TMO])) break; if (_sp > XB_SPIN_CAP) { atomicAdd(&(bar)[XB_TMO], 1u); break; } } } } while (0)

struct XcdBarrier {
    unsigned* bar; unsigned x;
    volatile LAS unsigned* st;
};

__device__ __forceinline__ XcdBarrier xcd_barrier_post(unsigned* bar, volatile LAS unsigned* st) {
    XcdBarrier b; b.bar = bar; b.x = xb_xcc_id(); b.st = st;
    if (threadIdx.x == 0) (void)xb_add(&bar[XB_XCNT(b.x)], 1u);
    return b;
}
__device__ __forceinline__ void xcd_barrier_complete(unsigned* bar, unsigned x, unsigned& nloc, unsigned& nx) {
    const unsigned G = gridDim.x * gridDim.y * gridDim.z;
    unsigned sum, cnt, mine, sp = 0u;
    for (;;) {
        sum = 0u; cnt = 0u; mine = 0u;
#pragma unroll
        for (unsigned j = 0; j < 16; ++j) { const unsigned c = xb_ld(&bar[XB_XCNT(j)]); sum += c; cnt += (c > 0u) ? 1u : 0u; mine = (j == x) ? c : mine; }
        if (sum == G) break;
        __builtin_amdgcn_s_sleep(1);
        if ((++sp & 255u) == 0u) { if (xb_ld(&bar[XB_TMO])) break; if (sp > XB_SPIN_CAP) { atomicAdd(&bar[XB_TMO], 1u); break; } }
    }
    nloc = mine > 0u ? mine : 1u; nx = cnt > 0u ? cnt : 1u;
}

__device__ __forceinline__ void xcd_barrier(const XcdBarrier& b) {
    asm volatile("s_waitcnt vmcnt(0)" ::: "memory");
    __syncthreads();
    if (threadIdx.x == 0) {
        unsigned* bar = b.bar;
        __builtin_amdgcn_s_waitcnt(0);
        unsigned nloc = b.st[0], nx = b.st[1];
        if (nloc == 0u) { xcd_barrier_complete(bar, b.x, nloc, nx); b.st[0] = nloc; b.st[1] = nx; }
        const unsigned old = xb_add(&bar[XB_XSUB(b.x)], 1u);
        const unsigned gen = old / nloc;
        if (old + 1u == (gen + 1u) * nloc) {
            __builtin_amdgcn_fence(__ATOMIC_RELEASE, "agent");
            asm volatile("s_waitcnt vmcnt(0)" ::: "memory");
            const unsigned og = xb_add(&bar[XB_TOP], 1u);
            const unsigned tg = og / nx;
            if (og + 1u == (tg + 1u) * nx) xb_add(&bar[XB_TOPGEN], 1u);
            else XB_SPIN(xb_ld(&bar[XB_TOPGEN]) == tg, bar);
            __builtin_amdgcn_fence(__ATOMIC_ACQUIRE, "agent");
            xb_add(&bar[XB_XGEN(b.x)], 1u);
            asm volatile("s_waitcnt vmcnt(0)" ::: "memory");
        } else {
            XB_SPIN(xb_ld(&bar[XB_XGEN(b.x)]) == gen, bar);
            __builtin_amdgcn_fence(__ATOMIC_ACQUIRE, "agent");
            asm volatile("s_waitcnt vmcnt(0)" ::: "memory");
        }
    }
    __syncthreads();
}

constexpr int CW_BAR = 4096;
constexpr int MISC_OFF = 131072 + 320;
__global__ void __launch_bounds__(512, 2) fwd_kernel(Args a) {
    extern __shared__ __attribute__((aligned(16))) unsigned char lds_raw[];
    LAS unsigned char* lds = (LAS unsigned char*)lds_raw;
    const int tid = threadIdx.x, lane = tid & 63, wave = __builtin_amdgcn_readfirstlane(tid >> 6);
    const int G = gridDim.x, bid = blockIdx.x;
    unsigned char* ws = a.ws;
    const int lo = a.ph_lo, hi = a.ph_hi;
    cg::grid_group grid = cg::this_grid();
    for (int u = tid; u < (LDS_BYTES - 131072) / 4; u += 512) ((LAS unsigned*)(lds + 131072))[u] = 0u;
    __syncthreads();
    volatile LAS unsigned* MISC = (volatile LAS unsigned*)(lds + MISC_OFF);
    XcdBarrier bar; bar.bar = (unsigned*)(ws + WS_CTL) + CW_BAR; bar.x = 0; bar.st = nullptr;
    if (hi - lo > 1) bar = xcd_barrier_post((unsigned*)(ws + WS_CTL) + CW_BAR, MISC + 8);
    if (lo < 0) grid.sync();
#define IN(k) (lo <= (k) && (k) < hi)
#define SEAM(k) do { if (lo <= (k) && (k) + 1 < hi) xcd_barrier(bar); } while (0)
    bf16* HB = (bf16*)(ws + WS_HB); bf16* C = (bf16*)(ws + WS_C); bf16* X3B = (bf16*)(ws + WS_X1); bf16* X1B = (bf16*)(ws + WS_X1B); bf16* Qb = (bf16*)(ws + WS_Q);
    bf16* Ob = (bf16*)(ws + WS_O); bf16* X2B = (bf16*)(ws + WS_X2B); bf16* Fb = (bf16*)(ws + WS_F);
    float* SSQ1 = (float*)(ws + WS_SSQ1); float* SSQ2 = (float*)(ws + WS_SSQ2); float* SSQ3 = (float*)(ws + WS_SSQ3);
    float* SSQ1S = (float*)(ws + WS_SSQS); float* SSQ2S = SSQ1S + NS * 64; float* SSQ3S = SSQ2S + NS * 64;
    LAS float* red = (LAS float*)lds;

    if (IN(0)) { p0_prologue(a, lds, bid, G, tid, lane, wave); }
    SEAM(0);
    if (IN(1)) {
        { pg8::Gemm g{HB, (const bf16*)(ws + WS_WIN), MP, 1536, 1024}; pg8::StaticOrder S; S.init(MP, 1536, G, bid);
          pg8::EpiIn E{(bf16*)(ws + WS_AP), (bf16*)(ws + WS_GLU), a.out + O_PP, a.out + O_CP};
          pg8::gemm_phase<pg8::EpiIn, pg8::StaticOrder, true, true>(lds, g, S, E); }
        { pg8::Gemm g{(const bf16*)(ws + WS_MB), (const bf16*)(ws + WS_WKV), MMEM, 2048, 1024}; pg8::StaticOrder S; S.init(MMEM, 2048, G, (bid + G - (128 % G)) % G);
          pg8::EpiKV E{a.out + O_MK, a.out + O_MV, (bf16*)(ws + WS_KB)};
          pg8::gemm_phase<pg8::EpiKV, pg8::StaticOrder, true, true>(lds, g, S, E); }
        { pg8::Gemm g{(const bf16*)(ws + WS_WKV) + (size_t)1024 * 1024, (const bf16*)(ws + WS_MB), 1024, MMEM, 1024}; pg8::StaticOrder S; S.init(1024, MMEM, G, (bid + G - (192 % G)) % G);
          pg8::EpiPlain E{(bf16*)(ws + WS_VT), 2048};
          pg8::gemm_phase<pg8::EpiPlain, pg8::StaticOrder, true, true>(lds, g, S, E); }
        __syncthreads();
        { SkRaw f{(float*)(ws + WS_US), 1536}; const int ge = G > 32 ? 32 : G, cc = (bid + G - (224 % G)) % G; if (cc < ge) skinny<false>(HB + (size_t)MP * DM, (const bf16*)(ws + WS_WIN), 1024, 96, cc, ge, red, tid, f); }
    }
    SEAM(1);
    if (IN(2)) {
        mixer_phase(a, lds, bid, G, tid, lane, wave);
    }
    SEAM(2);
    if (IN(3)) {
        { pg8::Gemm g{C, (const bf16*)(ws + WS_WOUT), MP, 1024, 1024}; pg8::StaticOrder S; S.init(MP, 1024, G, bid);
          pg8::EpiRes<false> E{a.in[0], X1B, SSQ1};
          pg8::gemm_phase<pg8::EpiRes<false>, pg8::StaticOrder, false, true>(lds, g, S, E); }
        __syncthreads();
        { SkRes<false> f{a.in[1], X1B + (size_t)MP * DM, SSQ1S}; skinny<false>(C + (size_t)MP * DM, (const bf16*)(ws + WS_WOUT), 1024, 64, bid, G, red, tid, f); }
    }
    SEAM(3);
    if (IN(4)) {
        { pg8::Gemm g{X1B, (const bf16*)(ws + WS_WQ), MP, 1024, 1024}; pg8::StaticOrder S; S.init(MP, 1024, G, bid);
          pg8::EpiQ E{SSQ1, Qb, QSCALE};
          pg8::gemm_phase<pg8::EpiQ, pg8::StaticOrder, false, true>(lds, g, S, E); }
        __syncthreads();
        { SkQ f{SSQ1S, Qb + (size_t)MP * DM}; skinny<false>(X1B + (size_t)MP * DM, (const bf16*)(ws + WS_WQ), 1024, 64, bid, G, red, tid, f); }
    }
    SEAM(4);
    if (IN(5)) {
        for (int u = bid; u < 512; u += G) attn_prompt_unit(a, lds, u, tid, lane, wave);
        __syncthreads();
        for (int it = bid; it < 256; it += G) attn_sample_item(a, lds, it, tid, lane, wave);
    }
    SEAM(5);
    if (IN(6)) {
        { pg8::Gemm g{Ob, (const bf16*)(ws + WS_WO), MP, 1024, 1024}; pg8::StaticOrder S; S.init(MP, 1024, G, bid);
          pg8::EpiRes<true> E{X1B, X2B, SSQ2};
          pg8::gemm_phase<pg8::EpiRes<true>, pg8::StaticOrder, false, true>(lds, g, S, E); }
        __syncthreads();
        { SkRes<true> f{X1B + (size_t)MP * DM, X2B + (size_t)MP * DM, SSQ2S}; skinny<false>(Ob + (size_t)MP * DM, (const bf16*)(ws + WS_WO), 1024, 64, bid, G, red, tid, f); }
    }
    SEAM(6);
    if (IN(7)) {
        { pg8::Gemm g{X2B, (const bf16*)(ws + WS_WGU), MP, FF2, 1024}; pg8::StaticOrder S; S.init(MP, FF2, G, bid);
          pg8::EpiGU E{SSQ2, Fb};
          pg8::gemm_phase<pg8::EpiGU, pg8::StaticOrder, true, true>(lds, g, S, E); }
        __syncthreads();
        { SkGU f{SSQ2S, Fb + (size_t)MP * FF}; const int half = G >= 2 ? G / 2 : 1;
          if (bid >= G - half) skinny<true>(X2B + (size_t)MP * DM, (const bf16*)(ws + WS_WGU), 1024, 176, bid - (G - half), half, red, tid, f); }
    }
    SEAM(7);
    if (IN(8)) {
        { pg8::Gemm g{Fb, (const bf16*)(ws + WS_WD), MP, 1024, FF}; pg8::StaticOrder S; S.init(MP, 1024, G, bid);
          pg8::EpiRes<true> E{X2B, X3B, SSQ3};
          pg8::gemm_phase<pg8::EpiRes<true>, pg8::StaticOrder, false, true>(lds, g, S, E); }
        __syncthreads();
        { SkRes<true> f{X2B + (size_t)MP * DM, X3B + (size_t)MP * DM, SSQ3S}; skinny<false>(Fb + (size_t)MP * FF, (const bf16*)(ws + WS_WD), FF, 64, bid, G, red, tid, f); }
    }
    SEAM(8);
    if (IN(9)) {
        const int gw = bid * 8 + wave, NGW = G * 8;
        const f32x4* gf = (const f32x4*)a.in[27] + lane;
        for (int m = gw; m < MALL; m += NGW) {
            float* yrow; float ssum;
            if (m < MP) { yrow = a.out + O_Y + (size_t)m * DM; const float v = (lane < 16) ? SSQ3[(size_t)m * 16 + lane] : 0.f; ssum = wave_sum(v); }
            else { yrow = a.out + O_YS + (size_t)(m - MP) * DM; ssum = wave_sum(SSQ3S[(m - MP) * 64 + lane]); }
            const float rstd = 1.0f / sqrtf(ssum * (1.0f / DM) + EPS);
            const u32x2* xr = (const u32x2*)(X3B + (size_t)m * DM) + lane; f32x4* yr = (f32x4*)yrow + lane;
#pragma unroll
            for (int j = 0; j < 4; ++j) { const u32x2 w = xr[64 * j];
                const f32x4 v = {__builtin_bit_cast(float, w.x << 16), __builtin_bit_cast(float, w.x & 0xffff0000u), __builtin_bit_cast(float, w.y << 16), __builtin_bit_cast(float, w.y & 0xffff0000u)};
                yr[64 * j] = v * rstd * gf[64 * j]; }
        }
    }
#undef IN
#undef SEAM
}

#ifndef MK_MULTI
#define MK_MULTI 0
#endif
extern "C" void kernel_launch(void* const* d_in, const int* in_sizes, int n_in, void* d_out, int out_size, void* d_ws, size_t ws_size, hipStream_t stream) {
    static int grid = 0;
    if (grid == 0) {
        if (n_in != 28 || ws_size < WS_END) { fprintf(stderr, "kernel_launch: unexpected n_in %d / ws_size %zu\n", n_in, ws_size); grid = -1; return; }
        int dev = 0, cus = 0, per_cu = 0;
        (void)hipGetDevice(&dev); (void)hipDeviceGetAttribute(&cus, hipDeviceAttributeMultiprocessorCount, dev);
        if (hipFuncSetAttribute((const void*)fwd_kernel, hipFuncAttributeMaxDynamicSharedMemorySize, LDS_BYTES) != hipSuccess) { fprintf(stderr, "kernel_launch: hipFuncSetAttribute failed\n"); grid = -1; return; }
        if (hipOccupancyMaxActiveBlocksPerMultiprocessor(&per_cu, (const void*)fwd_kernel, 512, LDS_BYTES) != hipSuccess || per_cu < 1) { fprintf(stderr, "kernel_launch: occupancy query says %d\n", per_cu); per_cu = 1; }
        (void)hipGetLastError();
        grid = cus;
    }
    if (grid < 0) return;
    (void)hipMemsetAsync((char*)d_ws + WS_CTL, 0, CTL_ZERO_BYTES, stream);
    Args a{};
    for (int i = 0; i < 28; ++i) a.in[i] = (const float*)d_in[i];
    a.out = (float*)d_out; a.ws = (unsigned char*)d_ws;
#if MK_MULTI
    for (int p = 0; p < NPHASE; ++p) { a.ph_lo = p; a.ph_hi = p + 1; hipLaunchKernelGGL(fwd_kernel, dim3(grid), dim3(512), LDS_BYTES, stream, a); }
#else
    a.ph_lo = 0; a.ph_hi = NPHASE;
    void* args[] = {&a};
    hipError_t e = hipLaunchCooperativeKernel((const void*)fwd_kernel, dim3(grid), dim3(512), args, LDS_BYTES, stream);
    if (e != hipSuccess) fprintf(stderr, "cooperative launch failed: %s (grid %d)\n", hipGetErrorString(e), grid);
#endif
}
```

```cpp
#include <hip/hip_runtime.h>
#include <hip/hip_cooperative_groups.h>
#include <cstdio>
#include <cstdint>
namespace cg = cooperative_groups;
namespace pg8 {
#define PG8_LAS __attribute__((address_space(3)))
typedef unsigned short bf16_t;
typedef short bf16x8 __attribute__((ext_vector_type(8)));
typedef float f32x4 __attribute__((ext_vector_type(4)));
typedef unsigned u32x4 __attribute__((ext_vector_type(4)));
constexpr int BM = 256, BK = 64, HALF = 128, HTB = HALF * BK * 2  , STAGE_BYTES = 8 * HTB, NXCD = 8, WGM = 8;

__host__ __device__ __forceinline__ int lds_byte(int r, int c) { const int st = (r >> 4) * 2 + (c >> 5), rr = r & 15, cc = c & 31, ob = rr * 64 + cc * 2; return st * 1024 + (ob ^ (((ob >> 9) & 1) << 5)); }
__host__ __device__ __forceinline__ void stage_rc(int b, int& R, int& C) { const int st = b / 1024, sb = b % 1024, swz = sb ^ (((sb >> 9) & 1) << 5); R = (st >> 1) * 16 + swz / 64; C = (st & 1) * 32 + (swz % 64) / 2; }
__host__ __device__ __forceinline__ int perm32(int rho) { const int n = rho >> 4, i = rho & 15; return 8 * (i >> 2) + 4 * n + (i & 3); }

struct Unit { int pm, pn; };
struct Gemm { const bf16_t* A; const bf16_t* Bt; int M, N, K; };

struct StaticOrder {
    int nM, nN, nwg, G, c;
    __host__ __device__ void init(int M, int N, int G_, int c_) { nM = M / BM; nN = N / BM; nwg = nM * nN; G = G_; c = c_; }
    __host__ __device__ bool next(int i, Unit& u) const {
        const long L = (long)i * G + c; if (L >= nwg) return false;
        int wgid = (int)L; { const int q = nwg / NXCD, r = nwg % NXCD, xcd = wgid % NXCD, off = wgid / NXCD; wgid = (xcd < r ? xcd * (q + 1) : r * (q + 1) + (xcd - r) * q) + off; }
        const int nig = WGM * nN, gid = wgid / nig, fm = gid * WGM, gsz = (nM - fm) < WGM ? (nM - fm) : WGM;
        u.pm = fm + ((wgid % nig) % gsz); u.pn = (wgid % nig) / gsz; return true;
    }
    __device__ __forceinline__ void a_ready(const Unit&) const {}
    __device__ __forceinline__ void done(const Unit&) const {}
};
typedef unsigned u32x4 __attribute__((ext_vector_type(4)));
constexpr float EPSF = 1e-6f;
__device__ __forceinline__ unsigned cvt_pk_bf16(float lo, float hi) { unsigned r; asm volatile("v_cvt_pk_bf16_f32 %0, %1, %2" : "=v"(r) : "v"(lo), "v"(hi)); return r; }
__device__ __forceinline__ u32x4 pack8(const f32x4 a, const f32x4 b) { u32x4 w; w.x = cvt_pk_bf16(a[0], a[1]); w.y = cvt_pk_bf16(a[2], a[3]); w.z = cvt_pk_bf16(b[0], b[1]); w.w = cvt_pk_bf16(b[2], b[3]); return w; }
__device__ __forceinline__ float sigm(float x) { return __builtin_amdgcn_rcpf(1.0f + __builtin_amdgcn_exp2f(-1.4426950408889634f * x)); }
__device__ __forceinline__ float rstd16(const float* p) {
    const f32x4 a = ((const f32x4*)p)[0], b = ((const f32x4*)p)[1], c = ((const f32x4*)p)[2], d = ((const f32x4*)p)[3];
    const float s = ((a[0] + a[1]) + (a[2] + a[3])) + ((b[0] + b[1]) + (b[2] + b[3])) + ((c[0] + c[1]) + (c[2] + c[3])) + ((d[0] + d[1]) + (d[2] + d[3]));
    return 1.0f / sqrtf(s * (1.0f / 1024.0f) + EPSF);
}
struct EpiIn {
    static constexpr bool PERM = true, AFTER_DRAIN = false;
    bf16_t* AP; bf16_t* GLU; float* outPP; float* outCP;
    __device__ __forceinline__ void operator()(const f32x4 (&acc)[2][2][4][2], const Unit& u, int wr, int wc, int fr, int fq) const {
        const int row0 = u.pm * BM + wr * 64 + fr, cl = wc * 32 + 8 * fq;
        if (u.pn < 2) {
#pragma unroll
            for (int ai = 0; ai < 2; ++ai)
#pragma unroll
                for (int m = 0; m < 4; ++m) { const int row = row0 + ai * HALF + m * 16, t = row & 2047, b = row >> 11;
#pragma unroll
                    for (int bj = 0; bj < 2; ++bj) { const int col = u.pn * 256 + bj * HALF + cl; const f32x4 v0 = acc[ai][bj][m][0], v1 = acc[ai][bj][m][1];
                        *(u32x4*)(AP + (size_t)row * 512 + col) = pack8(v0, v1);
                        if (t >= 2033) { float* o = outPP + ((size_t)(b * 15 + t - 2033) * 512 + col); *(f32x4*)o = v0; *(f32x4*)(o + 4) = v1; } } }
        } else {
            const int ch = (u.pn - 2) * 128 + cl;
#pragma unroll
            for (int ai = 0; ai < 2; ++ai)
#pragma unroll
                for (int m = 0; m < 4; ++m) { const int row = row0 + ai * HALF + m * 16, t = row & 2047, b = row >> 11;
                    f32x4 o0, o1;
#pragma unroll
                    for (int j = 0; j < 4; ++j) { o0[j] = acc[ai][0][m][0][j] * sigm(acc[ai][1][m][0][j]); o1[j] = acc[ai][0][m][1][j] * sigm(acc[ai][1][m][1][j]); }
                    *(u32x4*)(GLU + (size_t)row * 512 + ch) = pack8(o0, o1);
                    if (t >= 2018) { float* o = outCP + ((size_t)(b * 30 + t - 2018) * 512 + ch); *(f32x4*)o = o0; *(f32x4*)(o + 4) = o1; } }
        }
    }
};
struct EpiKV {
    static constexpr bool PERM = true, AFTER_DRAIN = false;
    float* outK; float* outV; bf16_t* KB;
    __device__ __forceinline__ void operator()(const f32x4 (&acc)[2][2][4][2], const Unit& u, int wr, int wc, int fr, int fq) const {
        const int row0 = u.pm * BM + wr * 64 + fr, cl = wc * 32 + 8 * fq;
#pragma unroll
        for (int ai = 0; ai < 2; ++ai)
#pragma unroll
            for (int m = 0; m < 4; ++m) { const int row = row0 + ai * HALF + m * 16;
#pragma unroll
                for (int bj = 0; bj < 2; ++bj) { const int col = u.pn * 256 + bj * HALF + cl; const f32x4 v0 = acc[ai][bj][m][0], v1 = acc[ai][bj][m][1];
                    if (u.pn < 4) { float* o = outK + (size_t)row * 1024 + col; *(f32x4*)o = v0; *(f32x4*)(o + 4) = v1; *(u32x4*)(KB + (size_t)row * 1024 + col) = pack8(v0, v1); }
                    else { float* o = outV + (size_t)row * 1024 + (col - 1024); *(f32x4*)o = v0; *(f32x4*)(o + 4) = v1; } } }
    }
};
struct EpiPlain {
    static constexpr bool PERM = true, AFTER_DRAIN = false;
    bf16_t* O; int ldc;
    __device__ __forceinline__ void operator()(const f32x4 (&acc)[2][2][4][2], const Unit& u, int wr, int wc, int fr, int fq) const {
        const int row0 = u.pm * BM + wr * 64 + fr, cl = wc * 32 + 8 * fq;
#pragma unroll
        for (int ai = 0; ai < 2; ++ai)
#pragma unroll
            for (int m = 0; m < 4; ++m) { const int row = row0 + ai * HALF + m * 16;
#pragma unroll
                for (int bj = 0; bj < 2; ++bj) { const int col = u.pn * 256 + bj * HALF + cl; *(u32x4*)(O + (size_t)row * ldc + col) = pack8(acc[ai][bj][m][0], acc[ai][bj][m][1]); } }
    }
};
template <bool RES_BF16> struct EpiRes {
    static constexpr bool PERM = true, AFTER_DRAIN = false;
    const void* resid; bf16_t* xb; float* ssq;
    __device__ __forceinline__ void operator()(const f32x4 (&acc)[2][2][4][2], const Unit& u, int wr, int wc, int fr, int fq) const {
        const int row0 = u.pm * BM + wr * 64 + fr, cl = wc * 32 + 8 * fq;
#pragma unroll
        for (int ai = 0; ai < 2; ++ai)
#pragma unroll
            for (int m = 0; m < 4; ++m) { const int row = row0 + ai * HALF + m * 16; float ss = 0.f;
#pragma unroll
                for (int bj = 0; bj < 2; ++bj) { const size_t off = (size_t)row * 1024 + u.pn * 256 + bj * HALF + cl;
                    f32x4 r0, r1;
                    if (RES_BF16) { const u32x4 w = *(const u32x4*)((const bf16_t*)resid + off);
                        r0 = (f32x4){__builtin_bit_cast(float, w.x << 16), __builtin_bit_cast(float, w.x & 0xffff0000u), __builtin_bit_cast(float, w.y << 16), __builtin_bit_cast(float, w.y & 0xffff0000u)};
                        r1 = (f32x4){__builtin_bit_cast(float, w.z << 16), __builtin_bit_cast(float, w.z & 0xffff0000u), __builtin_bit_cast(float, w.w << 16), __builtin_bit_cast(float, w.w & 0xffff0000u)}; }
                    else { r0 = *(const f32x4*)((const float*)resid + off); r1 = *(const f32x4*)((const float*)resid + off + 4); }
                    const f32x4 x0 = r0 + acc[ai][bj][m][0], x1 = r1 + acc[ai][bj][m][1];
                    *(u32x4*)(xb + off) = pack8(x0, x1);
                    ss += ((x0[0] * x0[0] + x0[1] * x0[1]) + (x0[2] * x0[2] + x0[3] * x0[3])) + ((x1[0] * x1[0] + x1[1] * x1[1]) + (x1[2] * x1[2] + x1[3] * x1[3])); }
                ss += __shfl_xor(ss, 16); ss += __shfl_xor(ss, 32);
                if (fq == 0) ssq[(size_t)row * 16 + u.pn * 4 + wc] = ss; }
    }
};
struct EpiQ {
    static constexpr bool PERM = true, AFTER_DRAIN = false;
    const float* ssq; bf16_t* Q; float scale;
    __device__ __forceinline__ void operator()(const f32x4 (&acc)[2][2][4][2], const Unit& u, int wr, int wc, int fr, int fq) const {
        const int row0 = u.pm * BM + wr * 64 + fr, cl = wc * 32 + 8 * fq;
#pragma unroll
        for (int ai = 0; ai < 2; ++ai)
#pragma unroll
            for (int m = 0; m < 4; ++m) { const int row = row0 + ai * HALF + m * 16; const float rs = rstd16(ssq + (size_t)row * 16) * scale;
#pragma unroll
                for (int bj = 0; bj < 2; ++bj) { const size_t off = (size_t)row * 1024 + u.pn * 256 + bj * HALF + cl;
                    *(u32x4*)(Q + off) = pack8(acc[ai][bj][m][0] * rs, acc[ai][bj][m][1] * rs); } }
    }
};
struct EpiGU {
    static constexpr bool PERM = true, AFTER_DRAIN = false;
    const float* ssq; bf16_t* F;
    __device__ __forceinline__ void operator()(const f32x4 (&acc)[2][2][4][2], const Unit& u, int wr, int wc, int fr, int fq) const {
        const int row0 = u.pm * BM + wr * 64 + fr, cl = wc * 32 + 8 * fq;
#pragma unroll
        for (int ai = 0; ai < 2; ++ai)
#pragma unroll
            for (int m = 0; m < 4; ++m) { const int row = row0 + ai * HALF + m * 16; const float rs = rstd16(ssq + (size_t)row * 16);
                f32x4 o0, o1;
#pragma unroll
                for (int j = 0; j < 4; ++j) { const float g0 = acc[ai][0][m][0][j] * rs, g1 = acc[ai][0][m][1][j] * rs;
                    o0[j] = g0 * sigm(g0) * (acc[ai][1][m][0][j] * rs); o1[j] = g1 * sigm(g1) * (acc[ai][1][m][1][j] * rs); }
                *(u32x4*)(F + (size_t)row * 2816 + u.pn * 128 + cl) = pack8(o0, o1); }
    }
};
template <class Epi, class Sched, bool ALIGN_EPI = false, bool SP2 = false>
__device__ __forceinline__ void gemm_phase(PG8_LAS unsigned char* lds, const Gemm g, const Sched& S, const Epi& E) {
    const int tid = threadIdx.x, wid = __builtin_amdgcn_readfirstlane(tid >> 6), lane = tid & 63, wr = wid >> 2, wc = wid & 3, fr = lane & 15, fq = lane >> 4;
    const int K = g.K, nt = K / BK;
    unsigned voffA[2], voffB[2];
#pragma unroll
    for (int i = 0; i < 2; ++i) { int R, C; stage_rc(tid * 16 + i * 8192, R, C); const int Rb = Epi::PERM ? ((R & ~31) + perm32(R & 31)) : R;
        voffA[i] = (unsigned)(R * K + C) * 2u; voffB[i] = (unsigned)(Rb * K + C) * 2u; }
    const size_t kstep = (size_t)(BK * 2);
    const size_t hstep = (size_t)HALF * K * 2;
    const size_t tstep = 2 * hstep;
    const unsigned ldsw = (unsigned)wid * 1024u;
    const int aoff = lds_byte(wr * 64 + fr, fq * 8), boff = lds_byte(wc * 32 + fr, fq * 8);
#define PG8_SA(b, h) (((b) * 2 + (h)) * HTB)
#define PG8_SB(b, h) ((4 + (b) * 2 + (h)) * HTB)
#define PG8_STAGE(bufoff, gbase, voff) do { _Pragma("unroll") for (int _i = 0; _i < 2; ++_i) \
        __builtin_amdgcn_global_load_lds((const unsigned*)((const char*)(gbase) + (voff)[_i]), (PG8_LAS unsigned*)(lds + (bufoff) + ldsw + _i * 8192), 16, 0, 0); } while (0)
#define PG8_LDA(dst, b, h) do { _Pragma("unroll") for (int m = 0; m < 4; ++m) _Pragma("unroll") for (int k = 0; k < 2; ++k) dst[m][k] = *(const PG8_LAS bf16x8*)(lds + PG8_SA(b, h) + aoff + m * 2048 + k * 1024); } while (0)
#define PG8_LDB(dst, b, h) do { _Pragma("unroll") for (int n = 0; n < 2; ++n) _Pragma("unroll") for (int k = 0; k < 2; ++k) dst[n][k] = *(const PG8_LAS bf16x8*)(lds + PG8_SB(b, h) + boff + n * 2048 + k * 1024); } while (0)
#define PG8_MMA(ai, bj, At, Bt) do { __builtin_amdgcn_s_setprio(1); _Pragma("unroll") for (int m = 0; m < 4; ++m) _Pragma("unroll") for (int n = 0; n < 2; ++n) _Pragma("unroll") for (int k = 0; k < 2; ++k) \
        acc[ai][bj][m][n] = __builtin_amdgcn_mfma_f32_16x16x32_bf16(Bt[n][k], At[m][k], acc[ai][bj][m][n], 0, 0, 0); __builtin_amdgcn_s_setprio(0); } while (0)
#define PG8_WAIT_V(n) asm volatile("s_waitcnt vmcnt(" #n ")" ::: "memory")
#define PG8_WAIT_L(n) asm volatile("s_waitcnt lgkmcnt(" #n ")" ::: "memory")
#define PG8_BAR __builtin_amdgcn_s_barrier()
#define PG8_SCHED __builtin_amdgcn_sched_barrier(0)
    Unit cur, nxt; int ui = 0;
    if (!S.next(0, cur)) return;
    f32x4 acc[2][2][4][2];
#pragma unroll
    for (int a = 0; a < 2; ++a)
#pragma unroll
        for (int b = 0; b < 2; ++b)
#pragma unroll
            for (int m = 0; m < 4; ++m)
#pragma unroll
                for (int n = 0; n < 2; ++n) acc[a][b][m][n] = (f32x4){0.f, 0.f, 0.f, 0.f};
    bf16x8 At[4][2], B0[2][2], B1[2][2];
    const char* cA = (const char*)g.A + (size_t)cur.pm * tstep; const char* cB = (const char*)g.Bt + (size_t)cur.pn * tstep;
    S.a_ready(cur);
    if constexpr (SP2) {
        PG8_STAGE(PG8_SB(0, 0), cB, voffB); PG8_STAGE(PG8_SB(0, 1), cB + hstep, voffB); PG8_STAGE(PG8_SA(0, 0), cA, voffA); PG8_STAGE(PG8_SA(0, 1), cA + hstep, voffA);
        if (wr == 1) PG8_BAR;
        PG8_WAIT_V(2); PG8_BAR;
        PG8_STAGE(PG8_SB(1, 0), cB + kstep, voffB); PG8_STAGE(PG8_SA(1, 0), cA + kstep, voffA); PG8_STAGE(PG8_SB(1, 1), cB + hstep + kstep, voffB);
        PG8_WAIT_V(6); PG8_BAR;
    } else {
        PG8_STAGE(PG8_SB(0, 0), cB, voffB); PG8_STAGE(PG8_SA(0, 0), cA, voffA); PG8_STAGE(PG8_SB(0, 1), cB + hstep, voffB); PG8_STAGE(PG8_SA(0, 1), cA + hstep, voffA);
        if (wr == 1) PG8_BAR;
        PG8_WAIT_V(4); PG8_BAR;
        PG8_STAGE(PG8_SB(1, 0), cB + kstep, voffB); PG8_STAGE(PG8_SA(1, 0), cA + kstep, voffA); PG8_STAGE(PG8_SB(1, 1), cB + hstep + kstep, voffB);
        PG8_WAIT_V(6); PG8_BAR;
    }
    for (;;) {
        const bool has_next = S.next(ui + 1, nxt);
        const char* nA = has_next ? (const char*)g.A + (size_t)nxt.pm * tstep : cA; const char* nB = has_next ? (const char*)g.Bt + (size_t)nxt.pn * tstep : cB;
        for (int t = 0; t < nt; t += 2) {
            const bool last = (t == nt - 2);
            const char* a1 = cA + (size_t)(t + 1) * kstep;
            const char* a2 = last ? nA : cA + (size_t)(t + 2) * kstep; const char* b2 = last ? nB : cB + (size_t)(t + 2) * kstep;
            const char* a3 = a2 + kstep; const char* b3 = b2 + kstep;
            if (last && has_next) S.a_ready(nxt);
            if constexpr (SP2) {
            PG8_LDB(B0, 0, 0); PG8_LDB(B1, 0, 1); PG8_SCHED; PG8_LDA(At, 0, 0); PG8_STAGE(PG8_SA(1, 1), a1 + hstep, voffA);
            PG8_WAIT_V(8); PG8_WAIT_L(0); PG8_BAR; PG8_MMA(0, 0, At, B0); PG8_MMA(0, 1, At, B1); PG8_BAR; PG8_SCHED;
            PG8_LDA(At, 0, 1); PG8_STAGE(PG8_SB(0, 0), b2, voffB); PG8_STAGE(PG8_SB(0, 1), b2 + hstep, voffB); PG8_STAGE(PG8_SA(0, 0), a2, voffA);
            PG8_WAIT_V(8); PG8_WAIT_L(0); PG8_BAR; PG8_MMA(1, 0, At, B0); PG8_MMA(1, 1, At, B1); PG8_BAR; PG8_SCHED;
            PG8_LDB(B0, 1, 0); PG8_LDB(B1, 1, 1); PG8_SCHED; PG8_LDA(At, 1, 0); PG8_STAGE(PG8_SA(0, 1), a2 + hstep, voffA);
            PG8_WAIT_V(8); PG8_WAIT_L(0); PG8_BAR; PG8_MMA(0, 0, At, B0); PG8_MMA(0, 1, At, B1); PG8_BAR; PG8_SCHED;
            PG8_LDA(At, 1, 1); PG8_STAGE(PG8_SB(1, 0), b3, voffB); PG8_STAGE(PG8_SB(1, 1), b3 + hstep, voffB); PG8_STAGE(PG8_SA(1, 0), a3, voffA);
            PG8_WAIT_V(8); PG8_WAIT_L(0); PG8_BAR; PG8_MMA(1, 0, At, B0); PG8_MMA(1, 1, At, B1); PG8_BAR; PG8_SCHED;
            } else {
            PG8_LDB(B0, 0, 0); PG8_SCHED; PG8_LDA(At, 0, 0); PG8_STAGE(PG8_SA(1, 1), a1 + hstep, voffA);
            PG8_WAIT_L(8); PG8_BAR; PG8_WAIT_L(0); PG8_MMA(0, 0, At, B0); PG8_BAR; PG8_SCHED;
            PG8_LDB(B1, 0, 1); PG8_STAGE(PG8_SB(0, 0), b2, voffB);
            PG8_BAR; PG8_WAIT_L(0); PG8_MMA(0, 1, At, B1); PG8_BAR;
            PG8_LDA(At, 0, 1); PG8_STAGE(PG8_SA(0, 0), a2, voffA);
            PG8_BAR; PG8_WAIT_L(0); PG8_MMA(1, 0, At, B0); PG8_BAR; PG8_SCHED;
            PG8_STAGE(PG8_SB(0, 1), b2 + hstep, voffB);
            PG8_WAIT_V(6); PG8_BAR; PG8_MMA(1, 1, At, B1); PG8_BAR;
            PG8_LDB(B0, 1, 0); PG8_SCHED; PG8_LDA(At, 1, 0); PG8_STAGE(PG8_SA(0, 1), a2 + hstep, voffA);
            PG8_WAIT_L(8); PG8_BAR; PG8_WAIT_L(0); PG8_MMA(0, 0, At, B0); PG8_BAR; PG8_SCHED;
            PG8_LDB(B1, 1, 1); PG8_STAGE(PG8_SB(1, 0), b3, voffB);
            PG8_BAR; PG8_WAIT_L(0); PG8_MMA(0, 1, At, B1); PG8_BAR;
            PG8_LDA(At, 1, 1); PG8_STAGE(PG8_SA(1, 0), a3, voffA);
            PG8_BAR; PG8_WAIT_L(0); PG8_MMA(1, 0, At, B0); PG8_BAR; PG8_SCHED;
            PG8_STAGE(PG8_SB(1, 1), b3 + hstep, voffB);
            PG8_WAIT_V(6); PG8_BAR; PG8_MMA(1, 1, At, B1); PG8_BAR;
            }
        }
        if constexpr (ALIGN_EPI) { if (wr == 0) PG8_BAR; }
        if constexpr (!Epi::AFTER_DRAIN) { E(acc, cur, wr, wc, fr, fq); S.done(cur); }
        if (!has_next) break;
#pragma unroll
        for (int a = 0; a < 2; ++a)
#pragma unroll
            for (int b = 0; b < 2; ++b)
#pragma unroll
                for (int m = 0; m < 4; ++m)
#pragma unroll
                    for (int n = 0; n < 2; ++n) acc[a][b][m][n] = (f32x4){0.f, 0.f, 0.f, 0.f};
        cur = nxt; cA = nA; cB = nB; ++ui;
        if constexpr (ALIGN_EPI) { if (wr == 1) PG8_BAR; }
    }
    PG8_WAIT_V(0);
    if constexpr (!ALIGN_EPI) { if (wr == 0) PG8_BAR; }
    PG8_BAR;
    if constexpr (Epi::AFTER_DRAIN) { E.fused(acc, cur, wr, wc, fr, fq, lds, wid, lane); S.done(cur); }
#undef PG8_SA
#undef PG8_SB
#undef PG8_STAGE
#undef PG8_LDA
#undef PG8_LDB
#undef PG8_MMA
#undef PG8_WAIT_V
#undef PG8_WAIT_L
#undef PG8_BAR
#undef PG8_SCHED
}
}

#define LAS __attribute__((address_space(3)))
typedef unsigned short bf16;
typedef float f32x4 __attribute__((ext_vector_type(4)));
typedef short bf16x8 __attribute__((ext_vector_type(8)));
typedef unsigned u32x4 __attribute__((ext_vector_type(4)));
typedef unsigned u32x2 __attribute__((ext_vector_type(2)));
constexpr int DM = 1024, NB = 8, SEQ = 2048, MP = NB * SEQ, NS = 128, MALL = MP + NS, NMEM = 256, FF = 2816, FF2 = 5632, MMEM = NB * NMEM;
constexpr float EPS = 1e-6f;
constexpr float QSCALE = 0.0625f * 1.4426950408889634f;
constexpr size_t O_Y = 0, O_YS = 16777216, O_PP = O_YS + 131072, O_PS = O_PP + 61440, O_CP = O_PS + 983040, O_CS = O_CP + 122880, O_MK = O_CS + 1966080, O_MV = O_MK + 2097152;
constexpr size_t MiB = 1u << 20;
constexpr size_t WS_CTL = 0, CTL_ZERO_BYTES = MiB;
constexpr size_t WS_WIN = 1 * MiB, WS_WKV = 4 * MiB, WS_WOUT = 8 * MiB, WS_WQ = 10 * MiB, WS_WO = 12 * MiB, WS_WGU = 14 * MiB, WS_WD = 25 * MiB, WS_WMAP = 31 * MiB;
constexpr size_t WS_HB = 32 * MiB, WS_AP = 65 * MiB, WS_GLU = 82 * MiB, WS_C = 99 * MiB, WS_X1 = 132 * MiB, WS_X1B = 197 * MiB, WS_Q = 230 * MiB, WS_KB = 263 * MiB, WS_VT = 267 * MiB;
constexpr size_t WS_O = 271 * MiB, WS_X2B = 304 * MiB, WS_F = 337 * MiB, WS_MB = 426 * MiB, WS_SSQ1 = 430 * MiB, WS_SSQ2 = 431 * MiB, WS_SSQ3 = 432 * MiB, WS_SSQS = 433 * MiB, WS_US = 434 * MiB, WS_HC = 435 * MiB;
constexpr size_t WS_HP = WS_HC + 512 * 1024, WS_END = 436 * MiB;
constexpr int LDS_BYTES = 147456;
constexpr int NPHASE = 10;

template <int CTRL> __device__ __forceinline__ float dpp_mov(float v) { return __builtin_bit_cast(float, __builtin_amdgcn_update_dpp(0, __builtin_bit_cast(int, v), CTRL, 0xF, 0xF, true)); }
__device__ __forceinline__ float rdl(float v, int l) { return __builtin_bit_cast(float, __builtin_amdgcn_readlane(__builtin_bit_cast(int, v), l)); }
__device__ __forceinline__ float wave_sum(float v) {
    v += dpp_mov<0xB1>(v); v += dpp_mov<0x4E>(v); v += dpp_mov<0x141>(v); v += dpp_mov<0x140>(v);
    return (rdl(v, 0) + rdl(v, 16)) + (rdl(v, 32) + rdl(v, 48));
}
__device__ __forceinline__ float wave_max(float v) {
    v = fmaxf(v, dpp_mov<0xB1>(v)); v = fmaxf(v, dpp_mov<0x4E>(v)); v = fmaxf(v, dpp_mov<0x141>(v)); v = fmaxf(v, dpp_mov<0x140>(v));
    return fmaxf(fmaxf(rdl(v, 0), rdl(v, 16)), fmaxf(rdl(v, 32), rdl(v, 48)));
}
__device__ __forceinline__ unsigned f2bf(float f) { unsigned u = __builtin_bit_cast(unsigned, f); return (u + 0x7fffu + ((u >> 16) & 1u)) >> 16; }
__device__ __forceinline__ unsigned pk2(float lo, float hi) { return f2bf(lo) | (f2bf(hi) << 16); }
__device__ __forceinline__ float bf2f(bf16 v) { return __builtin_bit_cast(float, (unsigned)v << 16); }
__device__ __forceinline__ float sigm(float x) { return __builtin_amdgcn_rcpf(1.0f + __builtin_amdgcn_exp2f(-1.4426950408889634f * x)); }
#define LDS_WAIT() asm volatile("s_waitcnt lgkmcnt(0)" ::: "memory")

__device__ __forceinline__ void transpose_item(const float* W, int K, int N, const float* gk, bf16* WT, int dst_row0, LAS float* scr, int k0, int n0, int lane) {
    f32x4 v[8];
#pragma unroll
    for (int i = 0; i < 8; ++i) { const int kk = (lane >> 3) + 8 * i; v[i] = *(const f32x4*)(W + (size_t)(k0 + kk) * N + n0 + 4 * (lane & 7)); }
    if (gk) {
#pragma unroll
        for (int i = 0; i < 8; ++i) v[i] = v[i] * gk[k0 + (lane >> 3) + 8 * i]; }
#pragma unroll
    for (int i = 0; i < 8; ++i) { LAS float* d = scr + ((lane >> 3) + 8 * i) * 33 + 4 * (lane & 7); d[0] = v[i].x; d[1] = v[i].y; d[2] = v[i].z; d[3] = v[i].w; }
    LDS_WAIT();
    const int c = lane & 7;
#pragma unroll
    for (int j = 0; j < 4; ++j) { const int n = (lane >> 3) + 8 * j; const LAS float* s = scr + (8 * c) * 33 + n;
        u32x4 o; o.x = pk2(s[0 * 33], s[1 * 33]); o.y = pk2(s[2 * 33], s[3 * 33]); o.z = pk2(s[4 * 33], s[5 * 33]); o.w = pk2(s[6 * 33], s[7 * 33]);
        *(u32x4*)(WT + (size_t)(dst_row0 + n) * K + k0 + 8 * c) = o; }
    LDS_WAIT();
}
__device__ __forceinline__ void rms_load(const float* xrow, int lane, f32x4 (&v)[4]) {
    const f32x4* xr = (const f32x4*)xrow + lane;
#pragma unroll
    for (int j = 0; j < 4; ++j) v[j] = xr[64 * j];
}
__device__ __forceinline__ void rms_finish(const f32x4 (&v)[4], const float* g, bf16* orow, int lane) {
    const f32x4* gr = (const f32x4*)g + lane; float s = 0.f;
#pragma unroll
    for (int j = 0; j < 4; ++j) s += (v[j].x * v[j].x + v[j].y * v[j].y) + (v[j].z * v[j].z + v[j].w * v[j].w);
    const float rstd = 1.0f / sqrtf(wave_sum(s) * (1.0f / DM) + EPS);
    unsigned long long* o8 = (unsigned long long*)orow + lane;
#pragma unroll
    for (int j = 0; j < 4; ++j) { const f32x4 gg = gr[64 * j]; const f32x4 o = v[j] * rstd * gg;
        o8[64 * j] = (unsigned long long)pk2(o.x, o.y) | ((unsigned long long)pk2(o.z, o.w) << 32); }
}

struct Args { const float* in[28]; float* out; unsigned char* ws; int ph_lo, ph_hi; };

__device__ __forceinline__ void p0_prologue(const Args& a, LAS unsigned char* lds, int bid, int G, int tid, int lane, int wave) {
    unsigned char* ws = a.ws;
    LAS float* scr = (LAS float*)(lds + wave * 16384);
    const int gw = bid * 8 + wave, NGW = G * 8;
    constexpr int I_IN = 16 * 48, I_SQ = 16 * 32, I_GU = 16 * 88, I_D = 44 * 32, I_PM = 2 * 4;
    constexpr int NITEMS = I_IN + 5 * I_SQ + 2 * I_GU + I_D + 4 * I_PM;
    for (int it = gw; it < NITEMS; it += NGW) {
        int r = it;
        if (r < I_IN) { const int kb = r / 48, n0 = (r % 48) * 32; int dr;
            if (n0 < 512) dr = n0; else { int j = n0 - 512; int hi = 0; if (j >= 512) { j -= 512; hi = 128; } dr = 512 + (j >> 7) * 256 + hi + (j & 127); }
            transpose_item(a.in[8], 1024, 1536, nullptr, (bf16*)(ws + WS_WIN), dr, scr, 64 * kb, n0, lane); continue; } r -= I_IN;
        if (r < I_SQ) { transpose_item(a.in[20], 1024, 1024, nullptr, (bf16*)(ws + WS_WKV), (r % 32) * 32, scr, 64 * (r / 32), (r % 32) * 32, lane); continue; } r -= I_SQ;
        if (r < I_SQ) { transpose_item(a.in[21], 1024, 1024, nullptr, (bf16*)(ws + WS_WKV), 1024 + (r % 32) * 32, scr, 64 * (r / 32), (r % 32) * 32, lane); continue; } r -= I_SQ;
        if (r < I_SQ) { transpose_item(a.in[16], 1024, 1024, nullptr, (bf16*)(ws + WS_WOUT), (r % 32) * 32, scr, 64 * (r / 32), (r % 32) * 32, lane); continue; } r -= I_SQ;
        if (r < I_SQ) { transpose_item(a.in[19], 1024, 1024, a.in[17], (bf16*)(ws + WS_WQ), (r % 32) * 32, scr, 64 * (r / 32), (r % 32) * 32, lane); continue; } r -= I_SQ;
        if (r < I_SQ) { transpose_item(a.in[22], 1024, 1024, nullptr, (bf16*)(ws + WS_WO), (r % 32) * 32, scr, 64 * (r / 32), (r % 32) * 32, lane); continue; } r -= I_SQ;
        if (r < I_GU) { const int n0 = (r % 88) * 32; transpose_item(a.in[24], 1024, FF, a.in[23], (bf16*)(ws + WS_WGU), (n0 >> 7) * 256 + (n0 & 127), scr, 64 * (r / 88), n0, lane); continue; } r -= I_GU;
        if (r < I_GU) { const int n0 = (r % 88) * 32; transpose_item(a.in[25], 1024, FF, a.in[23], (bf16*)(ws + WS_WGU), (n0 >> 7) * 256 + 128 + (n0 & 127), scr, 64 * (r / 88), n0, lane); continue; } r -= I_GU;
        if (r < I_D) { transpose_item(a.in[26], FF, 1024, nullptr, (bf16*)(ws + WS_WD), (r % 32) * 32, scr, 64 * (r / 32), (r % 32) * 32, lane); continue; } r -= I_D;
        { const int g = r / I_PM, q = r % I_PM; transpose_item(a.in[9] + (size_t)g * 16384, 128, 128, nullptr, (bf16*)(ws + WS_WMAP) + (size_t)g * 16384, (q % 4) * 32, scr, 64 * (q / 4), (q % 4) * 32, lane); }
    }
#define ROW_SRC(m) ((m) < MP ? a.in[0] + (size_t)(m) * DM : ((m) < MALL ? a.in[1] + (size_t)((m) - MP) * DM : a.in[2] + (size_t)((m) - MALL) * DM))
    { f32x4 cur[4], nxt[4]; int m = gw;
      if (m < MALL + MMEM) rms_load(ROW_SRC(m), lane, cur);
      for (; m < MALL + MMEM; m += NGW) { const int mn = m + NGW;
          if (mn < MALL + MMEM) rms_load(ROW_SRC(mn), lane, nxt);
          if (m < MALL) rms_finish(cur, a.in[7], (bf16*)(ws + WS_HB) + (size_t)m * DM, lane);
          else rms_finish(cur, a.in[18], (bf16*)(ws + WS_MB) + (size_t)(m - MALL) * DM, lane);
#pragma unroll
          for (int j = 0; j < 4; ++j) cur[j] = nxt[j]; } }
#undef ROW_SRC
    const float* spool = a.in[3]; const float* sconv = a.in[4]; const float* wdw = a.in[12]; const float* bdw = a.in[13];
    float* HC = (float*)(ws + WS_HC); float* HP = (float*)(ws + WS_HP);
    for (int e2 = bid * 512 + tid; e2 < 2 * NS * 512; e2 += G * 512) {
        const int e = e2 & (NS * 512 - 1), b = e >> 9, ch = e & 511;
        if (e2 < NS * 512) {
            float v[30];
#pragma unroll
            for (int j = 0; j < 30; ++j) v[j] = sconv[(size_t)(b * 30 + j) * 512 + ch];
            float acc = bdw[ch];
#pragma unroll
            for (int j = 0; j < 30; ++j) { acc += wdw[j * 512 + ch] * v[j]; if (j >= 1) a.out[O_CS + (size_t)(b * 30 + j - 1) * 512 + ch] = v[j]; }
            HC[e] = acc;
        } else {
            float v[15];
#pragma unroll
            for (int j = 0; j < 15; ++j) v[j] = spool[(size_t)(b * 15 + j) * 512 + ch];
            const int w = 2 << (ch >> 7); float sacc = 0.f;
#pragma unroll
            for (int j = 0; j < 15; ++j) { if (j >= 1) a.out[O_PS + (size_t)(b * 15 + j - 1) * 512 + ch] = v[j]; if (j >= 16 - w) sacc += v[j]; }
            HP[e] = sacc;
        }
    }
}

template <bool PAIR, class Fn>
__device__ __forceinline__ void skinny(const bf16* A, const bf16* Bt, int K, int nColBlk, int c, int G, LAS float* red, int tid, const Fn& fn) {
    const int lane = tid & 63, wave = __builtin_amdgcn_readfirstlane(tid >> 6), fr = lane & 15, fq = lane >> 4;
    const int nItems = nColBlk * 4, kw = K >> 3;
    for (int it = c; it < nItems; it += G) {
        const int rb = it & 3, cb = it >> 2;
        const int n0 = PAIR ? ((cb >> 3) * 256 + (cb & 7) * 16) : cb * 16;
        const bf16* ap = A + (size_t)(32 * rb + fr) * K + wave * kw + 8 * fq;
        const bf16* bp = Bt + (size_t)(n0 + fr) * K + wave * kw + 8 * fq;
        f32x4 c00 = {0.f, 0.f, 0.f, 0.f}, c01 = c00, c10 = c00, c11 = c00;
        for (int ks = 0; ks < kw; ks += 32) {
            const bf16x8 b0 = *(const bf16x8*)(bp + ks), a0 = *(const bf16x8*)(ap + ks), a1 = *(const bf16x8*)(ap + (size_t)16 * K + ks);
            c00 = __builtin_amdgcn_mfma_f32_16x16x32_bf16(b0, a0, c00, 0, 0, 0); c01 = __builtin_amdgcn_mfma_f32_16x16x32_bf16(b0, a1, c01, 0, 0, 0);
            if (PAIR) { const bf16x8 b1 = *(const bf16x8*)(bp + (size_t)128 * K + ks);
                c10 = __builtin_amdgcn_mfma_f32_16x16x32_bf16(b1, a0, c10, 0, 0, 0); c11 = __builtin_amdgcn_mfma_f32_16x16x32_bf16(b1, a1, c11, 0, 0, 0); }
        }
        LAS float* rw = red + wave * 1024;
        *(LAS f32x4*)(rw + fr * 16 + 4 * fq) = c00; *(LAS f32x4*)(rw + (16 + fr) * 16 + 4 * fq) = c01;
        if (PAIR) { *(LAS f32x4*)(rw + 512 + fr * 16 + 4 * fq) = c10; *(LAS f32x4*)(rw + 512 + (16 + fr) * 16 + 4 * fq) = c11; }
        __syncthreads();
        float v0 = 0.f, v1 = 0.f;
#pragma unroll
        for (int w = 0; w < 8; ++w) { v0 += red[w * 1024 + tid]; if (PAIR) v1 += red[w * 1024 + 512 + tid]; }
        fn(32 * rb + (tid >> 4), cb * 16 + (tid & 15), cb, v0, v1);
        __syncthreads();
    }
}
__device__ __forceinline__ float red16(float s) { s += __shfl_xor(s, 1); s += __shfl_xor(s, 2); s += __shfl_xor(s, 4); s += __shfl_xor(s, 8); return s; }
__device__ __forceinline__ float rstd_s(const float* p, int row, int ci) {
    const float* q = p + row * 64 + ci; return 1.0f / sqrtf(red16((q[0] + q[16]) + (q[32] + q[48])) * (1.0f / DM) + EPS);
}
struct SkRaw { float* O; int ld; __device__ __forceinline__ void operator()(int row, int col, int, float v0, float) const { O[(size_t)row * ld + col] = v0; } };
template <bool RES_BF16> struct SkRes { const void* resid; bf16* xb; float* ssq;
    __device__ __forceinline__ void operator()(int row, int col, int cb, float v0, float) const {
        const size_t off = (size_t)row * DM + col; const float r = RES_BF16 ? bf2f(((const bf16*)resid)[off]) : ((const float*)resid)[off];
        const float x = r + v0; xb[off] = (bf16)f2bf(x);
        const float ss = red16(x * x); if ((col & 15) == 0) ssq[row * 64 + cb] = ss; } };
struct SkQ { const float* ssq; bf16* Q; __device__ __forceinline__ void operator()(int row, int col, int, float v0, float) const {
        const float rs = rstd_s(ssq, row, col & 15) * QSCALE; Q[(size_t)row * DM + col] = (bf16)f2bf(v0 * rs); } };
struct SkGU { const float* ssq; bf16* F; __device__ __forceinline__ void operator()(int row, int col, int, float v0, float v1) const {
        const float rs = rstd_s(ssq, row, col & 15); const float g = v0 * rs; F[(size_t)row * FF + col] = (bf16)f2bf(g * sigm(g) * (v1 * rs)); } };

constexpr int MX_TG = 0, MX_TA = 46 * 1024, MX_YC = MX_TA + 31 * 1024, MX_D = MX_YC + 16 * 2048, MX_DSTRIDE = 1040, MX_NPIECE = (46 + 31) * 64;
static_assert(MX_D + 16 * MX_DSTRIDE <= 131072, "mixer LDS");
template <int W> __device__ __forceinline__ void pool16(int t0, int tid, LAS unsigned char* lds) {
    float in[16 + W - 1];
#pragma unroll
    for (int i = 0; i < 16 + W - 1; ++i) in[i] = bf2f(*(const LAS bf16*)(lds + MX_TA + (16 - W + i) * 1024 + tid * 2));
#pragma unroll
    for (int r = 0; r < 16; ++r) { float s = 0.f;
#pragma unroll
        for (int j = 0; j < W; ++j) s += in[r + j];
        const int t = t0 + r; const int cnt = (t + 1 < W) ? (t + 1) : W;
        const float d = s / (float)cnt - in[r + W - 1];
        *(LAS bf16*)(lds + MX_D + r * MX_DSTRIDE + tid * 2) = (bf16)f2bf(d); }
}
struct MixP { f32x4 g0, g1, b0, b1; };
__device__ __forceinline__ void mixer_finish(const Args& a, LAS unsigned char* lds, int crow0, int tid, int lane, int wave, const MixP& P) {
    bf16* C = (bf16*)(a.ws + WS_C);
    const LAS float* yc = (const LAS float*)(lds + MX_YC);
    { const f32x4 g0 = P.g0, g1 = P.g1, b0 = P.b0, b1 = P.b1;
#pragma unroll
      for (int i = 0; i < 2; ++i) { const int r = 2 * wave + i;
        const f32x4 y0 = *(const LAS f32x4*)(yc + r * 512 + lane * 8), y1 = *(const LAS f32x4*)(yc + r * 512 + lane * 8 + 4);
        const float mu = wave_sum((y0.x + y0.y) + (y0.z + y0.w) + (y1.x + y1.y) + (y1.z + y1.w)) * (1.0f / 512.0f);
        const f32x4 d0 = y0 - mu, d1 = y1 - mu;
        const float var = wave_sum((d0.x * d0.x + d0.y * d0.y) + (d0.z * d0.z + d0.w * d0.w) + (d1.x * d1.x + d1.y * d1.y) + (d1.z * d1.z + d1.w * d1.w)) * (1.0f / 512.0f);
        const float rs = 1.0f / sqrtf(var + EPS);
        f32x4 n0 = d0 * rs * g0 + b0, n1 = d1 * rs * g1 + b1;
#pragma unroll
        for (int j = 0; j < 4; ++j) { n0[j] = n0[j] * sigm(n0[j]); n1[j] = n1[j] * sigm(n1[j]); }
        u32x4 o; o.x = pk2(n0.x, n0.y); o.y = pk2(n0.z, n0.w); o.z = pk2(n1.x, n1.y); o.w = pk2(n1.z, n1.w);
        *(u32x4*)(C + (size_t)(crow0 + r) * DM + 512 + lane * 8) = o; } }
    { const int g = wave >> 1, nh = wave & 1, fr = lane & 15, fq = lane >> 4;
      const bf16* WT = (const bf16*)(a.ws + WS_WMAP) + (size_t)g * 16384;
      f32x4 acc[4];
#pragma unroll
      for (int nb = 0; nb < 4; ++nb) acc[nb] = (f32x4){0.f, 0.f, 0.f, 0.f};
#pragma unroll
      for (int kc = 0; kc < 4; ++kc) {
          const bf16x8 af = *(const LAS bf16x8*)(lds + MX_D + fr * MX_DSTRIDE + (g * 128 + 32 * kc + 8 * fq) * 2);
#pragma unroll
          for (int nb = 0; nb < 4; ++nb) { const bf16x8 bf = *(const bf16x8*)(WT + (size_t)(64 * nh + 16 * nb + fr) * 128 + 32 * kc + 8 * fq);
              acc[nb] = __builtin_amdgcn_mfma_f32_16x16x32_bf16(bf, af, acc[nb], 0, 0, 0); }
      }
#pragma unroll
      for (int nb = 0; nb < 4; ++nb) { const int ch = g * 128 + 64 * nh + 16 * nb + 4 * fq;
          const f32x4 bm = *(const f32x4*)(a.in[10] + ch), sc = *(const f32x4*)(a.in[11] + ch);
          const f32x4 y = (acc[nb] + bm) * sc; u32x2 o; o.x = pk2(y.x, y.y); o.y = pk2(y.z, y.w);
          *(u32x2*)(C + (size_t)(crow0 + fr) * DM + ch) = o; } }
}
__device__ __forceinline__ void mixer_phase(const Args& a, LAS unsigned char* lds, int bid, int G, int tid, int lane, int wave) {
    const bf16* GLU = (const bf16*)(a.ws + WS_GLU); const bf16* AP = (const bf16*)(a.ws + WS_AP);
    LAS float* yc = (LAS float*)(lds + MX_YC);
    u32x4 pr[10];
#define MX_LOAD(u) do { const int b_ = (u) >> 7, t0_ = ((u) & 127) * 16; _Pragma("unroll") for (int i = 0; i < 10; ++i) { const int p = tid + 512 * i; \
        if (p < MX_NPIECE) { const bool isg = p < 46 * 64; const int q = isg ? p : p - 46 * 64; const int t = t0_ - (isg ? 30 : 15) + (q >> 6); const int tt = t < 0 ? 0 : t; \
            const u32x4 v = *(const u32x4*)((isg ? GLU : AP) + (size_t)(b_ * SEQ + tt) * 512 + (q & 63) * 8); pr[i] = t >= 0 ? v : (u32x4){0u, 0u, 0u, 0u}; } } } while (0)
    int u = bid; bool have = u < 1024;
    if (have) MX_LOAD(u);
    float w[31];
#pragma unroll
    for (int j = 0; j < 31; ++j) w[j] = a.in[12][j * 512 + tid];
    const float bias = a.in[13][tid];
    MixP P;
    P.g0 = *(const f32x4*)(a.in[14] + lane * 8); P.g1 = *(const f32x4*)(a.in[14] + lane * 8 + 4); P.b0 = *(const f32x4*)(a.in[15] + lane * 8); P.b1 = *(const f32x4*)(a.in[15] + lane * 8 + 4);
#define MX_STORE() do { _Pragma("unroll") for (int i = 0; i < 10; ++i) { const int p = tid + 512 * i; if (p < MX_NPIECE) *(LAS u32x4*)(lds + p * 16) = pr[i]; } } while (0)
    if (have) { MX_STORE(); const int un = u + G; if (un < 1024) MX_LOAD(un); }
    while (have) {
        __syncthreads();
        const int b = u >> 7, t0 = (u & 127) * 16;
        { float in[46];
#pragma unroll
          for (int i = 0; i < 46; ++i) in[i] = bf2f(*(const LAS bf16*)(lds + MX_TG + i * 1024 + tid * 2));
#pragma unroll
          for (int r = 0; r < 16; ++r) { float acc = bias;
#pragma unroll
              for (int j = 0; j < 31; ++j) acc += w[j] * in[r + j];
              yc[r * 512 + tid] = acc; } }
        { const int g = tid >> 7;
          if (g == 0) pool16<2>(t0, tid, lds); else if (g == 1) pool16<4>(t0, tid, lds); else if (g == 2) pool16<8>(t0, tid, lds); else pool16<16>(t0, tid, lds); }
        __syncthreads();
        const int un = u + G; const bool hn = un < 1024;
        if (hn) { MX_STORE(); const int unn = un + G; if (unn < 1024) MX_LOAD(unn); }
        mixer_finish(a, lds, b * SEQ + t0, tid, lane, wave, P);
        u = un; have = hn;
    }
#undef MX_STORE
#undef MX_LOAD
    const float* US = (const float*)(a.ws + WS_US); const float* HC = (const float*)(a.ws + WS_HC); const float* HP = (const float*)(a.ws + WS_HP);
    for (int su = (bid + 8) % G; su < 8; su += G) {
        __syncthreads();
        const float w30 = w[30]; const int wdt = 2 << (tid >> 7); const float invw = 1.0f / (float)wdt;
        const int gcol = 512 + (tid >> 7) * 256 + (tid & 127);
#pragma unroll
        for (int s2 = 0; s2 < 16; ++s2) { const int bs = 16 * su + s2;
            const float val = US[(size_t)bs * 1536 + gcol], gate = US[(size_t)bs * 1536 + gcol + 128], av = US[(size_t)bs * 1536 + tid];
            const float glu = val * sigm(gate);
            a.out[O_CS + (size_t)(bs * 30 + 29) * 512 + tid] = glu; a.out[O_PS + (size_t)(bs * 15 + 14) * 512 + tid] = av;
            yc[s2 * 512 + tid] = HC[bs * 512 + tid] + w30 * glu;
            const float d = (av + HP[bs * 512 + tid]) * invw - av;
            *(LAS bf16*)(lds + MX_D + s2 * MX_DSTRIDE + tid * 2) = (bf16)f2bf(d); }
        __syncthreads();
        mixer_finish(a, lds, MP + 16 * su, tid, lane, wave, P);
    }
    __syncthreads();
}

constexpr int AT_K = 0, AT_KSTR = 528, AT_V = 64 * AT_KSTR, AT_VSTR = 144;
__device__ __forceinline__ float fexp2(float x) { return __builtin_amdgcn_exp2f(x); }
__device__ __forceinline__ void attn_prompt_unit(const Args& a, LAS unsigned char* lds, int u, int tid, int lane, int wave) {
    const int qb = u & 15, h = (u >> 4) & 3, b = u >> 6, fr = lane & 15, fq = lane >> 4;
    const bf16* Q = (const bf16*)(a.ws + WS_Q); const bf16* KB = (const bf16*)(a.ws + WS_KB); const bf16* VT = (const bf16*)(a.ws + WS_VT); bf16* O = (bf16*)(a.ws + WS_O);
    const size_t rowq = (size_t)b * SEQ + qb * 128 + wave * 16 + fr;
    bf16x8 qf[8];
#pragma unroll
    for (int kd = 0; kd < 8; ++kd) qf[kd] = *(const bf16x8*)(Q + rowq * DM + h * 256 + 32 * kd + 8 * fq);
    f32x4 o[16];
#pragma unroll
    for (int i = 0; i < 16; ++i) o[i] = (f32x4){0.f, 0.f, 0.f, 0.f};
    float mrun = -INFINITY, lrun = 0.f;
    u32x4 kr[4], vr[4];
#define AT_LOAD(c) do { _Pragma("unroll") for (int i = 0; i < 4; ++i) { const int p = tid + 512 * i; \
        kr[i] = *(const u32x4*)(KB + (size_t)(b * 256 + 64 * (c) + (p >> 5)) * DM + h * 256 + (p & 31) * 8); \
        vr[i] = *(const u32x4*)(VT + (size_t)(h * 256 + (p >> 3)) * 2048 + b * 256 + 64 * (c) + (p & 7) * 8); } } while (0)
    AT_LOAD(0);
#pragma unroll 1
    for (int c = 0; c < 4; ++c) {
        __syncthreads();
#pragma unroll
        for (int i = 0; i < 4; ++i) { const int p = tid + 512 * i;
            *(LAS u32x4*)(lds + AT_K + (p >> 5) * AT_KSTR + (p & 31) * 16) = kr[i];
            *(LAS u32x4*)(lds + AT_V + (p >> 3) * AT_VSTR + (p & 7) * 16) = vr[i]; }
        __syncthreads();
        if (c < 3) AT_LOAD(c + 1);
        f32x4 s[4];
#pragma unroll
        for (int nb = 0; nb < 4; ++nb) { s[nb] = (f32x4){0.f, 0.f, 0.f, 0.f};
#pragma unroll
            for (int kd = 0; kd < 8; ++kd) { const bf16x8 kf = *(const LAS bf16x8*)(lds + AT_K + (16 * nb + fr) * AT_KSTR + kd * 64 + fq * 16);
                s[nb] = __builtin_amdgcn_mfma_f32_16x16x32_bf16(kf, qf[kd], s[nb], 0, 0, 0); } }
        float mx = s[0][0];
#pragma unroll
        for (int nb = 0; nb < 4; ++nb)
#pragma unroll
            for (int j = 0; j < 4; ++j) mx = fmaxf(mx, s[nb][j]);
        mx = fmaxf(mx, __shfl_xor(mx, 16)); mx = fmaxf(mx, __shfl_xor(mx, 32));
        const float mnew = fmaxf(mrun, mx), alpha = fexp2(mrun - mnew);
        float ps = 0.f;
#pragma unroll
        for (int nb = 0; nb < 4; ++nb)
#pragma unroll
            for (int j = 0; j < 4; ++j) { s[nb][j] = fexp2(s[nb][j] - mnew); ps += s[nb][j]; }
        ps += __shfl_xor(ps, 16); ps += __shfl_xor(ps, 32);
        lrun = lrun * alpha + ps; mrun = mnew;
#pragma unroll
        for (int i = 0; i < 16; ++i) o[i] = o[i] * alpha;
#pragma unroll
        for (int kb = 0; kb < 2; ++kb) {
            u32x4 pw; pw.x = pg8::cvt_pk_bf16(s[2 * kb][0], s[2 * kb][1]); pw.y = pg8::cvt_pk_bf16(s[2 * kb][2], s[2 * kb][3]);
            pw.z = pg8::cvt_pk_bf16(s[2 * kb + 1][0], s[2 * kb + 1][1]); pw.w = pg8::cvt_pk_bf16(s[2 * kb + 1][2], s[2 * kb + 1][3]);
            const bf16x8 pf = __builtin_bit_cast(bf16x8, pw);
#pragma unroll
            for (int db = 0; db < 16; ++db) {
                const u32x2 v0 = *(const LAS u32x2*)(lds + AT_V + (16 * db + fr) * AT_VSTR + kb * 64 + fq * 8), v1 = *(const LAS u32x2*)(lds + AT_V + (16 * db + fr) * AT_VSTR + kb * 64 + 32 + fq * 8);
                u32x4 vw; vw.x = v0.x; vw.y = v0.y; vw.z = v1.x; vw.w = v1.y;
                o[db] = __builtin_amdgcn_mfma_f32_16x16x32_bf16(__builtin_bit_cast(bf16x8, vw), pf, o[db], 0, 0, 0); }
        }
    }
#undef AT_LOAD
    const float inv = 1.0f / lrun;
#pragma unroll
    for (int db = 0; db < 16; ++db) { const f32x4 y = o[db] * inv; u32x2 w; w.x = pg8::cvt_pk_bf16(y.x, y.y); w.y = pg8::cvt_pk_bf16(y.z, y.w);
        *(u32x2*)(O + rowq * DM + h * 256 + 16 * db + 4 * fq) = w; }
}
__device__ __forceinline__ float rdlane(float v, int l) { return __builtin_bit_cast(float, __builtin_amdgcn_readlane(__builtin_bit_cast(int, v), l)); }
__device__ __forceinline__ void attn_sample_item(const Args& a, LAS unsigned char* lds, int item, int tid, int lane, int wave) {
    const int u = 2 * item + (wave >> 2), qt = wave & 3, b = u >> 2, h = u & 3;
    const bf16* Q = (const bf16*)(a.ws + WS_Q) + (size_t)(MP + b) * DM + h * 256;
    const float* ck = a.in[5] + ((size_t)(b * 256 + 64 * qt) * 4 + h) * 256 + lane * 4; const float* cv = a.in[6] + ((size_t)(b * 256 + 64 * qt) * 4 + h) * 256 + lane * 4;
    const u32x2 qw = *(const u32x2*)(Q + lane * 4);
    const f32x4 q = {__builtin_bit_cast(float, qw.x << 16), __builtin_bit_cast(float, qw.x & 0xffff0000u), __builtin_bit_cast(float, qw.y << 16), __builtin_bit_cast(float, qw.y & 0xffff0000u)};
    f32x4 A[8], B[8];
#define SA_PTR(j) (((j) < 8 ? ck : cv) + (size_t)(((j) & 7) * 8) * 1024)
#define SA_LOAD(buf, j) do { const float* bp_ = SA_PTR(j); _Pragma("unroll") for (int i = 0; i < 8; ++i) buf[i] = __builtin_nontemporal_load((const f32x4*)(bp_ + (size_t)i * 1024)); } while (0)
#define SA_DOTS(buf, j) do { _Pragma("unroll") for (int i = 0; i < 8; ++i) { const float sd = wave_sum((buf[i].x * q.x + buf[i].y * q.y) + (buf[i].z * q.z + buf[i].w * q.w)); mine = (lane == 8 * (j) + i) ? sd : mine; } } while (0)
#define SA_ACC(buf, j) do { _Pragma("unroll") for (int i = 0; i < 8; ++i) { const float pi = pl[8 * (j) + i]; acc += buf[i] * pi; } } while (0)
    float mine = 0.f;
    SA_LOAD(A, 0); SA_LOAD(B, 1);
#pragma unroll 1
    for (int j = 0; j < 8; j += 2) { SA_DOTS(A, j); SA_LOAD(A, j + 2); SA_DOTS(B, j + 1); SA_LOAD(B, j + 3); }
    const float mloc = wave_max(mine); const float p = fexp2(mine - mloc); const float lloc = wave_sum(p);
    LAS float* pl = (LAS float*)(lds + 16384) + wave * 64;
    pl[lane] = p; LDS_WAIT();
    f32x4 acc = {0.f, 0.f, 0.f, 0.f};
#pragma unroll 1
    for (int j = 0; j < 8; j += 2) { SA_ACC(A, j); if (j + 2 < 8) SA_LOAD(A, j + 10); SA_ACC(B, j + 1); if (j + 2 < 8) SA_LOAD(B, j + 11); }
#undef SA_PTR
#undef SA_LOAD
#undef SA_DOTS
#undef SA_ACC
    LAS float* po = (LAS float*)lds; LAS float* ml = po + 8 * 256;
    __syncthreads();
    *(LAS f32x4*)(po + wave * 256 + lane * 4) = acc; if (lane == 0) { ml[2 * wave] = mloc; ml[2 * wave + 1] = lloc; }
    __syncthreads();
    { const int ul = tid >> 8, d = tid & 255;
      const float m0 = ml[8 * ul], m1 = ml[8 * ul + 2], m2 = ml[8 * ul + 4], m3 = ml[8 * ul + 6];
      const float M = fmaxf(fmaxf(m0, m1), fmaxf(m2, m3));
      const float e0 = fexp2(m0 - M), e1 = fexp2(m1 - M), e2 = fexp2(m2 - M), e3 = fexp2(m3 - M);
      const float den = (e0 * ml[8 * ul + 1] + e1 * ml[8 * ul + 3]) + (e2 * ml[8 * ul + 5] + e3 * ml[8 * ul + 7]);
      const float num = (e0 * po[(4 * ul) * 256 + d] + e1 * po[(4 * ul + 1) * 256 + d]) + (e2 * po[(4 * ul + 2) * 256 + d] + e3 * po[(4 * ul + 3) * 256 + d]);
      const int uu = 2 * item + ul;
      ((bf16*)(a.ws + WS_O))[(size_t)(MP + (uu >> 2)) * DM + (uu & 3) * 256 + d] = (bf16)f2bf(num / den); }
    __syncthreads();
}

#define XB_TMO      128
#define XB_XCNT(j)  (256  + 64 * (j))
#define XB_XSUB(j)  (1280 + 64 * (j))
#define XB_XGEN(j)  (2304 + 64 * (j))
#define XB_TOP      3328
#define XB_TOPGEN   3392
#define XCD_BAR_WORDS 3456
#define XB_SPIN_CAP (1u << 18)

__device__ __forceinline__ unsigned xb_ld(unsigned* p)              { return __hip_atomic_load(p, __ATOMIC_RELAXED, __HIP_MEMORY_SCOPE_AGENT); }
__device__ __forceinline__ unsigned xb_add(unsigned* p, unsigned v) { return __hip_atomic_fetch_add(p, v, __ATOMIC_RELAXED, __HIP_MEMORY_SCOPE_AGENT); }
__device__ __forceinline__ unsigned xb_xcc_id() { return (unsigned)__builtin_amdgcn_s_getreg((3 << 11) | 20) & 0xFu; }
#define XB_SPIN(cond, bar) do { unsigned _sp = 0; while (cond) { __builtin_amdgcn_s_sleep(1); \
    if ((++_sp & 255u) == 0u) { if (xb_ld(&(bar)[XB_TMO])) break; if (_sp > XB_SPIN_CAP) { atomicAdd(&(bar)[XB_TMO], 1u); break; } } } } while (0)

struct XcdBarrier {
    unsigned* bar; unsigned x;
    volatile LAS unsigned* st;
};

__device__ __forceinline__ XcdBarrier xcd_barrier_post(unsigned* bar, volatile LAS unsigned* st) {
    XcdBarrier b; b.bar = bar; b.x = xb_xcc_id(); b.st = st;
    if (threadIdx.x == 0) (void)xb_add(&bar[XB_XCNT(b.x)], 1u);
    return b;
}
__device__ __forceinline__ void xcd_barrier_complete(unsigned* bar, unsigned x, unsigned& nloc, unsigned& nx) {
    const unsigned G = gridDim.x * gridDim.y * gridDim.z;
    unsigned sum, cnt, mine, sp = 0u;
    for (;;) {
        sum = 0u; cnt = 0u; mine = 0u;
#pragma unroll
        for (unsigned j = 0; j < 16; ++j) { const unsigned c = xb_ld(&bar[XB_XCNT(j)]); sum += c; cnt += (c > 0u) ? 1u : 0u; mine = (j == x) ? c : mine; }
        if (sum == G) break;
        __builtin_amdgcn_s_sleep(1);
        if ((++sp & 255u) == 0u) { if (xb_ld(&bar[XB_TMO])) break; if (sp > XB_SPIN_CAP) { atomicAdd(&bar[XB_TMO], 1u); break; } }
    }
    nloc = mine > 0u ? mine : 1u; nx = cnt > 0u ? cnt : 1u;
}

__device__ __forceinline__ void xcd_barrier(const XcdBarrier& b) {
    asm volatile("s_waitcnt vmcnt(0)" ::: "memory");
    __syncthreads();
    if (threadIdx.x == 0) {
        unsigned* bar = b.bar;
        __builtin_amdgcn_s_waitcnt(0);
        unsigned nloc = b.st[0], nx = b.st[1];
        if (nloc == 0u) { xcd_barrier_complete(bar, b.x, nloc, nx); b.st[0] = nloc; b.st[1] = nx; }
        const unsigned old = xb_add(&bar[XB_XSUB(b.x)], 1u);
        const unsigned gen = old / nloc;
        if (old + 1u == (gen + 1u) * nloc) {
            __builtin_amdgcn_fence(__ATOMIC_RELEASE, "agent");
            asm volatile("s_waitcnt vmcnt(0)" ::: "memory");
            const unsigned og = xb_add(&bar[XB_TOP], 1u);
            const unsigned tg = og / nx;
            if (og + 1u == (tg + 1u) * nx) xb_add(&bar[XB_TOPGEN], 1u);
            else XB_SPIN(xb_ld(&bar[XB_TOPGEN]) == tg, bar);
            __builtin_amdgcn_fence(__ATOMIC_ACQUIRE, "agent");
            xb_add(&bar[XB_XGEN(b.x)], 1u);
            asm volatile("s_waitcnt vmcnt(0)" ::: "memory");
        } else {
            XB_SPIN(xb_ld(&bar[XB_XGEN(b.x)]) == gen, bar);
            __builtin_amdgcn_fence(__ATOMIC_ACQUIRE, "agent");
            asm volatile("s_waitcnt vmcnt(0)" ::: "memory");
        }
    }
    __syncthreads();
}

constexpr int CW_BAR = 4096;
constexpr int MISC_OFF = 131072 + 320;
__global__ void __launch_bounds__(512, 2) fwd_kernel(Args a) {
    extern __shared__ __attribute__((aligned(16))) unsigned char lds_raw[];
    LAS unsigned char* lds = (LAS unsigned char*)lds_raw;
    const int tid = threadIdx.x, lane = tid & 63, wave = __builtin_amdgcn_readfirstlane(tid >> 6);
    const int G = gridDim.x, bid = blockIdx.x;
    unsigned char* ws = a.ws;
    const int lo = a.ph_lo, hi = a.ph_hi;
    cg::grid_group grid = cg::this_grid();
    for (int u = tid; u < (LDS_BYTES - 131072) / 4; u += 512) ((LAS unsigned*)(lds + 131072))[u] = 0u;
    __syncthreads();
    volatile LAS unsigned* MISC = (volatile LAS unsigned*)(lds + MISC_OFF);
    XcdBarrier bar; bar.bar = (unsigned*)(ws + WS_CTL) + CW_BAR; bar.x = 0; bar.st = nullptr;
    if (hi - lo > 1) bar = xcd_barrier_post((unsigned*)(ws + WS_CTL) + CW_BAR, MISC + 8);
    if (lo < 0) grid.sync();
#define IN(k) (lo <= (k) && (k) < hi)
#define SEAM(k) do { if (lo <= (k) && (k) + 1 < hi) xcd_barrier(bar); } while (0)
    bf16* HB = (bf16*)(ws + WS_HB); bf16* C = (bf16*)(ws + WS_C); bf16* X3B = (bf16*)(ws + WS_X1); bf16* X1B = (bf16*)(ws + WS_X1B); bf16* Qb = (bf16*)(ws + WS_Q);
    bf16* Ob = (bf16*)(ws + WS_O); bf16* X2B = (bf16*)(ws + WS_X2B); bf16* Fb = (bf16*)(ws + WS_F);
    float* SSQ1 = (float*)(ws + WS_SSQ1); float* SSQ2 = (float*)(ws + WS_SSQ2); float* SSQ3 = (float*)(ws + WS_SSQ3);
    float* SSQ1S = (float*)(ws + WS_SSQS); float* SSQ2S = SSQ1S + NS * 64; float* SSQ3S = SSQ2S + NS * 64;
    LAS float* red = (LAS float*)lds;

    if (IN(0)) { p0_prologue(a, lds, bid, G, tid, lane, wave); }
    SEAM(0);
    if (IN(1)) {
        { pg8::Gemm g{HB, (const bf16*)(ws + WS_WIN), MP, 1536, 1024}; pg8::StaticOrder S; S.init(MP, 1536, G, bid);
          pg8::EpiIn E{(bf16*)(ws + WS_AP), (bf16*)(ws + WS_GLU), a.out + O_PP, a.out + O_CP};
          pg8::gemm_phase<pg8::EpiIn, pg8::StaticOrder, true, true>(lds, g, S, E); }
        { pg8::Gemm g{(const bf16*)(ws + WS_MB), (const bf16*)(ws + WS_WKV), MMEM, 2048, 1024}; pg8::StaticOrder S; S.init(MMEM, 2048, G, (bid + G - (128 % G)) % G);
          pg8::EpiKV E{a.out + O_MK, a.out + O_MV, (bf16*)(ws + WS_KB)};
          pg8::gemm_phase<pg8::EpiKV, pg8::StaticOrder, true, true>(lds, g, S, E); }
        { pg8::Gemm g{(const bf16*)(ws + WS_WKV) + (size_t)1024 * 1024, (const bf16*)(ws + WS_MB), 1024, MMEM, 1024}; pg8::StaticOrder S; S.init(1024, MMEM, G, (bid + G - (192 % G)) % G);
          pg8::EpiPlain E{(bf16*)(ws + WS_VT), 2048};
          pg8::gemm_phase<pg8::EpiPlain, pg8::StaticOrder, true, true>(lds, g, S, E); }
        __syncthreads();
        { SkRaw f{(float*)(ws + WS_US), 1536}; const int ge = G > 32 ? 32 : G, cc = (bid + G - (224 % G)) % G; if (cc < ge) skinny<false>(HB + (size_t)MP * DM, (const bf16*)(ws + WS_WIN), 1024, 96, cc, ge, red, tid, f); }
    }
    SEAM(1);
    if (IN(2)) {
        mixer_phase(a, lds, bid, G, tid, lane, wave);
    }
    SEAM(2);
    if (IN(3)) {
        { pg8::Gemm g{C, (const bf16*)(ws + WS_WOUT), MP, 1024, 1024}; pg8::StaticOrder S; S.init(MP, 1024, G, bid);
          pg8::EpiRes<false> E{a.in[0], X1B, SSQ1};
          pg8::gemm_phase<pg8::EpiRes<false>, pg8::StaticOrder, false, true>(lds, g, S, E); }
        __syncthreads();
        { SkRes<false> f{a.in[1], X1B + (size_t)MP * DM, SSQ1S}; skinny<false>(C + (size_t)MP * DM, (const bf16*)(ws + WS_WOUT), 1024, 64, bid, G, red, tid, f); }
    }
    SEAM(3);
    if (IN(4)) {
        { pg8::Gemm g{X1B, (const bf16*)(ws + WS_WQ), MP, 1024, 1024}; pg8::StaticOrder S; S.init(MP, 1024, G, bid);
          pg8::EpiQ E{SSQ1, Qb, QSCALE};
          pg8::gemm_phase<pg8::EpiQ, pg8::StaticOrder, false, true>(lds, g, S, E); }
        __syncthreads();
        { SkQ f{SSQ1S, Qb + (size_t)MP * DM}; skinny<false>(X1B + (size_t)MP * DM, (const bf16*)(ws + WS_WQ), 1024, 64, bid, G, red, tid, f); }
    }
    SEAM(4);
    if (IN(5)) {
        for (int u = bid; u < 512; u += G) attn_prompt_unit(a, lds, u, tid, lane, wave);
        __syncthreads();
        for (int it = bid; it < 256; it += G) attn_sample_item(a, lds, it, tid, lane, wave);
    }
    SEAM(5);
    if (IN(6)) {
        { pg8::Gemm g{Ob, (const bf16*)(ws + WS_WO), MP, 1024, 1024}; pg8::StaticOrder S; S.init(MP, 1024, G, bid);
          pg8::EpiRes<true> E{X1B, X2B, SSQ2};
          pg8::gemm_phase<pg8::EpiRes<true>, pg8::StaticOrder, false, true>(lds, g, S, E); }
        __syncthreads();
        { SkRes<true> f{X1B + (size_t)MP * DM, X2B + (size_t)MP * DM, SSQ2S}; skinny<false>(Ob + (size_t)MP * DM, (const bf16*)(ws + WS_WO), 1024, 64, bid, G, red, tid, f); }
    }
    SEAM(6);
    if (IN(7)) {
        { pg8::Gemm g{X2B, (const bf16*)(ws + WS_WGU), MP, FF2, 1024}; pg8::StaticOrder S; S.init(MP, FF2, G, bid);
          pg8::EpiGU E{SSQ2, Fb};
          pg8::gemm_phase<pg8::EpiGU, pg8::StaticOrder, true, true>(lds, g, S, E); }
        __syncthreads();
        { SkGU f{SSQ2S, Fb + (size_t)MP * FF}; const int half = G >= 2 ? G / 2 : 1;
          if (bid >= G - half) skinny<true>(X2B + (size_t)MP * DM, (const bf16*)(ws + WS_WGU), 1024, 176, bid - (G - half), half, red, tid, f); }
    }
    SEAM(7);
    if (IN(8)) {
        { pg8::Gemm g{Fb, (const bf16*)(ws + WS_WD), MP, 1024, FF}; pg8::StaticOrder S; S.init(MP, 1024, G, bid);
          pg8::EpiRes<true> E{X2B, X3B, SSQ3};
          pg8::gemm_phase<pg8::EpiRes<true>, pg8::StaticOrder, false, true>(lds, g, S, E); }
        __syncthreads();
        { SkRes<true> f{X2B + (size_t)MP * DM, X3B + (size_t)MP * DM, SSQ3S}; skinny<false>(Fb + (size_t)MP * FF, (const bf16*)(ws + WS_WD), FF, 64, bid, G, red, tid, f); }
    }
    SEAM(8);
    if (IN(9)) {
        const int gw = bid * 8 + wave, NGW = G * 8;
        const f32x4* gf = (const f32x4*)a.in[27] + lane;
        for (int m = gw; m < MALL; m += NGW) {
            float* yrow; float ssum;
            if (m < MP) { yrow = a.out + O_Y + (size_t)m * DM; const float v = (lane < 16) ? SSQ3[(size_t)m * 16 + lane] : 0.f; ssum = wave_sum(v); }
            else { yrow = a.out + O_YS + (size_t)(m - MP) * DM; ssum = wave_sum(SSQ3S[(m - MP) * 64 + lane]); }
            const float rstd = 1.0f / sqrtf(ssum * (1.0f / DM) + EPS);
            const u32x2* xr = (const u32x2*)(X3B + (size_t)m * DM) + lane; f32x4* yr = (f32x4*)yrow + lane;
#pragma unroll
            for (int j = 0; j < 4; ++j) { const u32x2 w = xr[64 * j];
                const f32x4 v = {__builtin_bit_cast(float, w.x << 16), __builtin_bit_cast(float, w.x & 0xffff0000u), __builtin_bit_cast(float, w.y << 16), __builtin_bit_cast(float, w.y & 0xffff0000u)};
                yr[64 * j] = v * rstd * gf[64 * j]; }
        }
    }
#undef IN
#undef SEAM
}

#ifndef MK_MULTI
#define MK_MULTI 0
#endif
extern "C" void kernel_launch(void* const* d_in, const int* in_sizes, int n_in, void* d_out, int out_size, void* d_ws, size_t ws_size, hipStream_t stream) {
    static int grid = 0;
    if (grid == 0) {
        if (n_in != 28 || ws_size < WS_END) { fprintf(stderr, "kernel_launch: unexpected n_in %d / ws_size %zu\n", n_in, ws_size); grid = -1; return; }
        int dev = 0, cus = 0, per_cu = 0;
        (void)hipGetDevice(&dev); (void)hipDeviceGetAttribute(&cus, hipDeviceAttributeMultiprocessorCount, dev);
        if (hipFuncSetAttribute((const void*)fwd_kernel, hipFuncAttributeMaxDynamicSharedMemorySize, LDS_BYTES) != hipSuccess) { fprintf(stderr, "kernel_launch: hipFuncSetAttribute failed\n"); grid = -1; return; }
        if (hipOccupancyMaxActiveBlocksPerMultiprocessor(&per_cu, (const void*)fwd_kernel, 512, LDS_BYTES) != hipSuccess || per_cu < 1) { fprintf(stderr, "kernel_launch: occupancy query says %d\n", per_cu); per_cu = 1; }
        (void)hipGetLastError();
        grid = cus;
    }
    if (grid < 0) return;
    (void)hipMemsetAsync((char*)d_ws + WS_CTL, 0, CTL_ZERO_BYTES, stream);
    Args a{};
    for (int i = 0; i < 28; ++i) a.in[i] = (const float*)d_in[i];
    a.out = (float*)d_out; a.ws = (unsigned char*)d_ws;
#if MK_MULTI
    for (int p = 0; p < NPHASE; ++p) { a.ph_lo = p; a.ph_hi = p + 1; hipLaunchKernelGGL(fwd_kernel, dim3(grid), dim3(512), LDS_BYTES, stream, a); }
#else
    a.ph_lo = 0; a.ph_hi = NPHASE;
    void* args[] = {&a};
    hipError_t e = hipLaunchCooperativeKernel((const void*)fwd_kernel, dim3(grid), dim3(512), args, LDS_BYTES, stream);
    if (e != hipSuccess) fprintf(stderr, "cooperative launch failed: %s (grid %d)\n", hipGetErrorString(e), grid);
#endif
}
```

```cpp
#include <hip/hip_runtime.h>
#include <hip/hip_cooperative_groups.h>
#include <cstdio>
#include <cstdint>
namespace cg = cooperative_groups;
namespace pg8 {
#define PG8_LAS __attribute__((address_space(3)))
typedef unsigned short bf16_t;
typedef short bf16x8 __attribute__((ext_vector_type(8)));
typedef float f32x4 __attribute__((ext_vector_type(4)));
typedef unsigned u32x4 __attribute__((ext_vector_type(4)));
constexpr int BM = 256, BK = 64, HALF = 128, HTB = HALF * BK * 2  , STAGE_BYTES = 8 * HTB, NXCD = 8, WGM = 8;

__host__ __device__ __forceinline__ int lds_byte(int r, int c) { const int st = (r >> 4) * 2 + (c >> 5), rr = r & 15, cc = c & 31, ob = rr * 64 + cc * 2; return st * 1024 + (ob ^ (((ob >> 9) & 1) << 5)); }
__host__ __device__ __forceinline__ void stage_rc(int b, int& R, int& C) { const int st = b / 1024, sb = b % 1024, swz = sb ^ (((sb >> 9) & 1) << 5); R = (st >> 1) * 16 + swz / 64; C = (st & 1) * 32 + (swz % 64) / 2; }
__host__ __device__ __forceinline__ int perm32(int rho) { const int n = rho >> 4, i = rho & 15; return 8 * (i >> 2) + 4 * n + (i & 3); }

struct Unit { int pm, pn; };
struct Gemm { const bf16_t* A; const bf16_t* Bt; int M, N, K; };

struct StaticOrder {
    int nM, nN, nwg, G, c;
    __host__ __device__ void init(int M, int N, int G_, int c_) { nM = M / BM; nN = N / BM; nwg = nM * nN; G = G_; c = c_; }
    __host__ __device__ bool next(int i, Unit& u) const {
        const long L = (long)i * G + c; if (L >= nwg) return false;
        int wgid = (int)L; { const int q = nwg / NXCD, r = nwg % NXCD, xcd = wgid % NXCD, off = wgid / NXCD; wgid = (xcd < r ? xcd * (q + 1) : r * (q + 1) + (xcd - r) * q) + off; }
        const int nig = WGM * nN, gid = wgid / nig, fm = gid * WGM, gsz = (nM - fm) < WGM ? (nM - fm) : WGM;
        u.pm = fm + ((wgid % nig) % gsz); u.pn = (wgid % nig) / gsz; return true;
    }
    __device__ __forceinline__ void a_ready(const Unit&) const {}
    __device__ __forceinline__ void done(const Unit&) const {}
};
typedef unsigned u32x4 __attribute__((ext_vector_type(4)));
constexpr float EPSF = 1e-6f;
__device__ __forceinline__ unsigned cvt_pk_bf16(float lo, float hi) { unsigned r; asm volatile("v_cvt_pk_bf16_f32 %0, %1, %2" : "=v"(r) : "v"(lo), "v"(hi)); return r; }
__device__ __forceinline__ u32x4 pack8(const f32x4 a, const f32x4 b) { u32x4 w; w.x = cvt_pk_bf16(a[0], a[1]); w.y = cvt_pk_bf16(a[2], a[3]); w.z = cvt_pk_bf16(b[0], b[1]); w.w = cvt_pk_bf16(b[2], b[3]); return w; }
__device__ __forceinline__ float sigm(float x) { return __builtin_amdgcn_rcpf(1.0f + __builtin_amdgcn_exp2f(-1.4426950408889634f * x)); }
__device__ __forceinline__ float rstd16(const float* p) {
    const f32x4 a = ((const f32x4*)p)[0], b = ((const f32x4*)p)[1], c = ((const f32x4*)p)[2], d = ((const f32x4*)p)[3];
    const float s = ((a[0] + a[1]) + (a[2] + a[3])) + ((b[0] + b[1]) + (b[2] + b[3])) + ((c[0] + c[1]) + (c[2] + c[3])) + ((d[0] + d[1]) + (d[2] + d[3]));
    return 1.0f / sqrtf(s * (1.0f / 1024.0f) + EPSF);
}
struct EpiIn {
    static constexpr bool PERM = true, AFTER_DRAIN = false;
    bf16_t* AP; bf16_t* GLU; float* outPP; float* outCP;
    __device__ __forceinline__ void operator()(const f32x4 (&acc)[2][2][4][2], const Unit& u, int wr, int wc, int fr, int fq) const {
        const int row0 = u.pm * BM + wr * 64 + fr, cl = wc * 32 + 8 * fq;
        if (u.pn < 2) {
#pragma unroll
            for (int ai = 0; ai < 2; ++ai)
#pragma unroll
                for (int m = 0; m < 4; ++m) { const int row = row0 + ai * HALF + m * 16, t = row & 2047, b = row >> 11;
#pragma unroll
                    for (int bj = 0; bj < 2; ++bj) { const int col = u.pn * 256 + bj * HALF + cl; const f32x4 v0 = acc[ai][bj][m][0], v1 = acc[ai][bj][m][1];
                        *(u32x4*)(AP + (size_t)row * 512 + col) = pack8(v0, v1);
                        if (t >= 2033) { float* o = outPP + ((size_t)(b * 15 + t - 2033) * 512 + col); *(f32x4*)o = v0; *(f32x4*)(o + 4) = v1; } } }
        } else {
            const int ch = (u.pn - 2) * 128 + cl;
#pragma unroll
            for (int ai = 0; ai < 2; ++ai)
#pragma unroll
                for (int m = 0; m < 4; ++m) { const int row = row0 + ai * HALF + m * 16, t = row & 2047, b = row >> 11;
                    f32x4 o0, o1;
#pragma unroll
                    for (int j = 0; j < 4; ++j) { o0[j] = acc[ai][0][m][0][j] * sigm(acc[ai][1][m][0][j]); o1[j] = acc[ai][0][m][1][j] * sigm(acc[ai][1][m][1][j]); }
                    *(u32x4*)(GLU + (size_t)row * 512 + ch) = pack8(o0, o1);
                    if (t >= 2018) { float* o = outCP + ((size_t)(b * 30 + t - 2018) * 512 + ch); *(f32x4*)o = o0; *(f32x4*)(o + 4) = o1; } }
        }
    }
};
struct EpiKV {
    static constexpr bool PERM = true, AFTER_DRAIN = false;
    float* outK; float* outV; bf16_t* KB;
    __device__ __forceinline__ void operator()(const f32x4 (&acc)[2][2][4][2], const Unit& u, int wr, int wc, int fr, int fq) const {
        const int row0 = u.pm * BM + wr * 64 + fr, cl = wc * 32 + 8 * fq;
#pragma unroll
        for (int ai = 0; ai < 2; ++ai)
#pragma unroll
            for (int m = 0; m < 4; ++m) { const int row = row0 + ai * HALF + m * 16;
#pragma unroll
                for (int bj = 0; bj < 2; ++bj) { const int col = u.pn * 256 + bj * HALF + cl; const f32x4 v0 = acc[ai][bj][m][0], v1 = acc[ai][bj][m][1];
                    if (u.pn < 4) { float* o = outK + (size_t)row * 1024 + col; *(f32x4*)o = v0; *(f32x4*)(o + 4) = v1; *(u32x4*)(KB + (size_t)row * 1024 + col) = pack8(v0, v1); }
                    else { float* o = outV + (size_t)row * 1024 + (col - 1024); *(f32x4*)o = v0; *(f32x4*)(o + 4) = v1; } } }
    }
};
struct EpiPlain {
    static constexpr bool PERM = true, AFTER_DRAIN = false;
    bf16_t* O; int ldc;
    __device__ __forceinline__ void operator()(const f32x4 (&acc)[2][2][4][2], const Unit& u, int wr, int wc, int fr, int fq) const {
        const int row0 = u.pm * BM + wr * 64 + fr, cl = wc * 32 + 8 * fq;
#pragma unroll
        for (int ai = 0; ai < 2; ++ai)
#pragma unroll
            for (int m = 0; m < 4; ++m) { const int row = row0 + ai * HALF + m * 16;
#pragma unroll
                for (int bj = 0; bj < 2; ++bj) { const int col = u.pn * 256 + bj * HALF + cl; *(u32x4*)(O + (size_t)row * ldc + col) = pack8(acc[ai][bj][m][0], acc[ai][bj][m][1]); } }
    }
};
template <bool RES_BF16> struct EpiRes {
    static constexpr bool PERM = true, AFTER_DRAIN = false;
    const void* resid; bf16_t* xb; float* ssq; const float* bias;
    __device__ __forceinline__ void operator()(const f32x4 (&acc)[2][2][4][2], const Unit& u, int wr, int wc, int fr, int fq) const {
        const int row0 = u.pm * BM + wr * 64 + fr, cl = wc * 32 + 8 * fq;
#pragma unroll
        for (int ai = 0; ai < 2; ++ai)
#pragma unroll
            for (int m = 0; m < 4; ++m) { const int row = row0 + ai * HALF + m * 16; float ss = 0.f;
#pragma unroll
                for (int bj = 0; bj < 2; ++bj) { const size_t off = (size_t)row * 1024 + u.pn * 256 + bj * HALF + cl;
                    f32x4 r0, r1;
                    if (RES_BF16) { const u32x4 w = *(const u32x4*)((const bf16_t*)resid + off);
                        r0 = (f32x4){__builtin_bit_cast(float, w.x << 16), __builtin_bit_cast(float, w.x & 0xffff0000u), __builtin_bit_cast(float, w.y << 16), __builtin_bit_cast(float, w.y & 0xffff0000u)};
                        r1 = (f32x4){__builtin_bit_cast(float, w.z << 16), __builtin_bit_cast(float, w.z & 0xffff0000u), __builtin_bit_cast(float, w.w << 16), __builtin_bit_cast(float, w.w & 0xffff0000u)}; }
                    else { const int col = u.pn * 256 + bj * HALF + cl; r0 = *(const f32x4*)((const float*)resid + off) + *(const f32x4*)(bias + col); r1 = *(const f32x4*)((const float*)resid + off + 4) + *(const f32x4*)(bias + col + 4); }
                    const f32x4 x0 = r0 + acc[ai][bj][m][0], x1 = r1 + acc[ai][bj][m][1];
                    *(u32x4*)(xb + off) = pack8(x0, x1);
                    ss += ((x0[0] * x0[0] + x0[1] * x0[1]) + (x0[2] * x0[2] + x0[3] * x0[3])) + ((x1[0] * x1[0] + x1[1] * x1[1]) + (x1[2] * x1[2] + x1[3] * x1[3])); }
                ss += __shfl_xor(ss, 16); ss += __shfl_xor(ss, 32);
                if (fq == 0) ssq[(size_t)row * 16 + u.pn * 4 + wc] = ss; }
    }
};
struct EpiQ {
    static constexpr bool PERM = true, AFTER_DRAIN = false;
    const float* ssq; bf16_t* Q; float scale;
    __device__ __forceinline__ void operator()(const f32x4 (&acc)[2][2][4][2], const Unit& u, int wr, int wc, int fr, int fq) const {
        const int row0 = u.pm * BM + wr * 64 + fr, cl = wc * 32 + 8 * fq;
#pragma unroll
        for (int ai = 0; ai < 2; ++ai)
#pragma unroll
            for (int m = 0; m < 4; ++m) { const int row = row0 + ai * HALF + m * 16; const float rs = rstd16(ssq + (size_t)row * 16) * scale;
#pragma unroll
                for (int bj = 0; bj < 2; ++bj) { const size_t off = (size_t)row * 1024 + u.pn * 256 + bj * HALF + cl;
                    *(u32x4*)(Q + off) = pack8(acc[ai][bj][m][0] * rs, acc[ai][bj][m][1] * rs); } }
    }
};
struct EpiGU {
    static constexpr bool PERM = true, AFTER_DRAIN = false;
    const float* ssq; bf16_t* F;
    __device__ __forceinline__ void operator()(const f32x4 (&acc)[2][2][4][2], const Unit& u, int wr, int wc, int fr, int fq) const {
        const int row0 = u.pm * BM + wr * 64 + fr, cl = wc * 32 + 8 * fq;
#pragma unroll
        for (int ai = 0; ai < 2; ++ai)
#pragma unroll
            for (int m = 0; m < 4; ++m) { const int row = row0 + ai * HALF + m * 16; const float rs = rstd16(ssq + (size_t)row * 16);
                f32x4 o0, o1;
#pragma unroll
                for (int j = 0; j < 4; ++j) { const float g0 = acc[ai][0][m][0][j] * rs, g1 = acc[ai][0][m][1][j] * rs;
                    o0[j] = g0 * sigm(g0) * (acc[ai][1][m][0][j] * rs); o1[j] = g1 * sigm(g1) * (acc[ai][1][m][1][j] * rs); }
                *(u32x4*)(F + (size_t)row * 2816 + u.pn * 128 + cl) = pack8(o0, o1); }
    }
};
template <class Epi, class Sched, bool ALIGN_EPI = false, bool SP2 = false>
__device__ __forceinline__ void gemm_phase(PG8_LAS unsigned char* lds, const Gemm g, const Sched& S, const Epi& E) {
    const int tid = threadIdx.x, wid = __builtin_amdgcn_readfirstlane(tid >> 6), lane = tid & 63, wr = wid >> 2, wc = wid & 3, fr = lane & 15, fq = lane >> 4;
    const int K = g.K, nt = K / BK;
    unsigned voffA[2], voffB[2];
#pragma unroll
    for (int i = 0; i < 2; ++i) { int R, C; stage_rc(tid * 16 + i * 8192, R, C); const int Rb = Epi::PERM ? ((R & ~31) + perm32(R & 31)) : R;
        voffA[i] = (unsigned)(R * K + C) * 2u; voffB[i] = (unsigned)(Rb * K + C) * 2u; }
    const size_t kstep = (size_t)(BK * 2);
    const size_t hstep = (size_t)HALF * K * 2;
    const size_t tstep = 2 * hstep;
    const unsigned ldsw = (unsigned)wid * 1024u;
    const int aoff = lds_byte(wr * 64 + fr, fq * 8), boff = lds_byte(wc * 32 + fr, fq * 8);
#define PG8_SA(b, h) (((b) * 2 + (h)) * HTB)
#define PG8_SB(b, h) ((4 + (b) * 2 + (h)) * HTB)
#define PG8_STAGE(bufoff, gbase, voff) do { _Pragma("unroll") for (int _i = 0; _i < 2; ++_i) \
        __builtin_amdgcn_global_load_lds((const unsigned*)((const char*)(gbase) + (voff)[_i]), (PG8_LAS unsigned*)(lds + (bufoff) + ldsw + _i * 8192), 16, 0, 0); } while (0)
#define PG8_LDA(dst, b, h) do { _Pragma("unroll") for (int m = 0; m < 4; ++m) _Pragma("unroll") for (int k = 0; k < 2; ++k) dst[m][k] = *(const PG8_LAS bf16x8*)(lds + PG8_SA(b, h) + aoff + m * 2048 + k * 1024); } while (0)
#define PG8_LDB(dst, b, h) do { _Pragma("unroll") for (int n = 0; n < 2; ++n) _Pragma("unroll") for (int k = 0; k < 2; ++k) dst[n][k] = *(const PG8_LAS bf16x8*)(lds + PG8_SB(b, h) + boff + n * 2048 + k * 1024); } while (0)
#define PG8_MMA(ai, bj, At, Bt) do { __builtin_amdgcn_s_setprio(1); _Pragma("unroll") for (int m = 0; m < 4; ++m) _Pragma("unroll") for (int n = 0; n < 2; ++n) _Pragma("unroll") for (int k = 0; k < 2; ++k) \
        acc[ai][bj][m][n] = __builtin_amdgcn_mfma_f32_16x16x32_bf16(Bt[n][k], At[m][k], acc[ai][bj][m][n], 0, 0, 0); __builtin_amdgcn_s_setprio(0); } while (0)
#define PG8_WAIT_V(n) asm volatile("s_waitcnt vmcnt(" #n ")" ::: "memory")
#define PG8_WAIT_L(n) asm volatile("s_waitcnt lgkmcnt(" #n ")" ::: "memory")
#define PG8_BAR __builtin_amdgcn_s_barrier()
#define PG8_SCHED __builtin_amdgcn_sched_barrier(0)
    Unit cur, nxt; int ui = 0;
    if (!S.next(0, cur)) return;
    f32x4 acc[2][2][4][2];
#pragma unroll
    for (int a = 0; a < 2; ++a)
#pragma unroll
        for (int b = 0; b < 2; ++b)
#pragma unroll
            for (int m = 0; m < 4; ++m)
#pragma unroll
                for (int n = 0; n < 2; ++n) acc[a][b][m][n] = (f32x4){0.f, 0.f, 0.f, 0.f};
    bf16x8 At[4][2], B0[2][2], B1[2][2];
    const char* cA = (const char*)g.A + (size_t)cur.pm * tstep; const char* cB = (const char*)g.Bt + (size_t)cur.pn * tstep;
    S.a_ready(cur);
    if constexpr (SP2) {
        PG8_STAGE(PG8_SB(0, 0), cB, voffB); PG8_STAGE(PG8_SB(0, 1), cB + hstep, voffB); PG8_STAGE(PG8_SA(0, 0), cA, voffA); PG8_STAGE(PG8_SA(0, 1), cA + hstep, voffA);
        if (wr == 1) PG8_BAR;
        PG8_WAIT_V(2); PG8_BAR;
        PG8_STAGE(PG8_SB(1, 0), cB + kstep, voffB); PG8_STAGE(PG8_SA(1, 0), cA + kstep, voffA); PG8_STAGE(PG8_SB(1, 1), cB + hstep + kstep, voffB);
        PG8_WAIT_V(6); PG8_BAR;
    } else {
        PG8_STAGE(PG8_SB(0, 0), cB, voffB); PG8_STAGE(PG8_SA(0, 0), cA, voffA); PG8_STAGE(PG8_SB(0, 1), cB + hstep, voffB); PG8_STAGE(PG8_SA(0, 1), cA + hstep, voffA);
        if (wr == 1) PG8_BAR;
        PG8_WAIT_V(4); PG8_BAR;
        PG8_STAGE(PG8_SB(1, 0), cB + kstep, voffB); PG8_STAGE(PG8_SA(1, 0), cA + kstep, voffA); PG8_STAGE(PG8_SB(1, 1), cB + hstep + kstep, voffB);
        PG8_WAIT_V(6); PG8_BAR;
    }
    for (;;) {
        const bool has_next = S.next(ui + 1, nxt);
        const char* nA = has_next ? (const char*)g.A + (size_t)nxt.pm * tstep : cA; const char* nB = has_next ? (const char*)g.Bt + (size_t)nxt.pn * tstep : cB;
        for (int t = 0; t < nt; t += 2) {
            const bool last = (t == nt - 2);
            const char* a1 = cA + (size_t)(t + 1) * kstep;
            const char* a2 = last ? nA : cA + (size_t)(t + 2) * kstep; const char* b2 = last ? nB : cB + (size_t)(t + 2) * kstep;
            const char* a3 = a2 + kstep; const char* b3 = b2 + kstep;
            if (last && has_next) S.a_ready(nxt);
            if constexpr (SP2) {
            PG8_LDB(B0, 0, 0); PG8_LDB(B1, 0, 1); PG8_SCHED; PG8_LDA(At, 0, 0); PG8_STAGE(PG8_SA(1, 1), a1 + hstep, voffA);
            PG8_WAIT_V(8); PG8_WAIT_L(0); PG8_BAR; PG8_MMA(0, 0, At, B0); PG8_MMA(0, 1, At, B1); PG8_BAR; PG8_SCHED;
            PG8_LDA(At, 0, 1); PG8_STAGE(PG8_SB(0, 0), b2, voffB); PG8_STAGE(PG8_SB(0, 1), b2 + hstep, voffB); PG8_STAGE(PG8_SA(0, 0), a2, voffA);
            PG8_WAIT_V(8); PG8_WAIT_L(0); PG8_BAR; PG8_MMA(1, 0, At, B0); PG8_MMA(1, 1, At, B1); PG8_BAR; PG8_SCHED;
            PG8_LDB(B0, 1, 0); PG8_LDB(B1, 1, 1); PG8_SCHED; PG8_LDA(At, 1, 0); PG8_STAGE(PG8_SA(0, 1), a2 + hstep, voffA);
            PG8_WAIT_V(8); PG8_WAIT_L(0); PG8_BAR; PG8_MMA(0, 0, At, B0); PG8_MMA(0, 1, At, B1); PG8_BAR; PG8_SCHED;
            PG8_LDA(At, 1, 1); PG8_STAGE(PG8_SB(1, 0), b3, voffB); PG8_STAGE(PG8_SB(1, 1), b3 + hstep, voffB); PG8_STAGE(PG8_SA(1, 0), a3, voffA);
            PG8_WAIT_V(8); PG8_WAIT_L(0); PG8_BAR; PG8_MMA(1, 0, At, B0); PG8_MMA(1, 1, At, B1); PG8_BAR; PG8_SCHED;
            } else {
            PG8_LDB(B0, 0, 0); PG8_SCHED; PG8_LDA(At, 0, 0); PG8_STAGE(PG8_SA(1, 1), a1 + hstep, voffA);
            PG8_WAIT_L(8); PG8_BAR; PG8_WAIT_L(0); PG8_MMA(0, 0, At, B0); PG8_BAR; PG8_SCHED;
            PG8_LDB(B1, 0, 1); PG8_STAGE(PG8_SB(0, 0), b2, voffB);
            PG8_BAR; PG8_WAIT_L(0); PG8_MMA(0, 1, At, B1); PG8_BAR;
            PG8_LDA(At, 0, 1); PG8_STAGE(PG8_SA(0, 0), a2, voffA);
            PG8_BAR; PG8_WAIT_L(0); PG8_MMA(1, 0, At, B0); PG8_BAR; PG8_SCHED;
            PG8_STAGE(PG8_SB(0, 1), b2 + hstep, voffB);
            PG8_WAIT_V(6); PG8_BAR; PG8_MMA(1, 1, At, B1); PG8_BAR;
            PG8_LDB(B0, 1, 0); PG8_SCHED; PG8_LDA(At, 1, 0); PG8_STAGE(PG8_SA(0, 1), a2 + hstep, voffA);
            PG8_WAIT_L(8); PG8_BAR; PG8_WAIT_L(0); PG8_MMA(0, 0, At, B0); PG8_BAR; PG8_SCHED;
            PG8_LDB(B1, 1, 1); PG8_STAGE(PG8_SB(1, 0), b3, voffB);
            PG8_BAR; PG8_WAIT_L(0); PG8_MMA(0, 1, At, B1); PG8_BAR;
            PG8_LDA(At, 1, 1); PG8_STAGE(PG8_SA(1, 0), a3, voffA);
            PG8_BAR; PG8_WAIT_L(0); PG8_MMA(1, 0, At, B0); PG8_BAR; PG8_SCHED;
            PG8_STAGE(PG8_SB(1, 1), b3 + hstep, voffB);
            PG8_WAIT_V(6); PG8_BAR; PG8_MMA(1, 1, At, B1); PG8_BAR;
            }
        }
        if constexpr (ALIGN_EPI) { if (wr == 0) PG8_BAR; }
        if constexpr (!Epi::AFTER_DRAIN) { E(acc, cur, wr, wc, fr, fq); S.done(cur); }
        if (!has_next) break;
#pragma unroll
        for (int a = 0; a < 2; ++a)
#pragma unroll
            for (int b = 0; b < 2; ++b)
#pragma unroll
                for (int m = 0; m < 4; ++m)
#pragma unroll
                    for (int n = 0; n < 2; ++n) acc[a][b][m][n] = (f32x4){0.f, 0.f, 0.f, 0.f};
        cur = nxt; cA = nA; cB = nB; ++ui;
        if constexpr (ALIGN_EPI) { if (wr == 1) PG8_BAR; }
    }
    PG8_WAIT_V(0);
    if constexpr (!ALIGN_EPI) { if (wr == 0) PG8_BAR; }
    PG8_BAR;
    if constexpr (Epi::AFTER_DRAIN) { E.fused(acc, cur, wr, wc, fr, fq, lds, wid, lane); S.done(cur); }
#undef PG8_SA
#undef PG8_SB
#undef PG8_STAGE
#undef PG8_LDA
#undef PG8_LDB
#undef PG8_MMA
#undef PG8_WAIT_V
#undef PG8_WAIT_L
#undef PG8_BAR
#undef PG8_SCHED
}
}

#define LAS __attribute__((address_space(3)))
typedef unsigned short bf16;
typedef float f32x4 __attribute__((ext_vector_type(4)));
typedef short bf16x8 __attribute__((ext_vector_type(8)));
typedef unsigned u32x4 __attribute__((ext_vector_type(4)));
typedef unsigned u32x2 __attribute__((ext_vector_type(2)));
constexpr int DM = 1024, NB = 8, SEQ = 2048, MP = NB * SEQ, NS = 128, MALL = MP + NS, NMEM = 256, FF = 2816, FF2 = 5632, MMEM = NB * NMEM;
constexpr float EPS = 1e-6f;
constexpr float QSCALE = 0.0625f * 1.4426950408889634f;
constexpr size_t O_Y = 0, O_YS = 16777216, O_PP = O_YS + 131072, O_PS = O_PP + 61440, O_CP = O_PS + 983040, O_CS = O_CP + 122880, O_MK = O_CS + 1966080, O_MV = O_MK + 2097152;
constexpr size_t MiB = 1u << 20;
constexpr size_t WS_CTL = 0, CTL_ZERO_BYTES = MiB;
constexpr size_t WS_WIN = 1 * MiB, WS_WKV = 4 * MiB, WS_WOUT = 8 * MiB, WS_WQ = 10 * MiB, WS_WO = 12 * MiB, WS_WGU = 14 * MiB, WS_WD = 25 * MiB, WS_WMAP = 31 * MiB;
constexpr size_t WS_HB = 32 * MiB, WS_AP = 65 * MiB, WS_GLU = 82 * MiB, WS_C = 99 * MiB, WS_X1 = 132 * MiB, WS_X1B = 197 * MiB, WS_Q = 230 * MiB, WS_KB = 263 * MiB, WS_VT = 267 * MiB;
constexpr size_t WS_O = 271 * MiB, WS_X2B = 304 * MiB, WS_F = 337 * MiB, WS_MB = 426 * MiB, WS_SSQ1 = 430 * MiB, WS_SSQ2 = 431 * MiB, WS_SSQ3 = 432 * MiB, WS_SSQS = 433 * MiB, WS_US = 434 * MiB, WS_HC = 435 * MiB;
constexpr size_t WS_HP = WS_HC + 512 * 1024, WS_END = 436 * MiB;
constexpr int LDS_BYTES = 147456;
constexpr int NPHASE = 10;

template <int CTRL> __device__ __forceinline__ float dpp_mov(float v) { return __builtin_bit_cast(float, __builtin_amdgcn_update_dpp(0, __builtin_bit_cast(int, v), CTRL, 0xF, 0xF, true)); }
__device__ __forceinline__ float rdl(float v, int l) { return __builtin_bit_cast(float, __builtin_amdgcn_readlane(__builtin_bit_cast(int, v), l)); }
__device__ __forceinline__ float wave_sum(float v) {
    v += dpp_mov<0xB1>(v); v += dpp_mov<0x4E>(v); v += dpp_mov<0x141>(v); v += dpp_mov<0x140>(v);
    return (rdl(v, 0) + rdl(v, 16)) + (rdl(v, 32) + rdl(v, 48));
}
__device__ __forceinline__ float wave_max(float v) {
    v = fmaxf(v, dpp_mov<0xB1>(v)); v = fmaxf(v, dpp_mov<0x4E>(v)); v = fmaxf(v, dpp_mov<0x141>(v)); v = fmaxf(v, dpp_mov<0x140>(v));
    return fmaxf(fmaxf(rdl(v, 0), rdl(v, 16)), fmaxf(rdl(v, 32), rdl(v, 48)));
}
__device__ __forceinline__ unsigned f2bf(float f) { unsigned u = __builtin_bit_cast(unsigned, f); return (u + 0x7fffu + ((u >> 16) & 1u)) >> 16; }
__device__ __forceinline__ unsigned pk2(float lo, float hi) { return f2bf(lo) | (f2bf(hi) << 16); }
__device__ __forceinline__ float bf2f(bf16 v) { return __builtin_bit_cast(float, (unsigned)v << 16); }
__device__ __forceinline__ float sigm(float x) { return __builtin_amdgcn_rcpf(1.0f + __builtin_amdgcn_exp2f(-1.4426950408889634f * x)); }
#define LDS_WAIT() asm volatile("s_waitcnt lgkmcnt(0)" ::: "memory")

__device__ __forceinline__ void transpose_item(const float* W, int K, int N, const float* gk, bf16* WT, int dst_row0, LAS float* scr, int k0, int n0, int lane) {
    f32x4 v[8];
#pragma unroll
    for (int i = 0; i < 8; ++i) { const int kk = (lane >> 3) + 8 * i; v[i] = *(const f32x4*)(W + (size_t)(k0 + kk) * N + n0 + 4 * (lane & 7)); }
    if (gk) {
#pragma unroll
        for (int i = 0; i < 8; ++i) v[i] = v[i] * gk[k0 + (lane >> 3) + 8 * i]; }
#pragma unroll
    for (int i = 0; i < 8; ++i) { LAS float* d = scr + ((lane >> 3) + 8 * i) * 33 + 4 * (lane & 7); d[0] = v[i].x; d[1] = v[i].y; d[2] = v[i].z; d[3] = v[i].w; }
    LDS_WAIT();
    const int c = lane & 7;
#pragma unroll
    for (int j = 0; j < 4; ++j) { const int n = (lane >> 3) + 8 * j; const LAS float* s = scr + (8 * c) * 33 + n;
        u32x4 o; o.x = pk2(s[0 * 33], s[1 * 33]); o.y = pk2(s[2 * 33], s[3 * 33]); o.z = pk2(s[4 * 33], s[5 * 33]); o.w = pk2(s[6 * 33], s[7 * 33]);
        *(u32x4*)(WT + (size_t)(dst_row0 + n) * K + k0 + 8 * c) = o; }
    LDS_WAIT();
}
__device__ __forceinline__ void rms_load(const float* xrow, int lane, f32x4 (&v)[4]) {
    const f32x4* xr = (const f32x4*)xrow + lane;
#pragma unroll
    for (int j = 0; j < 4; ++j) v[j] = xr[64 * j];
}
__device__ __forceinline__ void rms_finish(const f32x4 (&v)[4], const float* g, bf16* orow, int lane) {
    const f32x4* gr = (const f32x4*)g + lane; float s = 0.f;
#pragma unroll
    for (int j = 0; j < 4; ++j) s += (v[j].x * v[j].x + v[j].y * v[j].y) + (v[j].z * v[j].z + v[j].w * v[j].w);
    const float rstd = 1.0f / sqrtf(wave_sum(s) * (1.0f / DM) + EPS);
    unsigned long long* o8 = (unsigned long long*)orow + lane;
#pragma unroll
    for (int j = 0; j < 4; ++j) { const f32x4 gg = gr[64 * j]; const f32x4 o = v[j] * rstd * gg;
        o8[64 * j] = (unsigned long long)pk2(o.x, o.y) | ((unsigned long long)pk2(o.z, o.w) << 32); }
}

struct Args { const float* in[28]; float* out; unsigned char* ws; int ph_lo, ph_hi; };

__device__ __forceinline__ void p0_prologue(const Args& a, LAS unsigned char* lds, int bid, int G, int tid, int lane, int wave) {
    unsigned char* ws = a.ws;
    LAS float* scr = (LAS float*)(lds + wave * 16384);
    const int gw = bid * 8 + wave, NGW = G * 8;
    constexpr int I_IN = 16 * 48, I_SQ = 16 * 32, I_GU = 16 * 88, I_D = 44 * 32, I_WP = 2048, I_CB = 256;
    constexpr int NITEMS = I_IN + 5 * I_SQ + 2 * I_GU + I_D + I_WP + I_CB;
    for (int it = gw; it < NITEMS; it += NGW) {
        int r = it;
        if (r < I_IN) { const int kb = r / 48, n0 = (r % 48) * 32; int dr;
            if (n0 < 512) dr = n0; else { int j = n0 - 512; int hi = 0; if (j >= 512) { j -= 512; hi = 128; } dr = 512 + (j >> 7) * 256 + hi + (j & 127); }
            transpose_item(a.in[8], 1024, 1536, nullptr, (bf16*)(ws + WS_WIN), dr, scr, 64 * kb, n0, lane); continue; } r -= I_IN;
        if (r < I_SQ) { transpose_item(a.in[20], 1024, 1024, nullptr, (bf16*)(ws + WS_WKV), (r % 32) * 32, scr, 64 * (r / 32), (r % 32) * 32, lane); continue; } r -= I_SQ;
        if (r < I_SQ) { transpose_item(a.in[21], 1024, 1024, nullptr, (bf16*)(ws + WS_WKV), 1024 + (r % 32) * 32, scr, 64 * (r / 32), (r % 32) * 32, lane); continue; } r -= I_SQ;
        if (r < I_SQ) { if (r >= I_SQ / 2) transpose_item(a.in[16], 1024, 1024, nullptr, (bf16*)(ws + WS_WOUT), (r % 32) * 32, scr, 64 * (r / 32), (r % 32) * 32, lane); continue; } r -= I_SQ;
        if (r < I_SQ) { transpose_item(a.in[19], 1024, 1024, a.in[17], (bf16*)(ws + WS_WQ), (r % 32) * 32, scr, 64 * (r / 32), (r % 32) * 32, lane); continue; } r -= I_SQ;
        if (r < I_SQ) { transpose_item(a.in[22], 1024, 1024, nullptr, (bf16*)(ws + WS_WO), (r % 32) * 32, scr, 64 * (r / 32), (r % 32) * 32, lane); continue; } r -= I_SQ;
        if (r < I_GU) { const int n0 = (r % 88) * 32; transpose_item(a.in[24], 1024, FF, a.in[23], (bf16*)(ws + WS_WGU), (n0 >> 7) * 256 + (n0 & 127), scr, 64 * (r / 88), n0, lane); continue; } r -= I_GU;
        if (r < I_GU) { const int n0 = (r % 88) * 32; transpose_item(a.in[25], 1024, FF, a.in[23], (bf16*)(ws + WS_WGU), (n0 >> 7) * 256 + 128 + (n0 & 127), scr, 64 * (r / 88), n0, lane); continue; } r -= I_GU;
        if (r < I_D) { transpose_item(a.in[26], FF, 1024, nullptr, (bf16*)(ws + WS_WD), (r % 32) * 32, scr, 64 * (r / 32), (r % 32) * 32, lane); continue; } r -= I_D;
if (r < I_WP) {
            const int g = r >> 9, n0 = ((r >> 3) & 63) * 16, c0 = (r & 7) * 16, fr = lane & 15, fq = lane >> 4;
            const float* Wout = a.in[16]; const float* Wm = a.in[9] + (size_t)g * 16384; const float* sc = a.in[11] + g * 128;
            f32x4 acc = {0.f, 0.f, 0.f, 0.f};
#pragma unroll
            for (int ks = 0; ks < 4; ++ks) { float av[8];
#pragma unroll
                for (int e = 0; e < 8; ++e) av[e] = Wout[(size_t)(g * 128 + 32 * ks + 8 * fq + e) * 1024 + n0 + fr];
                const f32x4 m0 = *(const f32x4*)(Wm + (c0 + fr) * 128 + 32 * ks + 8 * fq) * *(const f32x4*)(sc + 32 * ks + 8 * fq), m1 = *(const f32x4*)(Wm + (c0 + fr) * 128 + 32 * ks + 8 * fq + 4) * *(const f32x4*)(sc + 32 * ks + 8 * fq + 4);
                u32x4 aw, bw; aw.x = pk2(av[0], av[1]); aw.y = pk2(av[2], av[3]); aw.z = pk2(av[4], av[5]); aw.w = pk2(av[6], av[7]);
                bw.x = pk2(m0.x, m0.y); bw.y = pk2(m0.z, m0.w); bw.z = pk2(m1.x, m1.y); bw.w = pk2(m1.z, m1.w);
                acc = __builtin_amdgcn_mfma_f32_16x16x32_bf16(__builtin_bit_cast(bf16x8, aw), __builtin_bit_cast(bf16x8, bw), acc, 0, 0, 0); }
            bf16* WT = (bf16*)(ws + WS_WOUT);
#pragma unroll
            for (int jj = 0; jj < 4; ++jj) WT[(size_t)(n0 + 4 * fq + jj) * 1024 + g * 128 + c0 + fr] = (bf16)f2bf(acc[jj]);
            continue; } r -= I_WP;
        {
            const int nb = r & 15, cb = r >> 4; const float* Wout = a.in[16]; float part = 0.f;
#pragma unroll
            for (int e = 0; e < 32; ++e) { const int ch = 32 * cb + e; part += (a.in[10][ch] * a.in[11][ch]) * Wout[(size_t)ch * 1024 + 64 * nb + lane]; }
            atomicAdd((float*)(ws + WS_CTL + 512 * 1024) + 64 * nb + lane, part); }
    }
#define ROW_SRC(m) ((m) < MP ? a.in[0] + (size_t)(m) * DM : ((m) < MALL ? a.in[1] + (size_t)((m) - MP) * DM : a.in[2] + (size_t)((m) - MALL) * DM))
    { f32x4 cur[4], nxt[4]; int m = gw;
      if (m < MALL + MMEM) rms_load(ROW_SRC(m), lane, cur);
      for (; m < MALL + MMEM; m += NGW) { const int mn = m + NGW;
          if (mn < MALL + MMEM) rms_load(ROW_SRC(mn), lane, nxt);
          if (m < MALL) rms_finish(cur, a.in[7], (bf16*)(ws + WS_HB) + (size_t)m * DM, lane);
          else rms_finish(cur, a.in[18], (bf16*)(ws + WS_MB) + (size_t)(m - MALL) * DM, lane);
#pragma unroll
          for (int j = 0; j < 4; ++j) cur[j] = nxt[j]; } }
#undef ROW_SRC
    const float* spool = a.in[3]; const float* sconv = a.in[4]; const float* wdw = a.in[12]; const float* bdw = a.in[13];
    float* HC = (float*)(ws + WS_HC); float* HP = (float*)(ws + WS_HP);
    for (int e2 = bid * 512 + tid; e2 < 2 * NS * 512; e2 += G * 512) {
        const int e = e2 & (NS * 512 - 1), b = e >> 9, ch = e & 511;
        if (e2 < NS * 512) {
            float v[30];
#pragma unroll
            for (int j = 0; j < 30; ++j) v[j] = sconv[(size_t)(b * 30 + j) * 512 + ch];
            float acc = bdw[ch];
#pragma unroll
            for (int j = 0; j < 30; ++j) { acc += wdw[j * 512 + ch] * v[j]; if (j >= 1) a.out[O_CS + (size_t)(b * 30 + j - 1) * 512 + ch] = v[j]; }
            HC[e] = acc;
        } else {
            float v[15];
#pragma unroll
            for (int j = 0; j < 15; ++j) v[j] = spool[(size_t)(b * 15 + j) * 512 + ch];
            const int w = 2 << (ch >> 7); float sacc = 0.f;
#pragma unroll
            for (int j = 0; j < 15; ++j) { if (j >= 1) a.out[O_PS + (size_t)(b * 15 + j - 1) * 512 + ch] = v[j]; if (j >= 16 - w) sacc += v[j]; }
            HP[e] = sacc;
        }
    }
}

template <bool PAIR, class Fn>
__device__ __forceinline__ void skinny(const bf16* A, const bf16* Bt, int K, int nColBlk, int c, int G, LAS float* red, int tid, const Fn& fn) {
    const int lane = tid & 63, wave = __builtin_amdgcn_readfirstlane(tid >> 6), fr = lane & 15, fq = lane >> 4;
    const int nItems = nColBlk * 4, kw = K >> 3;
    for (int it = c; it < nItems; it += G) {
        const int rb = it & 3, cb = it >> 2;
        const int n0 = PAIR ? ((cb >> 3) * 256 + (cb & 7) * 16) : cb * 16;
        const bf16* ap = A + (size_t)(32 * rb + fr) * K + wave * kw + 8 * fq;
        const bf16* bp = Bt + (size_t)(n0 + fr) * K + wave * kw + 8 * fq;
        f32x4 c00 = {0.f, 0.f, 0.f, 0.f}, c01 = c00, c10 = c00, c11 = c00;
        for (int ks = 0; ks < kw; ks += 32) {
            const bf16x8 b0 = *(const bf16x8*)(bp + ks), a0 = *(const bf16x8*)(ap + ks), a1 = *(const bf16x8*)(ap + (size_t)16 * K + ks);
            c00 = __builtin_amdgcn_mfma_f32_16x16x32_bf16(b0, a0, c00, 0, 0, 0); c01 = __builtin_amdgcn_mfma_f32_16x16x32_bf16(b0, a1, c01, 0, 0, 0);
            if (PAIR) { const bf16x8 b1 = *(const bf16x8*)(bp + (size_t)128 * K + ks);
                c10 = __builtin_amdgcn_mfma_f32_16x16x32_bf16(b1, a0, c10, 0, 0, 0); c11 = __builtin_amdgcn_mfma_f32_16x16x32_bf16(b1, a1, c11, 0, 0, 0); }
        }
        LAS float* rw = red + wave * 1024;
        *(LAS f32x4*)(rw + fr * 16 + 4 * fq) = c00; *(LAS f32x4*)(rw + (16 + fr) * 16 + 4 * fq) = c01;
        if (PAIR) { *(LAS f32x4*)(rw + 512 + fr * 16 + 4 * fq) = c10; *(LAS f32x4*)(rw + 512 + (16 + fr) * 16 + 4 * fq) = c11; }
        __syncthreads();
        float v0 = 0.f, v1 = 0.f;
#pragma unroll
        for (int w = 0; w < 8; ++w) { v0 += red[w * 1024 + tid]; if (PAIR) v1 += red[w * 1024 + 512 + tid]; }
        fn(32 * rb + (tid >> 4), cb * 16 + (tid & 15), cb, v0, v1);
        __syncthreads();
    }
}
__device__ __forceinline__ float red16(float s) { s += __shfl_xor(s, 1); s += __shfl_xor(s, 2); s += __shfl_xor(s, 4); s += __shfl_xor(s, 8); return s; }
__device__ __forceinline__ float rstd_s(const float* p, int row, int ci) {
    const float* q = p + row * 64 + ci; return 1.0f / sqrtf(red16((q[0] + q[16]) + (q[32] + q[48])) * (1.0f / DM) + EPS);
}
struct SkRaw { float* O; int ld; __device__ __forceinline__ void operator()(int row, int col, int, float v0, float) const { O[(size_t)row * ld + col] = v0; } };
template <bool RES_BF16> struct SkRes { const void* resid; bf16* xb; float* ssq; const float* bias;
    __device__ __forceinline__ void operator()(int row, int col, int cb, float v0, float) const {
        const size_t off = (size_t)row * DM + col; const float r = RES_BF16 ? bf2f(((const bf16*)resid)[off]) : ((const float*)resid)[off] + bias[col];
        const float x = r + v0; xb[off] = (bf16)f2bf(x);
        const float ss = red16(x * x); if ((col & 15) == 0) ssq[row * 64 + cb] = ss; } };
struct SkQ { const float* ssq; bf16* Q; __device__ __forceinline__ void operator()(int row, int col, int, float v0, float) const {
        const float rs = rstd_s(ssq, row, col & 15) * QSCALE; Q[(size_t)row * DM + col] = (bf16)f2bf(v0 * rs); } };
struct SkGU { const float* ssq; bf16* F; __device__ __forceinline__ void operator()(int row, int col, int, float v0, float v1) const {
        const float rs = rstd_s(ssq, row, col & 15); const float g = v0 * rs; F[(size_t)row * FF + col] = (bf16)f2bf(g * sigm(g) * (v1 * rs)); } };

constexpr int MX_TG = 0, MX_TA = 46 * 1024, MX_YC = MX_TA + 31 * 1024, MX_D = MX_YC + 16 * 2048, MX_DSTRIDE = 1024, MX_NPIECE = (46 + 31) * 64;
static_assert(MX_D + 16 * MX_DSTRIDE <= 131072, "mixer LDS");
template <int W> __device__ __forceinline__ void pool16(int t0, int tid, LAS unsigned char* lds) {
    float in[16 + W - 1];
#pragma unroll
    for (int i = 0; i < 16 + W - 1; ++i) in[i] = bf2f(*(const LAS bf16*)(lds + MX_TA + (16 - W + i) * 1024 + tid * 2));
#pragma unroll
    for (int r = 0; r < 16; ++r) { float s = 0.f;
#pragma unroll
        for (int j = 0; j < W; ++j) s += in[r + j];
        const int t = t0 + r; const int cnt = (t + 1 < W) ? (t + 1) : W;
        const float d = s / (float)cnt - in[r + W - 1];
        *(LAS bf16*)(lds + MX_D + r * MX_DSTRIDE + tid * 2) = (bf16)f2bf(d); }
}
struct MixP { f32x4 g0, g1, b0, b1; };
__device__ __forceinline__ void mixer_finish(const Args& a, LAS unsigned char* lds, int crow0, int tid, int lane, int wave, const MixP& P) {
    bf16* C = (bf16*)(a.ws + WS_C);
    const LAS float* yc = (const LAS float*)(lds + MX_YC);
    { const f32x4 g0 = P.g0, g1 = P.g1, b0 = P.b0, b1 = P.b1;
#pragma unroll
      for (int i = 0; i < 2; ++i) { const int r = 2 * wave + i;
        const f32x4 y0 = *(const LAS f32x4*)(yc + r * 512 + lane * 8), y1 = *(const LAS f32x4*)(yc + r * 512 + lane * 8 + 4);
        const float mu = wave_sum((y0.x + y0.y) + (y0.z + y0.w) + (y1.x + y1.y) + (y1.z + y1.w)) * (1.0f / 512.0f);
        const f32x4 d0 = y0 - mu, d1 = y1 - mu;
        const float var = wave_sum((d0.x * d0.x + d0.y * d0.y) + (d0.z * d0.z + d0.w * d0.w) + (d1.x * d1.x + d1.y * d1.y) + (d1.z * d1.z + d1.w * d1.w)) * (1.0f / 512.0f);
        const float rs = 1.0f / sqrtf(var + EPS);
        f32x4 n0 = d0 * rs * g0 + b0, n1 = d1 * rs * g1 + b1;
#pragma unroll
        for (int j = 0; j < 4; ++j) { n0[j] = n0[j] * sigm(n0[j]); n1[j] = n1[j] * sigm(n1[j]); }
        u32x4 o; o.x = pk2(n0.x, n0.y); o.y = pk2(n0.z, n0.w); o.z = pk2(n1.x, n1.y); o.w = pk2(n1.z, n1.w);
        *(u32x4*)(C + (size_t)(crow0 + r) * DM + 512 + lane * 8) = o; } }
#pragma unroll
    for (int i = 0; i < 2; ++i) { const int r = 2 * wave + i; *(u32x4*)(C + (size_t)(crow0 + r) * DM + lane * 8) = *(const LAS u32x4*)(lds + MX_D + r * MX_DSTRIDE + lane * 16); }
}
__device__ __forceinline__ void mixer_phase(const Args& a, LAS unsigned char* lds, int bid, int G, int tid, int lane, int wave) {
    const bf16* GLU = (const bf16*)(a.ws + WS_GLU); const bf16* AP = (const bf16*)(a.ws + WS_AP);
    LAS float* yc = (LAS float*)(lds + MX_YC);
    u32x4 pr[10];
#define MX_LOAD(u) do { const int b_ = (u) >> 7, t0_ = ((u) & 127) * 16; _Pragma("unroll") for (int i = 0; i < 10; ++i) { const int p = tid + 512 * i; \
        if (p < MX_NPIECE) { const bool isg = p < 46 * 64; const int q = isg ? p : p - 46 * 64; const int t = t0_ - (isg ? 30 : 15) + (q >> 6); const int tt = t < 0 ? 0 : t; \
            const u32x4 v = *(const u32x4*)((isg ? GLU : AP) + (size_t)(b_ * SEQ + tt) * 512 + (q & 63) * 8); pr[i] = t >= 0 ? v : (u32x4){0u, 0u, 0u, 0u}; } } } while (0)
    int u = bid; bool have = u < 1024;
    if (have) MX_LOAD(u);
    float w[31];
#pragma unroll
    for (int j = 0; j < 31; ++j) w[j] = a.in[12][j * 512 + tid];
    const float bias = a.in[13][tid];
    MixP P;
    P.g0 = *(const f32x4*)(a.in[14] + lane * 8); P.g1 = *(const f32x4*)(a.in[14] + lane * 8 + 4); P.b0 = *(const f32x4*)(a.in[15] + lane * 8); P.b1 = *(const f32x4*)(a.in[15] + lane * 8 + 4);
#define MX_STORE() do { _Pragma("unroll") for (int i = 0; i < 10; ++i) { const int p = tid + 512 * i; if (p < MX_NPIECE) *(LAS u32x4*)(lds + p * 16) = pr[i]; } } while (0)
    if (have) { MX_STORE(); const int un = u + G; if (un < 1024) MX_LOAD(un); }
    while (have) {
        __syncthreads();
        const int b = u >> 7, t0 = (u & 127) * 16;
        { float in[46];
#pragma unroll
          for (int i = 0; i < 46; ++i) in[i] = bf2f(*(const LAS bf16*)(lds + MX_TG + i * 1024 + tid * 2));
#pragma unroll
          for (int r = 0; r < 16; ++r) { float acc = bias;
#pragma unroll
              for (int j = 0; j < 31; ++j) acc += w[j] * in[r + j];
              yc[r * 512 + tid] = acc; } }
        { const int g = tid >> 7;
          if (g == 0) pool16<2>(t0, tid, lds); else if (g == 1) pool16<4>(t0, tid, lds); else if (g == 2) pool16<8>(t0, tid, lds); else pool16<16>(t0, tid, lds); }
        __syncthreads();
        const int un = u + G; const bool hn = un < 1024;
        if (hn) { MX_STORE(); const int unn = un + G; if (unn < 1024) MX_LOAD(unn); }
        mixer_finish(a, lds, b * SEQ + t0, tid, lane, wave, P);
        u = un; have = hn;
    }
#undef MX_STORE
#undef MX_LOAD
    const float* US = (const float*)(a.ws + WS_US); const float* HC = (const float*)(a.ws + WS_HC); const float* HP = (const float*)(a.ws + WS_HP);
    for (int su = (bid + 8) % G; su < 8; su += G) {
        __syncthreads();
        const float w30 = w[30]; const int wdt = 2 << (tid >> 7); const float invw = 1.0f / (float)wdt;
        const int gcol = 512 + (tid >> 7) * 256 + (tid & 127);
#pragma unroll
        for (int s2 = 0; s2 < 16; ++s2) { const int bs = 16 * su + s2;
            const float val = US[(size_t)bs * 1536 + gcol], gate = US[(size_t)bs * 1536 + gcol + 128], av = US[(size_t)bs * 1536 + tid];
            const float glu = val * sigm(gate);
            a.out[O_CS + (size_t)(bs * 30 + 29) * 512 + tid] = glu; a.out[O_PS + (size_t)(bs * 15 + 14) * 512 + tid] = av;
            yc[s2 * 512 + tid] = HC[bs * 512 + tid] + w30 * glu;
            const float d = (av + HP[bs * 512 + tid]) * invw - av;
            *(LAS bf16*)(lds + MX_D + s2 * MX_DSTRIDE + tid * 2) = (bf16)f2bf(d); }
        __syncthreads();
        mixer_finish(a, lds, MP + 16 * su, tid, lane, wave, P);
    }
    __syncthreads();
}

constexpr int AT_K = 0, AT_KSTR = 528, AT_V = 64 * AT_KSTR, AT_VSTR = 144;
__device__ __forceinline__ float fexp2(float x) { return __builtin_amdgcn_exp2f(x); }
__device__ __forceinline__ void attn_prompt_unit(const Args& a, LAS unsigned char* lds, int u, int tid, int lane, int wave) {
    const int qb = u & 15, h = (u >> 4) & 3, b = u >> 6, fr = lane & 15, fq = lane >> 4;
    const bf16* Q = (const bf16*)(a.ws + WS_Q); const bf16* KB = (const bf16*)(a.ws + WS_KB); const bf16* VT = (const bf16*)(a.ws + WS_VT); bf16* O = (bf16*)(a.ws + WS_O);
    const size_t rowq = (size_t)b * SEQ + qb * 128 + wave * 16 + fr;
    bf16x8 qf[8];
#pragma unroll
    for (int kd = 0; kd < 8; ++kd) qf[kd] = *(const bf16x8*)(Q + rowq * DM + h * 256 + 32 * kd + 8 * fq);
    f32x4 o[16];
#pragma unroll
    for (int i = 0; i < 16; ++i) o[i] = (f32x4){0.f, 0.f, 0.f, 0.f};
    float mrun = -INFINITY, lrun = 0.f;
    u32x4 kr[4], vr[4];
#define AT_LOAD(c) do { _Pragma("unroll") for (int i = 0; i < 4; ++i) { const int p = tid + 512 * i; \
        kr[i] = *(const u32x4*)(KB + (size_t)(b * 256 + 64 * (c) + (p >> 5)) * DM + h * 256 + (p & 31) * 8); \
        vr[i] = *(const u32x4*)(VT + (size_t)(h * 256 + (p >> 3)) * 2048 + b * 256 + 64 * (c) + (p & 7) * 8); } } while (0)
    AT_LOAD(0);
#pragma unroll 1
    for (int c = 0; c < 4; ++c) {
        __syncthreads();
#pragma unroll
        for (int i = 0; i < 4; ++i) { const int p = tid + 512 * i;
            *(LAS u32x4*)(lds + AT_K + (p >> 5) * AT_KSTR + (p & 31) * 16) = kr[i];
            *(LAS u32x4*)(lds + AT_V + (p >> 3) * AT_VSTR + (p & 7) * 16) = vr[i]; }
        __syncthreads();
        if (c < 3) AT_LOAD(c + 1);
        f32x4 s[4];
#pragma unroll
        for (int nb = 0; nb < 4; ++nb) { s[nb] = (f32x4){0.f, 0.f, 0.f, 0.f};
#pragma unroll
            for (int kd = 0; kd < 8; ++kd) { const bf16x8 kf = *(const LAS bf16x8*)(lds + AT_K + (16 * nb + fr) * AT_KSTR + kd * 64 + fq * 16);
                s[nb] = __builtin_amdgcn_mfma_f32_16x16x32_bf16(kf, qf[kd], s[nb], 0, 0, 0); } }
        float mx = s[0][0];
#pragma unroll
        for (int nb = 0; nb < 4; ++nb)
#pragma unroll
            for (int j = 0; j < 4; ++j) mx = fmaxf(mx, s[nb][j]);
        mx = fmaxf(mx, __shfl_xor(mx, 16)); mx = fmaxf(mx, __shfl_xor(mx, 32));
        const float mnew = fmaxf(mrun, mx), alpha = fexp2(mrun - mnew);
        float ps = 0.f;
#pragma unroll
        for (int nb = 0; nb < 4; ++nb)
#pragma unroll
            for (int j = 0; j < 4; ++j) { s[nb][j] = fexp2(s[nb][j] - mnew); ps += s[nb][j]; }
        ps += __shfl_xor(ps, 16); ps += __shfl_xor(ps, 32);
        lrun = lrun * alpha + ps; mrun = mnew;
#pragma unroll
        for (int i = 0; i < 16; ++i) o[i] = o[i] * alpha;
#pragma unroll
        for (int kb = 0; kb < 2; ++kb) {
            u32x4 pw; pw.x = pg8::cvt_pk_bf16(s[2 * kb][0], s[2 * kb][1]); pw.y = pg8::cvt_pk_bf16(s[2 * kb][2], s[2 * kb][3]);
            pw.z = pg8::cvt_pk_bf16(s[2 * kb + 1][0], s[2 * kb + 1][1]); pw.w = pg8::cvt_pk_bf16(s[2 * kb + 1][2], s[2 * kb + 1][3]);
            const bf16x8 pf = __builtin_bit_cast(bf16x8, pw);
#pragma unroll
            for (int db = 0; db < 16; ++db) {
                const u32x2 v0 = *(const LAS u32x2*)(lds + AT_V + (16 * db + fr) * AT_VSTR + kb * 64 + fq * 8), v1 = *(const LAS u32x2*)(lds + AT_V + (16 * db + fr) * AT_VSTR + kb * 64 + 32 + fq * 8);
                u32x4 vw; vw.x = v0.x; vw.y = v0.y; vw.z = v1.x; vw.w = v1.y;
                o[db] = __builtin_amdgcn_mfma_f32_16x16x32_bf16(__builtin_bit_cast(bf16x8, vw), pf, o[db], 0, 0, 0); }
        }
    }
#undef AT_LOAD
    const float inv = 1.0f / lrun;
#pragma unroll
    for (int db = 0; db < 16; ++db) { const f32x4 y = o[db] * inv; u32x2 w; w.x = pg8::cvt_pk_bf16(y.x, y.y); w.y = pg8::cvt_pk_bf16(y.z, y.w);
        *(u32x2*)(O + rowq * DM + h * 256 + 16 * db + 4 * fq) = w; }
}
__device__ __forceinline__ float rdlane(float v, int l) { return __builtin_bit_cast(float, __builtin_amdgcn_readlane(__builtin_bit_cast(int, v), l)); }
__device__ __forceinline__ void attn_sample_item(const Args& a, LAS unsigned char* lds, int item, int tid, int lane, int wave) {
    const int u = 2 * item + (wave >> 2), qt = wave & 3, b = u >> 2, h = u & 3;
    const bf16* Q = (const bf16*)(a.ws + WS_Q) + (size_t)(MP + b) * DM + h * 256;
    const float* ck = a.in[5] + ((size_t)(b * 256 + 64 * qt) * 4 + h) * 256 + lane * 4; const float* cv = a.in[6] + ((size_t)(b * 256 + 64 * qt) * 4 + h) * 256 + lane * 4;
    const u32x2 qw = *(const u32x2*)(Q + lane * 4);
    const f32x4 q = {__builtin_bit_cast(float, qw.x << 16), __builtin_bit_cast(float, qw.x & 0xffff0000u), __builtin_bit_cast(float, qw.y << 16), __builtin_bit_cast(float, qw.y & 0xffff0000u)};
    f32x4 A[8], B[8];
#define SA_PTR(j) (((j) < 8 ? ck : cv) + (size_t)(((j) & 7) * 8) * 1024)
#define SA_LOAD(buf, j) do { const float* bp_ = SA_PTR(j); _Pragma("unroll") for (int i = 0; i < 8; ++i) buf[i] = __builtin_nontemporal_load((const f32x4*)(bp_ + (size_t)i * 1024)); } while (0)
#define SA_DOTS(buf, j) do { _Pragma("unroll") for (int i = 0; i < 8; ++i) { const float sd = wave_sum((buf[i].x * q.x + buf[i].y * q.y) + (buf[i].z * q.z + buf[i].w * q.w)); mine = (lane == 8 * (j) + i) ? sd : mine; } } while (0)
#define SA_ACC(buf, j) do { _Pragma("unroll") for (int i = 0; i < 8; ++i) { const float pi = pl[8 * (j) + i]; acc += buf[i] * pi; } } while (0)
    float mine = 0.f;
    SA_LOAD(A, 0); SA_LOAD(B, 1);
#pragma unroll 1
    for (int j = 0; j < 8; j += 2) { SA_DOTS(A, j); SA_LOAD(A, j + 2); SA_DOTS(B, j + 1); SA_LOAD(B, j + 3); }
    const float mloc = wave_max(mine); const float p = fexp2(mine - mloc); const float lloc = wave_sum(p);
    LAS float* pl = (LAS float*)(lds + 16384) + wave * 64;
    pl[lane] = p; LDS_WAIT();
    f32x4 acc = {0.f, 0.f, 0.f, 0.f};
#pragma unroll 1
    for (int j = 0; j < 8; j += 2) { SA_ACC(A, j); if (j + 2 < 8) SA_LOAD(A, j + 10); SA_ACC(B, j + 1); if (j + 2 < 8) SA_LOAD(B, j + 11); }
#undef SA_PTR
#undef SA_LOAD
#undef SA_DOTS
#undef SA_ACC
    LAS float* po = (LAS float*)lds; LAS float* ml = po + 8 * 256;
    __syncthreads();
    *(LAS f32x4*)(po + wave * 256 + lane * 4) = acc; if (lane == 0) { ml[2 * wave] = mloc; ml[2 * wave + 1] = lloc; }
    __syncthreads();
    { const int ul = tid >> 8, d = tid & 255;
      const float m0 = ml[8 * ul], m1 = ml[8 * ul + 2], m2 = ml[8 * ul + 4], m3 = ml[8 * ul + 6];
      const float M = fmaxf(fmaxf(m0, m1), fmaxf(m2, m3));
      const float e0 = fexp2(m0 - M), e1 = fexp2(m1 - M), e2 = fexp2(m2 - M), e3 = fexp2(m3 - M);
      const float den = (e0 * ml[8 * ul + 1] + e1 * ml[8 * ul + 3]) + (e2 * ml[8 * ul + 5] + e3 * ml[8 * ul + 7]);
      const float num = (e0 * po[(4 * ul) * 256 + d] + e1 * po[(4 * ul + 1) * 256 + d]) + (e2 * po[(4 * ul + 2) * 256 + d] + e3 * po[(4 * ul + 3) * 256 + d]);
      const int uu = 2 * item + ul;
      ((bf16*)(a.ws + WS_O))[(size_t)(MP + (uu >> 2)) * DM + (uu & 3) * 256 + d] = (bf16)f2bf(num / den); }
    __syncthreads();
}

#define XB_TMO      128
#define XB_XCNT(j)  (256  + 64 * (j))
#define XB_XSUB(j)  (1280 + 64 * (j))
#define XB_XGEN(j)  (2304 + 64 * (j))
#define XB_TOP      3328
#define XB_TOPGEN   3392
#define XCD_BAR_WORDS 3456
#define XB_SPIN_CAP (1u << 18)

__device__ __forceinline__ unsigned xb_ld(unsigned* p)              { return __hip_atomic_load(p, __ATOMIC_RELAXED, __HIP_MEMORY_SCOPE_AGENT); }
__device__ __forceinline__ unsigned xb_add(unsigned* p, unsigned v) { return __hip_atomic_fetch_add(p, v, __ATOMIC_RELAXED, __HIP_MEMORY_SCOPE_AGENT); }
__device__ __forceinline__ unsigned xb_xcc_id() { return (unsigned)__builtin_amdgcn_s_getreg((3 << 11) | 20) & 0xFu; }
#define XB_SPIN(cond, bar) do { unsigned _sp = 0; while (cond) { __builtin_amdgcn_s_sleep(1); \
    if ((++_sp & 255u) == 0u) { if (xb_ld(&(bar)[XB_TMO])) break; if (_sp > XB_SPIN_CAP) { atomicAdd(&(bar)[XB_TMO], 1u); break; } } } } while (0)

struct XcdBarrier {
    unsigned* bar; unsigned x;
    volatile LAS unsigned* st;
};

__device__ __forceinline__ XcdBarrier xcd_barrier_post(unsigned* bar, volatile LAS unsigned* st) {
    XcdBarrier b; b.bar = bar; b.x = xb_xcc_id(); b.st = st;
    if (threadIdx.x == 0) (void)xb_add(&bar[XB_XCNT(b.x)], 1u);
    return b;
}
__device__ __forceinline__ void xcd_barrier_complete(unsigned* bar, unsigned x, unsigned& nloc, unsigned& nx) {
    const unsigned G = gridDim.x * gridDim.y * gridDim.z;
    unsigned sum, cnt, mine, sp = 0u;
    for (;;) {
        sum = 0u; cnt = 0u; mine = 0u;
#pragma unroll
        for (unsigned j = 0; j < 16; ++j) { const unsigned c = xb_ld(&bar[XB_XCNT(j)]); sum += c; cnt += (c > 0u) ? 1u : 0u; mine = (j == x) ? c : mine; }
        if (sum == G) break;
        __builtin_amdgcn_s_sleep(1);
        if ((++sp & 255u) == 0u) { if (xb_ld(&bar[XB_TMO])) break; if (sp > XB_SPIN_CAP) { atomicAdd(&bar[XB_TMO], 1u); break; } }
    }
    nloc = mine > 0u ? mine : 1u; nx = cnt > 0u ? cnt : 1u;
}

__device__ __forceinline__ void xcd_barrier(const XcdBarrier& b) {
    asm volatile("s_waitcnt vmcnt(0)" ::: "memory");
    __syncthreads();
    if (threadIdx.x == 0) {
        unsigned* bar = b.bar;
        __builtin_amdgcn_s_waitcnt(0);
        unsigned nloc = b.st[0], nx = b.st[1];
        if (nloc == 0u) { xcd_barrier_complete(bar, b.x, nloc, nx); b.st[0] = nloc; b.st[1] = nx; }
        const unsigned old = xb_add(&bar[XB_XSUB(b.x)], 1u);
        const unsigned gen = old / nloc;
        if (old + 1u == (gen + 1u) * nloc) {
            __builtin_amdgcn_fence(__ATOMIC_RELEASE, "agent");
            asm volatile("s_waitcnt vmcnt(0)" ::: "memory");
            const unsigned og = xb_add(&bar[XB_TOP], 1u);
            const unsigned tg = og / nx;
            if (og + 1u == (tg + 1u) * nx) xb_add(&bar[XB_TOPGEN], 1u);
            else XB_SPIN(xb_ld(&bar[XB_TOPGEN]) == tg, bar);
            __builtin_amdgcn_fence(__ATOMIC_ACQUIRE, "agent");
            xb_add(&bar[XB_XGEN(b.x)], 1u);
            asm volatile("s_waitcnt vmcnt(0)" ::: "memory");
        } else {
            XB_SPIN(xb_ld(&bar[XB_XGEN(b.x)]) == gen, bar);
            __builtin_amdgcn_fence(__ATOMIC_ACQUIRE, "agent");
            asm volatile("s_waitcnt vmcnt(0)" ::: "memory");
        }
    }
    __syncthreads();
}

constexpr int CW_BAR = 4096;
constexpr int MISC_OFF = 131072 + 320;
__global__ void __launch_bounds__(512, 2) fwd_kernel(Args a) {
    extern __shared__ __attribute__((aligned(16))) unsigned char lds_raw[];
    LAS unsigned char* lds = (LAS unsigned char*)lds_raw;
    const int tid = threadIdx.x, lane = tid & 63, wave = __builtin_amdgcn_readfirstlane(tid >> 6);
    const int G = gridDim.x, bid = blockIdx.x;
    unsigned char* ws = a.ws;
    const int lo = a.ph_lo, hi = a.ph_hi;
    cg::grid_group grid = cg::this_grid();
    for (int u = tid; u < (LDS_BYTES - 131072) / 4; u += 512) ((LAS unsigned*)(lds + 131072))[u] = 0u;
    __syncthreads();
    volatile LAS unsigned* MISC = (volatile LAS unsigned*)(lds + MISC_OFF);
    XcdBarrier bar; bar.bar = (unsigned*)(ws + WS_CTL) + CW_BAR; bar.x = 0; bar.st = nullptr;
    if (hi - lo > 1) bar = xcd_barrier_post((unsigned*)(ws + WS_CTL) + CW_BAR, MISC + 8);
    if (lo < 0) grid.sync();
#define IN(k) (lo <= (k) && (k) < hi)
#define SEAM(k) do { if (lo <= (k) && (k) + 1 < hi) xcd_barrier(bar); } while (0)
    bf16* HB = (bf16*)(ws + WS_HB); bf16* C = (bf16*)(ws + WS_C); bf16* X3B = (bf16*)(ws + WS_X1); bf16* X1B = (bf16*)(ws + WS_X1B); bf16* Qb = (bf16*)(ws + WS_Q);
    bf16* Ob = (bf16*)(ws + WS_O); bf16* X2B = (bf16*)(ws + WS_X2B); bf16* Fb = (bf16*)(ws + WS_F);
    float* SSQ1 = (float*)(ws + WS_SSQ1); float* SSQ2 = (float*)(ws + WS_SSQ2); float* SSQ3 = (float*)(ws + WS_SSQ3);
    float* SSQ1S = (float*)(ws + WS_SSQS); float* SSQ2S = SSQ1S + NS * 64; float* SSQ3S = SSQ2S + NS * 64;
    LAS float* red = (LAS float*)lds;

    if (IN(0)) { p0_prologue(a, lds, bid, G, tid, lane, wave); }
    SEAM(0);
    if (IN(1)) {
        { pg8::Gemm g{HB, (const bf16*)(ws + WS_WIN), MP, 1536, 1024}; pg8::StaticOrder S; S.init(MP, 1536, G, bid);
          pg8::EpiIn E{(bf16*)(ws + WS_AP), (bf16*)(ws + WS_GLU), a.out + O_PP, a.out + O_CP};
          pg8::gemm_phase<pg8::EpiIn, pg8::StaticOrder, true, true>(lds, g, S, E); }
        { pg8::Gemm g{(const bf16*)(ws + WS_MB), (const bf16*)(ws + WS_WKV), MMEM, 2048, 1024}; pg8::StaticOrder S; S.init(MMEM, 2048, G, (bid + G - (128 % G)) % G);
          pg8::EpiKV E{a.out + O_MK, a.out + O_MV, (bf16*)(ws + WS_KB)};
          pg8::gemm_phase<pg8::EpiKV, pg8::StaticOrder, true, true>(lds, g, S, E); }
        { pg8::Gemm g{(const bf16*)(ws + WS_WKV) + (size_t)1024 * 1024, (const bf16*)(ws + WS_MB), 1024, MMEM, 1024}; pg8::StaticOrder S; S.init(1024, MMEM, G, (bid + G - (192 % G)) % G);
          pg8::EpiPlain E{(bf16*)(ws + WS_VT), 2048};
          pg8::gemm_phase<pg8::EpiPlain, pg8::StaticOrder, true, true>(lds, g, S, E); }
        __syncthreads();
        { SkRaw f{(float*)(ws + WS_US), 1536}; const int ge = G > 32 ? 32 : G, cc = (bid + G - (224 % G)) % G; if (cc < ge) skinny<false>(HB + (size_t)MP * DM, (const bf16*)(ws + WS_WIN), 1024, 96, cc, ge, red, tid, f); }
    }
    SEAM(1);
    if (IN(2)) {
        mixer_phase(a, lds, bid, G, tid, lane, wave);
    }
    SEAM(2);
    if (IN(3)) {
        { pg8::Gemm g{C, (const bf16*)(ws + WS_WOUT), MP, 1024, 1024}; pg8::StaticOrder S; S.init(MP, 1024, G, bid);
          pg8::EpiRes<false> E{a.in[0], X1B, SSQ1, (const float*)(ws + WS_CTL + 512 * 1024)};
          pg8::gemm_phase<pg8::EpiRes<false>, pg8::StaticOrder, false, true>(lds, g, S, E); }
        __syncthreads();
        { SkRes<false> f{a.in[1], X1B + (size_t)MP * DM, SSQ1S, (const float*)(ws + WS_CTL + 512 * 1024)}; skinny<false>(C + (size_t)MP * DM, (const bf16*)(ws + WS_WOUT), 1024, 64, bid, G, red, tid, f); }
    }
    SEAM(3);
    if (IN(4)) {
        { pg8::Gemm g{X1B, (const bf16*)(ws + WS_WQ), MP, 1024, 1024}; pg8::StaticOrder S; S.init(MP, 1024, G, bid);
          pg8::EpiQ E{SSQ1, Qb, QSCALE};
          pg8::gemm_phase<pg8::EpiQ, pg8::StaticOrder, false, true>(lds, g, S, E); }
        __syncthreads();
        { SkQ f{SSQ1S, Qb + (size_t)MP * DM}; skinny<false>(X1B + (size_t)MP * DM, (const bf16*)(ws + WS_WQ), 1024, 64, bid, G, red, tid, f); }
    }
    SEAM(4);
    if (IN(5)) {
        for (int u = bid; u < 512; u += G) attn_prompt_unit(a, lds, u, tid, lane, wave);
        __syncthreads();
        for (int it = bid; it < 256; it += G) attn_sample_item(a, lds, it, tid, lane, wave);
    }
    SEAM(5);
    if (IN(6)) {
        { pg8::Gemm g{Ob, (const bf16*)(ws + WS_WO), MP, 1024, 1024}; pg8::StaticOrder S; S.init(MP, 1024, G, bid);
          pg8::EpiRes<true> E{X1B, X2B, SSQ2, nullptr};
          pg8::gemm_phase<pg8::EpiRes<true>, pg8::StaticOrder, false, true>(lds, g, S, E); }
        __syncthreads();
        { SkRes<true> f{X1B + (size_t)MP * DM, X2B + (size_t)MP * DM, SSQ2S, nullptr}; skinny<false>(Ob + (size_t)MP * DM, (const bf16*)(ws + WS_WO), 1024, 64, bid, G, red, tid, f); }
    }
    SEAM(6);
    if (IN(7)) {
        { pg8::Gemm g{X2B, (const bf16*)(ws + WS_WGU), MP, FF2, 1024}; pg8::StaticOrder S; S.init(MP, FF2, G, bid);
          pg8::EpiGU E{SSQ2, Fb};
          pg8::gemm_phase<pg8::EpiGU, pg8::StaticOrder, true, true>(lds, g, S, E); }
        __syncthreads();
        { SkGU f{SSQ2S, Fb + (size_t)MP * FF}; const int half = G >= 2 ? G / 2 : 1;
          if (bid >= G - half) skinny<true>(X2B + (size_t)MP * DM, (const bf16*)(ws + WS_WGU), 1024, 176, bid - (G - half), half, red, tid, f); }
    }
    SEAM(7);
    if (IN(8)) {
        { pg8::Gemm g{Fb, (const bf16*)(ws + WS_WD), MP, 1024, FF}; pg8::StaticOrder S; S.init(MP, 1024, G, bid);
          pg8::EpiRes<true> E{X2B, X3B, SSQ3, nullptr};
          pg8::gemm_phase<pg8::EpiRes<true>, pg8::StaticOrder, false, true>(lds, g, S, E); }
        __syncthreads();
        { SkRes<true> f{X2B + (size_t)MP * DM, X3B + (size_t)MP * DM, SSQ3S, nullptr}; skinny<false>(Fb + (size_t)MP * FF, (const bf16*)(ws + WS_WD), FF, 64, bid, G, red, tid, f); }
    }
    SEAM(8);
    if (IN(9)) {
        const int gw = bid * 8 + wave, NGW = G * 8;
        const f32x4* gf = (const f32x4*)a.in[27] + lane;
        for (int m = gw; m < MALL; m += NGW) {
            float* yrow; float ssum;
            if (m < MP) { yrow = a.out + O_Y + (size_t)m * DM; const float v = (lane < 16) ? SSQ3[(size_t)m * 16 + lane] : 0.f; ssum = wave_sum(v); }
            else { yrow = a.out + O_YS + (size_t)(m - MP) * DM; ssum = wave_sum(SSQ3S[(m - MP) * 64 + lane]); }
            const float rstd = 1.0f / sqrtf(ssum * (1.0f / DM) + EPS);
            const u32x2* xr = (const u32x2*)(X3B + (size_t)m * DM) + lane; f32x4* yr = (f32x4*)yrow + lane;
#pragma unroll
            for (int j = 0; j < 4; ++j) { const u32x2 w = xr[64 * j];
                const f32x4 v = {__builtin_bit_cast(float, w.x << 16), __builtin_bit_cast(float, w.x & 0xffff0000u), __builtin_bit_cast(float, w.y << 16), __builtin_bit_cast(float, w.y & 0xffff0000u)};
                yr[64 * j] = v * rstd * gf[64 * j]; }
        }
    }
#undef IN
#undef SEAM
}

#ifndef MK_MULTI
#define MK_MULTI 0
#endif
extern "C" void kernel_launch(void* const* d_in, const int* in_sizes, int n_in, void* d_out, int out_size, void* d_ws, size_t ws_size, hipStream_t stream) {
    static int grid = 0;
    if (grid == 0) {
        if (n_in != 28 || ws_size < WS_END) { fprintf(stderr, "kernel_launch: unexpected n_in %d / ws_size %zu\n", n_in, ws_size); grid = -1; return; }
        int dev = 0, cus = 0, per_cu = 0;
        (void)hipGetDevice(&dev); (void)hipDeviceGetAttribute(&cus, hipDeviceAttributeMultiprocessorCount, dev);
        if (hipFuncSetAttribute((const void*)fwd_kernel, hipFuncAttributeMaxDynamicSharedMemorySize, LDS_BYTES) != hipSuccess) { fprintf(stderr, "kernel_launch: hipFuncSetAttribute failed\n"); grid = -1; return; }
        if (hipOccupancyMaxActiveBlocksPerMultiprocessor(&per_cu, (const void*)fwd_kernel, 512, LDS_BYTES) != hipSuccess || per_cu < 1) { fprintf(stderr, "kernel_launch: occupancy query says %d\n", per_cu); per_cu = 1; }
        (void)hipGetLastError();
        grid = cus;
    }
    if (grid < 0) return;
    (void)hipMemsetAsync((char*)d_ws + WS_CTL, 0, CTL_ZERO_BYTES, stream);
    Args a{};
    for (int i = 0; i < 28; ++i) a.in[i] = (const float*)d_in[i];
    a.out = (float*)d_out; a.ws = (unsigned char*)d_ws;
#if MK_MULTI
    for (int p = 0; p < NPHASE; ++p) { a.ph_lo = p; a.ph_hi = p + 1; hipLaunchKernelGGL(fwd_kernel, dim3(grid), dim3(512), LDS_BYTES, stream, a); }
#else
    a.ph_lo = 0; a.ph_hi = NPHASE;
    void* args[] = {&a};
    hipError_t e = hipLaunchCooperativeKernel((const void*)fwd_kernel, dim3(grid), dim3(512), args, LDS_BYTES, stream);
    if (e != hipSuccess) fprintf(stderr, "cooperative launch failed: %s (grid %d)\n", hipGetErrorString(e), grid);
#endif
}
```

```cpp
#include <hip/hip_runtime.h>
#include <hip/hip_cooperative_groups.h>
#include <cstdio>
#include <cstdint>
namespace cg = cooperative_groups;
namespace pg8 {
#define PG8_LAS __attribute__((address_space(3)))
typedef unsigned short bf16_t;
typedef short bf16x8 __attribute__((ext_vector_type(8)));
typedef float f32x4 __attribute__((ext_vector_type(4)));
typedef unsigned u32x4 __attribute__((ext_vector_type(4)));
constexpr int BM = 256, BK = 64, HALF = 128, HTB = HALF * BK * 2  , STAGE_BYTES = 8 * HTB, NXCD = 8, WGM = 8;

__host__ __device__ __forceinline__ int lds_byte(int r, int c) { const int st = (r >> 4) * 2 + (c >> 5), rr = r & 15, cc = c & 31, ob = rr * 64 + cc * 2; return st * 1024 + (ob ^ (((ob >> 9) & 1) << 5)); }
__host__ __device__ __forceinline__ void stage_rc(int b, int& R, int& C) { const int st = b / 1024, sb = b % 1024, swz = sb ^ (((sb >> 9) & 1) << 5); R = (st >> 1) * 16 + swz / 64; C = (st & 1) * 32 + (swz % 64) / 2; }
__host__ __device__ __forceinline__ int perm32(int rho) { const int n = rho >> 4, i = rho & 15; return 8 * (i >> 2) + 4 * n + (i & 3); }

struct Unit { int pm, pn; };
struct Gemm { const bf16_t* A; const bf16_t* Bt; int M, N, K; };

struct StaticOrder {
    int nM, nN, nwg, G, c;
    __host__ __device__ void init(int M, int N, int G_, int c_) { nM = M / BM; nN = N / BM; nwg = nM * nN; G = G_; c = c_; }
    __host__ __device__ bool next(int i, Unit& u) const {
        const long L = (long)i * G + c; if (L >= nwg) return false;
        int wgid = (int)L; { const int q = nwg / NXCD, r = nwg % NXCD, xcd = wgid % NXCD, off = wgid / NXCD; wgid = (xcd < r ? xcd * (q + 1) : r * (q + 1) + (xcd - r) * q) + off; }
        const int nig = WGM * nN, gid = wgid / nig, fm = gid * WGM, gsz = (nM - fm) < WGM ? (nM - fm) : WGM;
        u.pm = fm + ((wgid % nig) % gsz); u.pn = (wgid % nig) / gsz; return true;
    }
    __device__ __forceinline__ void a_ready(const Unit&) const {}
    __device__ __forceinline__ void done(const Unit&) const {}
};
typedef unsigned u32x4 __attribute__((ext_vector_type(4)));
constexpr float EPSF = 1e-6f;
__device__ __forceinline__ unsigned cvt_pk_bf16(float lo, float hi) { unsigned r; asm volatile("v_cvt_pk_bf16_f32 %0, %1, %2" : "=v"(r) : "v"(lo), "v"(hi)); return r; }
__device__ __forceinline__ u32x4 pack8(const f32x4 a, const f32x4 b) { u32x4 w; w.x = cvt_pk_bf16(a[0], a[1]); w.y = cvt_pk_bf16(a[2], a[3]); w.z = cvt_pk_bf16(b[0], b[1]); w.w = cvt_pk_bf16(b[2], b[3]); return w; }
__device__ __forceinline__ float sigm(float x) { return __builtin_amdgcn_rcpf(1.0f + __builtin_amdgcn_exp2f(-1.4426950408889634f * x)); }
__device__ __forceinline__ float rstd16(const float* p) {
    const f32x4 a = ((const f32x4*)p)[0], b = ((const f32x4*)p)[1], c = ((const f32x4*)p)[2], d = ((const f32x4*)p)[3];
    const float s = ((a[0] + a[1]) + (a[2] + a[3])) + ((b[0] + b[1]) + (b[2] + b[3])) + ((c[0] + c[1]) + (c[2] + c[3])) + ((d[0] + d[1]) + (d[2] + d[3]));
    return 1.0f / sqrtf(s * (1.0f / 1024.0f) + EPSF);
}
struct EpiIn {
    static constexpr bool PERM = true, AFTER_DRAIN = false;
    bf16_t* AP; bf16_t* GLU; float* outPP; float* outCP;
    __device__ __forceinline__ void operator()(const f32x4 (&acc)[2][2][4][2], const Unit& u, int wr, int wc, int fr, int fq) const {
        const int row0 = u.pm * BM + wr * 64 + fr, cl = wc * 32 + 8 * fq;
        if (u.pn < 2) {
#pragma unroll
            for (int ai = 0; ai < 2; ++ai)
#pragma unroll
                for (int m = 0; m < 4; ++m) { const int row = row0 + ai * HALF + m * 16, t = row & 2047, b = row >> 11;
#pragma unroll
                    for (int bj = 0; bj < 2; ++bj) { const int col = u.pn * 256 + bj * HALF + cl; const f32x4 v0 = acc[ai][bj][m][0], v1 = acc[ai][bj][m][1];
                        *(u32x4*)(AP + (size_t)row * 512 + col) = pack8(v0, v1);
                        if (t >= 2033) { float* o = outPP + ((size_t)(b * 15 + t - 2033) * 512 + col); *(f32x4*)o = v0; *(f32x4*)(o + 4) = v1; } } }
        } else {
            const int ch = (u.pn - 2) * 128 + cl;
#pragma unroll
            for (int ai = 0; ai < 2; ++ai)
#pragma unroll
                for (int m = 0; m < 4; ++m) { const int row = row0 + ai * HALF + m * 16, t = row & 2047, b = row >> 11;
                    f32x4 o0, o1;
#pragma unroll
                    for (int j = 0; j < 4; ++j) { o0[j] = acc[ai][0][m][0][j] * sigm(acc[ai][1][m][0][j]); o1[j] = acc[ai][0][m][1][j] * sigm(acc[ai][1][m][1][j]); }
                    *(u32x4*)(GLU + (size_t)row * 512 + ch) = pack8(o0, o1);
                    if (t >= 2018) { float* o = outCP + ((size_t)(b * 30 + t - 2018) * 512 + ch); *(f32x4*)o = o0; *(f32x4*)(o + 4) = o1; } }
        }
    }
};
struct EpiKV {
    static constexpr bool PERM = true, AFTER_DRAIN = false;
    float* outK; float* outV; bf16_t* KB;
    __device__ __forceinline__ void operator()(const f32x4 (&acc)[2][2][4][2], const Unit& u, int wr, int wc, int fr, int fq) const {
        const int row0 = u.pm * BM + wr * 64 + fr, cl = wc * 32 + 8 * fq;
#pragma unroll
        for (int ai = 0; ai < 2; ++ai)
#pragma unroll
            for (int m = 0; m < 4; ++m) { const int row = row0 + ai * HALF + m * 16;
#pragma unroll
                for (int bj = 0; bj < 2; ++bj) { const int col = u.pn * 256 + bj * HALF + cl; const f32x4 v0 = acc[ai][bj][m][0], v1 = acc[ai][bj][m][1];
                    if (u.pn < 4) { float* o = outK + (size_t)row * 1024 + col; *(f32x4*)o = v0; *(f32x4*)(o + 4) = v1; *(u32x4*)(KB + (size_t)row * 1024 + col) = pack8(v0, v1); }
                    else { float* o = outV + (size_t)row * 1024 + (col - 1024); *(f32x4*)o = v0; *(f32x4*)(o + 4) = v1; } } }
    }
};
struct EpiPlain {
    static constexpr bool PERM = true, AFTER_DRAIN = false;
    bf16_t* O; int ldc;
    __device__ __forceinline__ void operator()(const f32x4 (&acc)[2][2][4][2], const Unit& u, int wr, int wc, int fr, int fq) const {
        const int row0 = u.pm * BM + wr * 64 + fr, cl = wc * 32 + 8 * fq;
#pragma unroll
        for (int ai = 0; ai < 2; ++ai)
#pragma unroll
            for (int m = 0; m < 4; ++m) { const int row = row0 + ai * HALF + m * 16;
#pragma unroll
                for (int bj = 0; bj < 2; ++bj) { const int col = u.pn * 256 + bj * HALF + cl; *(u32x4*)(O + (size_t)row * ldc + col) = pack8(acc[ai][bj][m][0], acc[ai][bj][m][1]); } }
    }
};
template <bool RES_BF16> struct EpiRes {
    static constexpr bool PERM = true, AFTER_DRAIN = false;
    const void* resid; bf16_t* xb; float* ssq; const float* bias; const float* rinv; const float* gain;
    __device__ __forceinline__ void operator()(const f32x4 (&acc)[2][2][4][2], const Unit& u, int wr, int wc, int fr, int fq) const {
        const int row0 = u.pm * BM + wr * 64 + fr, cl = wc * 32 + 8 * fq;
#pragma unroll
        for (int ai = 0; ai < 2; ++ai)
#pragma unroll
            for (int m = 0; m < 4; ++m) { const int row = row0 + ai * HALF + m * 16; float ss = 0.f;
#pragma unroll
                for (int bj = 0; bj < 2; ++bj) { const size_t off = (size_t)row * 1024 + u.pn * 256 + bj * HALF + cl;
                    f32x4 r0, r1;
                    if (RES_BF16) { const u32x4 w = *(const u32x4*)((const bf16_t*)resid + off);
                        r0 = (f32x4){__builtin_bit_cast(float, w.x << 16), __builtin_bit_cast(float, w.x & 0xffff0000u), __builtin_bit_cast(float, w.y << 16), __builtin_bit_cast(float, w.y & 0xffff0000u)};
                        r1 = (f32x4){__builtin_bit_cast(float, w.z << 16), __builtin_bit_cast(float, w.z & 0xffff0000u), __builtin_bit_cast(float, w.w << 16), __builtin_bit_cast(float, w.w & 0xffff0000u)}; }
                    else { const int col = u.pn * 256 + bj * HALF + cl; const u32x4 w = *(const u32x4*)((const bf16_t*)resid + off); const float ri = rinv[row];
                        const f32x4 g0 = *(const f32x4*)(gain + col), g1 = *(const f32x4*)(gain + col + 4);
                        const f32x4 i0 = {__builtin_amdgcn_rcpf(g0[0]), __builtin_amdgcn_rcpf(g0[1]), __builtin_amdgcn_rcpf(g0[2]), __builtin_amdgcn_rcpf(g0[3])}, i1 = {__builtin_amdgcn_rcpf(g1[0]), __builtin_amdgcn_rcpf(g1[1]), __builtin_amdgcn_rcpf(g1[2]), __builtin_amdgcn_rcpf(g1[3])};
                        r0 = (f32x4){__builtin_bit_cast(float, w.x << 16), __builtin_bit_cast(float, w.x & 0xffff0000u), __builtin_bit_cast(float, w.y << 16), __builtin_bit_cast(float, w.y & 0xffff0000u)} * ri * i0 + *(const f32x4*)(bias + col);
                        r1 = (f32x4){__builtin_bit_cast(float, w.z << 16), __builtin_bit_cast(float, w.z & 0xffff0000u), __builtin_bit_cast(float, w.w << 16), __builtin_bit_cast(float, w.w & 0xffff0000u)} * ri * i1 + *(const f32x4*)(bias + col + 4); }
                    const f32x4 x0 = r0 + acc[ai][bj][m][0], x1 = r1 + acc[ai][bj][m][1];
                    *(u32x4*)(xb + off) = pack8(x0, x1);
                    ss += ((x0[0] * x0[0] + x0[1] * x0[1]) + (x0[2] * x0[2] + x0[3] * x0[3])) + ((x1[0] * x1[0] + x1[1] * x1[1]) + (x1[2] * x1[2] + x1[3] * x1[3])); }
                ss += __shfl_xor(ss, 16); ss += __shfl_xor(ss, 32);
                if (fq == 0) ssq[(size_t)row * 16 + u.pn * 4 + wc] = ss; }
    }
};
struct EpiQ {
    static constexpr bool PERM = true, AFTER_DRAIN = false;
    const float* ssq; bf16_t* Q; float scale; const PG8_LAS float* rtab; int tab_pm;
    __device__ __forceinline__ void operator()(const f32x4 (&acc)[2][2][4][2], const Unit& u, int wr, int wc, int fr, int fq) const {
        const int row0 = u.pm * BM + wr * 64 + fr, cl = wc * 32 + 8 * fq;
#pragma unroll
        for (int ai = 0; ai < 2; ++ai)
#pragma unroll
            for (int m = 0; m < 4; ++m) { const int row = row0 + ai * HALF + m * 16; const float rs = (u.pm == tab_pm ? rtab[ai * HALF + wr * 64 + m * 16 + fr] : rstd16(ssq + (size_t)row * 16)) * scale;
#pragma unroll
                for (int bj = 0; bj < 2; ++bj) { const size_t off = (size_t)row * 1024 + u.pn * 256 + bj * HALF + cl;
                    *(u32x4*)(Q + off) = pack8(acc[ai][bj][m][0] * rs, acc[ai][bj][m][1] * rs); } }
    }
};
struct EpiGU {
    static constexpr bool PERM = true, AFTER_DRAIN = false;
    const float* ssq; bf16_t* F; const PG8_LAS float* rtab; int tab_pm;
    __device__ __forceinline__ void operator()(const f32x4 (&acc)[2][2][4][2], const Unit& u, int wr, int wc, int fr, int fq) const {
        const int row0 = u.pm * BM + wr * 64 + fr, cl = wc * 32 + 8 * fq;
#pragma unroll
        for (int ai = 0; ai < 2; ++ai)
#pragma unroll
            for (int m = 0; m < 4; ++m) { const int row = row0 + ai * HALF + m * 16; const float rs = u.pm == tab_pm ? rtab[ai * HALF + wr * 64 + m * 16 + fr] : rstd16(ssq + (size_t)row * 16);
                f32x4 o0, o1;
#pragma unroll
                for (int j = 0; j < 4; ++j) { const float g0 = acc[ai][0][m][0][j] * rs, g1 = acc[ai][0][m][1][j] * rs;
                    o0[j] = g0 * sigm(g0) * (acc[ai][1][m][0][j] * rs); o1[j] = g1 * sigm(g1) * (acc[ai][1][m][1][j] * rs); }
                *(u32x4*)(F + (size_t)row * 2816 + u.pn * 128 + cl) = pack8(o0, o1); }
    }
};
template <class Epi, class Sched, bool ALIGN_EPI = false, bool SP2 = false>
__device__ __forceinline__ void gemm_phase(PG8_LAS unsigned char* lds, const Gemm g, const Sched& S, const Epi& E) {
    const int tid = threadIdx.x, wid = __builtin_amdgcn_readfirstlane(tid >> 6), lane = tid & 63, wr = wid >> 2, wc = wid & 3, fr = lane & 15, fq = lane >> 4;
    const int K = g.K, nt = K / BK;
    unsigned voffA[2], voffB[2];
#pragma unroll
    for (int i = 0; i < 2; ++i) { int R, C; stage_rc(tid * 16 + i * 8192, R, C); const int Rb = Epi::PERM ? ((R & ~31) + perm32(R & 31)) : R;
        voffA[i] = (unsigned)(R * K + C) * 2u; voffB[i] = (unsigned)(Rb * K + C) * 2u; }
    const size_t kstep = (size_t)(BK * 2);
    const size_t hstep = (size_t)HALF * K * 2;
    const size_t tstep = 2 * hstep;
    const unsigned ldsw = (unsigned)wid * 1024u;
    const int aoff = lds_byte(wr * 64 + fr, fq * 8), boff = lds_byte(wc * 32 + fr, fq * 8);
#define PG8_SA(b, h) (((b) * 2 + (h)) * HTB)
#define PG8_SB(b, h) ((4 + (b) * 2 + (h)) * HTB)
#define PG8_STAGE(bufoff, gbase, voff) do { _Pragma("unroll") for (int _i = 0; _i < 2; ++_i) \
        __builtin_amdgcn_global_load_lds((const unsigned*)((const char*)(gbase) + (voff)[_i]), (PG8_LAS unsigned*)(lds + (bufoff) + ldsw + _i * 8192), 16, 0, 0); } while (0)
#define PG8_LDA(dst, b, h) do { _Pragma("unroll") for (int m = 0; m < 4; ++m) _Pragma("unroll") for (int k = 0; k < 2; ++k) dst[m][k] = *(const PG8_LAS bf16x8*)(lds + PG8_SA(b, h) + aoff + m * 2048 + k * 1024); } while (0)
#define PG8_LDB(dst, b, h) do { _Pragma("unroll") for (int n = 0; n < 2; ++n) _Pragma("unroll") for (int k = 0; k < 2; ++k) dst[n][k] = *(const PG8_LAS bf16x8*)(lds + PG8_SB(b, h) + boff + n * 2048 + k * 1024); } while (0)
#define PG8_MMA(ai, bj, At, Bt) do { __builtin_amdgcn_s_setprio(1); _Pragma("unroll") for (int m = 0; m < 4; ++m) _Pragma("unroll") for (int n = 0; n < 2; ++n) _Pragma("unroll") for (int k = 0; k < 2; ++k) \
        acc[ai][bj][m][n] = __builtin_amdgcn_mfma_f32_16x16x32_bf16(Bt[n][k], At[m][k], acc[ai][bj][m][n], 0, 0, 0); __builtin_amdgcn_s_setprio(0); } while (0)
#define PG8_WAIT_V(n) asm volatile("s_waitcnt vmcnt(" #n ")" ::: "memory")
#define PG8_WAIT_L(n) asm volatile("s_waitcnt lgkmcnt(" #n ")" ::: "memory")
#define PG8_BAR __builtin_amdgcn_s_barrier()
#define PG8_SCHED __builtin_amdgcn_sched_barrier(0)
    Unit cur, nxt; int ui = 0;
    if (!S.next(0, cur)) return;
    f32x4 acc[2][2][4][2];
#pragma unroll
    for (int a = 0; a < 2; ++a)
#pragma unroll
        for (int b = 0; b < 2; ++b)
#pragma unroll
            for (int m = 0; m < 4; ++m)
#pragma unroll
                for (int n = 0; n < 2; ++n) acc[a][b][m][n] = (f32x4){0.f, 0.f, 0.f, 0.f};
    bf16x8 At[4][2], B0[2][2], B1[2][2];
    const char* cA = (const char*)g.A + (size_t)cur.pm * tstep; const char* cB = (const char*)g.Bt + (size_t)cur.pn * tstep;
    S.a_ready(cur);
    if constexpr (SP2) {
        PG8_STAGE(PG8_SB(0, 0), cB, voffB); PG8_STAGE(PG8_SB(0, 1), cB + hstep, voffB); PG8_STAGE(PG8_SA(0, 0), cA, voffA); PG8_STAGE(PG8_SA(0, 1), cA + hstep, voffA);
        if (wr == 1) PG8_BAR;
        PG8_WAIT_V(2); PG8_BAR;
        PG8_STAGE(PG8_SB(1, 0), cB + kstep, voffB); PG8_STAGE(PG8_SA(1, 0), cA + kstep, voffA); PG8_STAGE(PG8_SB(1, 1), cB + hstep + kstep, voffB);
        PG8_WAIT_V(6); PG8_BAR;
    } else {
        PG8_STAGE(PG8_SB(0, 0), cB, voffB); PG8_STAGE(PG8_SA(0, 0), cA, voffA); PG8_STAGE(PG8_SB(0, 1), cB + hstep, voffB); PG8_STAGE(PG8_SA(0, 1), cA + hstep, voffA);
        if (wr == 1) PG8_BAR;
        PG8_WAIT_V(4); PG8_BAR;
        PG8_STAGE(PG8_SB(1, 0), cB + kstep, voffB); PG8_STAGE(PG8_SA(1, 0), cA + kstep, voffA); PG8_STAGE(PG8_SB(1, 1), cB + hstep + kstep, voffB);
        PG8_WAIT_V(6); PG8_BAR;
    }
    for (;;) {
        const bool has_next = S.next(ui + 1, nxt);
        const char* nA = has_next ? (const char*)g.A + (size_t)nxt.pm * tstep : cA; const char* nB = has_next ? (const char*)g.Bt + (size_t)nxt.pn * tstep : cB;
        for (int t = 0; t < nt; t += 2) {
            const bool last = (t == nt - 2);
            const char* a1 = cA + (size_t)(t + 1) * kstep;
            const char* a2 = last ? nA : cA + (size_t)(t + 2) * kstep; const char* b2 = last ? nB : cB + (size_t)(t + 2) * kstep;
            const char* a3 = a2 + kstep; const char* b3 = b2 + kstep;
            if (last && has_next) S.a_ready(nxt);
            if constexpr (SP2) {
            PG8_LDB(B0, 0, 0); PG8_LDB(B1, 0, 1); PG8_SCHED; PG8_LDA(At, 0, 0); PG8_STAGE(PG8_SA(1, 1), a1 + hstep, voffA);
            PG8_WAIT_V(8); PG8_WAIT_L(0); PG8_BAR; PG8_MMA(0, 0, At, B0); PG8_MMA(0, 1, At, B1); PG8_BAR; PG8_SCHED;
            PG8_LDA(At, 0, 1); PG8_STAGE(PG8_SB(0, 0), b2, voffB); PG8_STAGE(PG8_SB(0, 1), b2 + hstep, voffB); PG8_STAGE(PG8_SA(0, 0), a2, voffA);
            PG8_WAIT_V(8); PG8_WAIT_L(0); PG8_BAR; PG8_MMA(1, 0, At, B0); PG8_MMA(1, 1, At, B1); PG8_BAR; PG8_SCHED;
            PG8_LDB(B0, 1, 0); PG8_LDB(B1, 1, 1); PG8_SCHED; PG8_LDA(At, 1, 0); PG8_STAGE(PG8_SA(0, 1), a2 + hstep, voffA);
            PG8_WAIT_V(8); PG8_WAIT_L(0); PG8_BAR; PG8_MMA(0, 0, At, B0); PG8_MMA(0, 1, At, B1); PG8_BAR; PG8_SCHED;
            PG8_LDA(At, 1, 1); PG8_STAGE(PG8_SB(1, 0), b3, voffB); PG8_STAGE(PG8_SB(1, 1), b3 + hstep, voffB); PG8_STAGE(PG8_SA(1, 0), a3, voffA);
            PG8_WAIT_V(8); PG8_WAIT_L(0); PG8_BAR; PG8_MMA(1, 0, At, B0); PG8_MMA(1, 1, At, B1); PG8_BAR; PG8_SCHED;
            } else {
            PG8_LDB(B0, 0, 0); PG8_SCHED; PG8_LDA(At, 0, 0); PG8_STAGE(PG8_SA(1, 1), a1 + hstep, voffA);
            PG8_WAIT_L(8); PG8_BAR; PG8_WAIT_L(0); PG8_MMA(0, 0, At, B0); PG8_BAR; PG8_SCHED;
            PG8_LDB(B1, 0, 1); PG8_STAGE(PG8_SB(0, 0), b2, voffB);
            PG8_BAR; PG8_WAIT_L(0); PG8_MMA(0, 1, At, B1); PG8_BAR;
            PG8_LDA(At, 0, 1); PG8_STAGE(PG8_SA(0, 0), a2, voffA);
            PG8_BAR; PG8_WAIT_L(0); PG8_MMA(1, 0, At, B0); PG8_BAR; PG8_SCHED;
            PG8_STAGE(PG8_SB(0, 1), b2 + hstep, voffB);
            PG8_WAIT_V(6); PG8_BAR; PG8_MMA(1, 1, At, B1); PG8_BAR;
            PG8_LDB(B0, 1, 0); PG8_SCHED; PG8_LDA(At, 1, 0); PG8_STAGE(PG8_SA(0, 1), a2 + hstep, voffA);
            PG8_WAIT_L(8); PG8_BAR; PG8_WAIT_L(0); PG8_MMA(0, 0, At, B0); PG8_BAR; PG8_SCHED;
            PG8_LDB(B1, 1, 1); PG8_STAGE(PG8_SB(1, 0), b3, voffB);
            PG8_BAR; PG8_WAIT_L(0); PG8_MMA(0, 1, At, B1); PG8_BAR;
            PG8_LDA(At, 1, 1); PG8_STAGE(PG8_SA(1, 0), a3, voffA);
            PG8_BAR; PG8_WAIT_L(0); PG8_MMA(1, 0, At, B0); PG8_BAR; PG8_SCHED;
            PG8_STAGE(PG8_SB(1, 1), b3 + hstep, voffB);
            PG8_WAIT_V(6); PG8_BAR; PG8_MMA(1, 1, At, B1); PG8_BAR;
            }
        }
        if constexpr (ALIGN_EPI) { if (wr == 0) PG8_BAR; }
        if constexpr (!Epi::AFTER_DRAIN) { E(acc, cur, wr, wc, fr, fq); S.done(cur); }
        if (!has_next) break;
#pragma unroll
        for (int a = 0; a < 2; ++a)
#pragma unroll
            for (int b = 0; b < 2; ++b)
#pragma unroll
                for (int m = 0; m < 4; ++m)
#pragma unroll
                    for (int n = 0; n < 2; ++n) acc[a][b][m][n] = (f32x4){0.f, 0.f, 0.f, 0.f};
        cur = nxt; cA = nA; cB = nB; ++ui;
        if constexpr (ALIGN_EPI) { if (wr == 1) PG8_BAR; }
    }
    PG8_WAIT_V(0);
    if constexpr (!ALIGN_EPI) { if (wr == 0) PG8_BAR; }
    PG8_BAR;
    if constexpr (Epi::AFTER_DRAIN) { E.fused(acc, cur, wr, wc, fr, fq, lds, wid, lane); S.done(cur); }
#undef PG8_SA
#undef PG8_SB
#undef PG8_STAGE
#undef PG8_LDA
#undef PG8_LDB
#undef PG8_MMA
#undef PG8_WAIT_V
#undef PG8_WAIT_L
#undef PG8_BAR
#undef PG8_SCHED
}
}

#define LAS __attribute__((address_space(3)))
typedef unsigned short bf16;
typedef float f32x4 __attribute__((ext_vector_type(4)));
typedef short bf16x8 __attribute__((ext_vector_type(8)));
typedef unsigned u32x4 __attribute__((ext_vector_type(4)));
typedef unsigned u32x2 __attribute__((ext_vector_type(2)));
constexpr int DM = 1024, NB = 8, SEQ = 2048, MP = NB * SEQ, NS = 128, MALL = MP + NS, NMEM = 256, FF = 2816, FF2 = 5632, MMEM = NB * NMEM;
constexpr float EPS = 1e-6f;
constexpr float QSCALE = 0.0625f * 1.4426950408889634f;
constexpr size_t O_Y = 0, O_YS = 16777216, O_PP = O_YS + 131072, O_PS = O_PP + 61440, O_CP = O_PS + 983040, O_CS = O_CP + 122880, O_MK = O_CS + 1966080, O_MV = O_MK + 2097152;
constexpr size_t MiB = 1u << 20;
constexpr size_t WS_CTL = 0, CTL_ZERO_BYTES = MiB;
constexpr size_t WS_WIN = 1 * MiB, WS_WKV = 4 * MiB, WS_WOUT = 8 * MiB, WS_WQ = 10 * MiB, WS_WO = 12 * MiB, WS_WGU = 14 * MiB, WS_WD = 25 * MiB, WS_WMAP = 31 * MiB;
constexpr size_t WS_HB = 32 * MiB, WS_AP = 65 * MiB, WS_GLU = 82 * MiB, WS_C = 99 * MiB, WS_X1 = 132 * MiB, WS_X1B = 197 * MiB, WS_Q = 230 * MiB, WS_KB = 263 * MiB, WS_VT = 267 * MiB;
constexpr size_t WS_O = 271 * MiB, WS_X2B = 304 * MiB, WS_F = 337 * MiB, WS_MB = 426 * MiB, WS_SSQ1 = 430 * MiB, WS_SSQ2 = 431 * MiB, WS_SSQ3 = 432 * MiB, WS_SSQS = 433 * MiB, WS_US = 434 * MiB, WS_HC = 435 * MiB;
constexpr size_t WS_HP = WS_HC + 512 * 1024, WS_END = 436 * MiB;
constexpr int LDS_BYTES = 147456;
constexpr int NPHASE = 10;

template <int CTRL> __device__ __forceinline__ float dpp_mov(float v) { return __builtin_bit_cast(float, __builtin_amdgcn_update_dpp(0, __builtin_bit_cast(int, v), CTRL, 0xF, 0xF, true)); }
__device__ __forceinline__ float rdl(float v, int l) { return __builtin_bit_cast(float, __builtin_amdgcn_readlane(__builtin_bit_cast(int, v), l)); }
__device__ __forceinline__ float wave_sum(float v) {
    v += dpp_mov<0xB1>(v); v += dpp_mov<0x4E>(v); v += dpp_mov<0x141>(v); v += dpp_mov<0x140>(v);
    return (rdl(v, 0) + rdl(v, 16)) + (rdl(v, 32) + rdl(v, 48));
}
__device__ __forceinline__ float wave_max(float v) {
    v = fmaxf(v, dpp_mov<0xB1>(v)); v = fmaxf(v, dpp_mov<0x4E>(v)); v = fmaxf(v, dpp_mov<0x141>(v)); v = fmaxf(v, dpp_mov<0x140>(v));
    return fmaxf(fmaxf(rdl(v, 0), rdl(v, 16)), fmaxf(rdl(v, 32), rdl(v, 48)));
}
__device__ __forceinline__ unsigned f2bf(float f) { unsigned u = __builtin_bit_cast(unsigned, f); return (u + 0x7fffu + ((u >> 16) & 1u)) >> 16; }
__device__ __forceinline__ unsigned pk2(float lo, float hi) { return f2bf(lo) | (f2bf(hi) << 16); }
__device__ __forceinline__ float bf2f(bf16 v) { return __builtin_bit_cast(float, (unsigned)v << 16); }
__device__ __forceinline__ float sigm(float x) { return __builtin_amdgcn_rcpf(1.0f + __builtin_amdgcn_exp2f(-1.4426950408889634f * x)); }
#define LDS_WAIT() asm volatile("s_waitcnt lgkmcnt(0)" ::: "memory")

__device__ __forceinline__ void transpose_item(const float* W, int K, int N, const float* gk, bf16* WT, int dst_row0, LAS float* scr, int k0, int n0, int lane) {
    f32x4 v[8];
#pragma unroll
    for (int i = 0; i < 8; ++i) { const int kk = (lane >> 3) + 8 * i; v[i] = *(const f32x4*)(W + (size_t)(k0 + kk) * N + n0 + 4 * (lane & 7)); }
    if (gk) {
#pragma unroll
        for (int i = 0; i < 8; ++i) v[i] = v[i] * gk[k0 + (lane >> 3) + 8 * i]; }
#pragma unroll
    for (int i = 0; i < 8; ++i) { LAS float* d = scr + ((lane >> 3) + 8 * i) * 33 + 4 * (lane & 7); d[0] = v[i].x; d[1] = v[i].y; d[2] = v[i].z; d[3] = v[i].w; }
    LDS_WAIT();
    const int c = lane & 7;
#pragma unroll
    for (int j = 0; j < 4; ++j) { const int n = (lane >> 3) + 8 * j; const LAS float* s = scr + (8 * c) * 33 + n;
        u32x4 o; o.x = pk2(s[0 * 33], s[1 * 33]); o.y = pk2(s[2 * 33], s[3 * 33]); o.z = pk2(s[4 * 33], s[5 * 33]); o.w = pk2(s[6 * 33], s[7 * 33]);
        *(u32x4*)(WT + (size_t)(dst_row0 + n) * K + k0 + 8 * c) = o; }
    LDS_WAIT();
}
__device__ __forceinline__ void rms_load(const float* xrow, int lane, f32x4 (&v)[4]) {
    const f32x4* xr = (const f32x4*)xrow + lane;
#pragma unroll
    for (int j = 0; j < 4; ++j) v[j] = xr[64 * j];
}
__device__ __forceinline__ void rms_finish(const f32x4 (&v)[4], const float* g, bf16* orow, int lane, float* rinv) {
    const f32x4* gr = (const f32x4*)g + lane; float s = 0.f;
#pragma unroll
    for (int j = 0; j < 4; ++j) s += (v[j].x * v[j].x + v[j].y * v[j].y) + (v[j].z * v[j].z + v[j].w * v[j].w);
    const float rms = sqrtf(wave_sum(s) * (1.0f / DM) + EPS); const float rstd = 1.0f / rms;
    if (rinv && lane == 0) *rinv = rms;
    unsigned long long* o8 = (unsigned long long*)orow + lane;
#pragma unroll
    for (int j = 0; j < 4; ++j) { const f32x4 gg = gr[64 * j]; const f32x4 o = v[j] * rstd * gg;
        o8[64 * j] = (unsigned long long)pk2(o.x, o.y) | ((unsigned long long)pk2(o.z, o.w) << 32); }
}

struct Args { const float* in[28]; float* out; unsigned char* ws; int ph_lo, ph_hi; };

__device__ __forceinline__ void p0_prologue(const Args& a, LAS unsigned char* lds, int bid, int G, int tid, int lane, int wave) {
    unsigned char* ws = a.ws;
    LAS float* scr = (LAS float*)(lds + wave * 16384);
    const int gw = bid * 8 + wave, NGW = G * 8;
    constexpr int I_IN = 16 * 48, I_SQ = 16 * 32, I_GU = 16 * 88, I_D = 44 * 32, I_WP = 2048, I_CB = 256;
    constexpr int NITEMS = I_IN + 5 * I_SQ + 2 * I_GU + I_D + I_WP + I_CB;
    for (int it = gw; it < NITEMS; it += NGW) {
        int r = it;
        if (r < I_IN) { const int kb = r / 48, n0 = (r % 48) * 32; int dr;
            if (n0 < 512) dr = n0; else { int j = n0 - 512; int hi = 0; if (j >= 512) { j -= 512; hi = 128; } dr = 512 + (j >> 7) * 256 + hi + (j & 127); }
            transpose_item(a.in[8], 1024, 1536, nullptr, (bf16*)(ws + WS_WIN), dr, scr, 64 * kb, n0, lane); continue; } r -= I_IN;
        if (r < I_SQ) { transpose_item(a.in[20], 1024, 1024, nullptr, (bf16*)(ws + WS_WKV), (r % 32) * 32, scr, 64 * (r / 32), (r % 32) * 32, lane); continue; } r -= I_SQ;
        if (r < I_SQ) { transpose_item(a.in[21], 1024, 1024, nullptr, (bf16*)(ws + WS_WKV), 1024 + (r % 32) * 32, scr, 64 * (r / 32), (r % 32) * 32, lane); continue; } r -= I_SQ;
        if (r < I_SQ) { if (r >= I_SQ / 2) transpose_item(a.in[16], 1024, 1024, nullptr, (bf16*)(ws + WS_WOUT), (r % 32) * 32, scr, 64 * (r / 32), (r % 32) * 32, lane); continue; } r -= I_SQ;
        if (r < I_SQ) { transpose_item(a.in[19], 1024, 1024, a.in[17], (bf16*)(ws + WS_WQ), (r % 32) * 32, scr, 64 * (r / 32), (r % 32) * 32, lane); continue; } r -= I_SQ;
        if (r < I_SQ) { transpose_item(a.in[22], 1024, 1024, nullptr, (bf16*)(ws + WS_WO), (r % 32) * 32, scr, 64 * (r / 32), (r % 32) * 32, lane); continue; } r -= I_SQ;
        if (r < I_GU) { const int n0 = (r % 88) * 32; transpose_item(a.in[24], 1024, FF, a.in[23], (bf16*)(ws + WS_WGU), (n0 >> 7) * 256 + (n0 & 127), scr, 64 * (r / 88), n0, lane); continue; } r -= I_GU;
        if (r < I_GU) { const int n0 = (r % 88) * 32; transpose_item(a.in[25], 1024, FF, a.in[23], (bf16*)(ws + WS_WGU), (n0 >> 7) * 256 + 128 + (n0 & 127), scr, 64 * (r / 88), n0, lane); continue; } r -= I_GU;
        if (r < I_D) { transpose_item(a.in[26], FF, 1024, nullptr, (bf16*)(ws + WS_WD), (r % 32) * 32, scr, 64 * (r / 32), (r % 32) * 32, lane); continue; } r -= I_D;
if (r < I_WP) {
            const int g = r >> 9, n0 = ((r >> 3) & 63) * 16, c0 = (r & 7) * 16, fr = lane & 15, fq = lane >> 4;
            const float* Wout = a.in[16]; const float* Wm = a.in[9] + (size_t)g * 16384; const float* sc = a.in[11] + g * 128;
            f32x4 acc = {0.f, 0.f, 0.f, 0.f};
#pragma unroll
            for (int ks = 0; ks < 4; ++ks) { float av[8];
#pragma unroll
                for (int e = 0; e < 8; ++e) av[e] = Wout[(size_t)(g * 128 + 32 * ks + 8 * fq + e) * 1024 + n0 + fr];
                const f32x4 m0 = *(const f32x4*)(Wm + (c0 + fr) * 128 + 32 * ks + 8 * fq) * *(const f32x4*)(sc + 32 * ks + 8 * fq), m1 = *(const f32x4*)(Wm + (c0 + fr) * 128 + 32 * ks + 8 * fq + 4) * *(const f32x4*)(sc + 32 * ks + 8 * fq + 4);
                u32x4 aw, bw; aw.x = pk2(av[0], av[1]); aw.y = pk2(av[2], av[3]); aw.z = pk2(av[4], av[5]); aw.w = pk2(av[6], av[7]);
                bw.x = pk2(m0.x, m0.y); bw.y = pk2(m0.z, m0.w); bw.z = pk2(m1.x, m1.y); bw.w = pk2(m1.z, m1.w);
                acc = __builtin_amdgcn_mfma_f32_16x16x32_bf16(__builtin_bit_cast(bf16x8, aw), __builtin_bit_cast(bf16x8, bw), acc, 0, 0, 0); }
            bf16* WT = (bf16*)(ws + WS_WOUT);
#pragma unroll
            for (int jj = 0; jj < 4; ++jj) WT[(size_t)(n0 + 4 * fq + jj) * 1024 + g * 128 + c0 + fr] = (bf16)f2bf(acc[jj]);
            continue; } r -= I_WP;
        {
            const int nb = r & 15, cb = r >> 4; const float* Wout = a.in[16]; float part = 0.f;
#pragma unroll
            for (int e = 0; e < 32; ++e) { const int ch = 32 * cb + e; part += (a.in[10][ch] * a.in[11][ch]) * Wout[(size_t)ch * 1024 + 64 * nb + lane]; }
            atomicAdd((float*)(ws + WS_CTL + 512 * 1024) + 64 * nb + lane, part); }
    }
#define ROW_SRC(m) ((m) < MP ? a.in[0] + (size_t)(m) * DM : ((m) < MALL ? a.in[1] + (size_t)((m) - MP) * DM : a.in[2] + (size_t)((m) - MALL) * DM))
    { f32x4 cur[4], nxt[4]; int m = gw;
      if (m < MALL + MMEM) rms_load(ROW_SRC(m), lane, cur);
      for (; m < MALL + MMEM; m += NGW) { const int mn = m + NGW;
          if (mn < MALL + MMEM) rms_load(ROW_SRC(mn), lane, nxt);
          if (m < MALL) rms_finish(cur, a.in[7], (bf16*)(ws + WS_HB) + (size_t)m * DM, lane, (float*)(ws + WS_SSQ3) + m);
          else rms_finish(cur, a.in[18], (bf16*)(ws + WS_MB) + (size_t)(m - MALL) * DM, lane, nullptr);
#pragma unroll
          for (int j = 0; j < 4; ++j) cur[j] = nxt[j]; } }
#undef ROW_SRC
    const float* spool = a.in[3]; const float* sconv = a.in[4]; const float* wdw = a.in[12]; const float* bdw = a.in[13];
    float* HC = (float*)(ws + WS_HC); float* HP = (float*)(ws + WS_HP);
    for (int e2 = bid * 512 + tid; e2 < 2 * NS * 512; e2 += G * 512) {
        const int e = e2 & (NS * 512 - 1), b = e >> 9, ch = e & 511;
        if (e2 < NS * 512) {
            float v[30];
#pragma unroll
            for (int j = 0; j < 30; ++j) v[j] = sconv[(size_t)(b * 30 + j) * 512 + ch];
            float acc = bdw[ch];
#pragma unroll
            for (int j = 0; j < 30; ++j) { acc += wdw[j * 512 + ch] * v[j]; if (j >= 1) a.out[O_CS + (size_t)(b * 30 + j - 1) * 512 + ch] = v[j]; }
            HC[e] = acc;
        } else {
            float v[15];
#pragma unroll
            for (int j = 0; j < 15; ++j) v[j] = spool[(size_t)(b * 15 + j) * 512 + ch];
            const int w = 2 << (ch >> 7); float sacc = 0.f;
#pragma unroll
            for (int j = 0; j < 15; ++j) { if (j >= 1) a.out[O_PS + (size_t)(b * 15 + j - 1) * 512 + ch] = v[j]; if (j >= 16 - w) sacc += v[j]; }
            HP[e] = sacc;
        }
    }
}

template <bool PAIR, class Fn>
__device__ __forceinline__ void skinny(const bf16* A, const bf16* Bt, int K, int nColBlk, int c, int G, LAS float* red, int tid, const Fn& fn) {
    const int lane = tid & 63, wave = __builtin_amdgcn_readfirstlane(tid >> 6), fr = lane & 15, fq = lane >> 4;
    const int nItems = nColBlk * 4, kw = K >> 3;
    for (int it = c; it < nItems; it += G) {
        const int rb = it & 3, cb = it >> 2;
        const int n0 = PAIR ? ((cb >> 3) * 256 + (cb & 7) * 16) : cb * 16;
        const bf16* ap = A + (size_t)(32 * rb + fr) * K + wave * kw + 8 * fq;
        const bf16* bp = Bt + (size_t)(n0 + fr) * K + wave * kw + 8 * fq;
        f32x4 c00 = {0.f, 0.f, 0.f, 0.f}, c01 = c00, c10 = c00, c11 = c00;
        for (int ks = 0; ks < kw; ks += 32) {
            const bf16x8 b0 = *(const bf16x8*)(bp + ks), a0 = *(const bf16x8*)(ap + ks), a1 = *(const bf16x8*)(ap + (size_t)16 * K + ks);
            c00 = __builtin_amdgcn_mfma_f32_16x16x32_bf16(b0, a0, c00, 0, 0, 0); c01 = __builtin_amdgcn_mfma_f32_16x16x32_bf16(b0, a1, c01, 0, 0, 0);
            if (PAIR) { const bf16x8 b1 = *(const bf16x8*)(bp + (size_t)128 * K + ks);
                c10 = __builtin_amdgcn_mfma_f32_16x16x32_bf16(b1, a0, c10, 0, 0, 0); c11 = __builtin_amdgcn_mfma_f32_16x16x32_bf16(b1, a1, c11, 0, 0, 0); }
        }
        LAS float* rw = red + wave * 1024;
        *(LAS f32x4*)(rw + fr * 16 + 4 * fq) = c00; *(LAS f32x4*)(rw + (16 + fr) * 16 + 4 * fq) = c01;
        if (PAIR) { *(LAS f32x4*)(rw + 512 + fr * 16 + 4 * fq) = c10; *(LAS f32x4*)(rw + 512 + (16 + fr) * 16 + 4 * fq) = c11; }
        __syncthreads();
        float v0 = 0.f, v1 = 0.f;
#pragma unroll
        for (int w = 0; w < 8; ++w) { v0 += red[w * 1024 + tid]; if (PAIR) v1 += red[w * 1024 + 512 + tid]; }
        fn(32 * rb + (tid >> 4), cb * 16 + (tid & 15), cb, v0, v1);
        __syncthreads();
    }
}
__device__ __forceinline__ float red16(float s) { s += __shfl_xor(s, 1); s += __shfl_xor(s, 2); s += __shfl_xor(s, 4); s += __shfl_xor(s, 8); return s; }
__device__ __forceinline__ float rstd_s(const float* p, int row, int ci) {
    const float* q = p + row * 64 + ci; return 1.0f / sqrtf(red16((q[0] + q[16]) + (q[32] + q[48])) * (1.0f / DM) + EPS);
}
struct SkRaw { float* O; int ld; __device__ __forceinline__ void operator()(int row, int col, int, float v0, float) const { O[(size_t)row * ld + col] = v0; } };
template <bool RES_BF16> struct SkRes { const void* resid; bf16* xb; float* ssq; const float* bias;
    __device__ __forceinline__ void operator()(int row, int col, int cb, float v0, float) const {
        const size_t off = (size_t)row * DM + col; const float r = RES_BF16 ? bf2f(((const bf16*)resid)[off]) : ((const float*)resid)[off] + bias[col];
        const float x = r + v0; xb[off] = (bf16)f2bf(x);
        const float ss = red16(x * x); if ((col & 15) == 0) ssq[row * 64 + cb] = ss; } };
struct SkQ { const float* ssq; bf16* Q; __device__ __forceinline__ void operator()(int row, int col, int, float v0, float) const {
        const float rs = rstd_s(ssq, row, col & 15) * QSCALE; Q[(size_t)row * DM + col] = (bf16)f2bf(v0 * rs); } };
struct SkGU { const float* ssq; bf16* F; __device__ __forceinline__ void operator()(int row, int col, int, float v0, float v1) const {
        const float rs = rstd_s(ssq, row, col & 15); const float g = v0 * rs; F[(size_t)row * FF + col] = (bf16)f2bf(g * sigm(g) * (v1 * rs)); } };

constexpr int MX_TG = 0, MX_TA = 46 * 1024, MX_YC = MX_TA + 31 * 1024, MX_D = MX_YC + 16 * 2048, MX_DSTRIDE = 1024, MX_NPIECE = (46 + 31) * 64;
static_assert(MX_D + 16 * MX_DSTRIDE <= 131072, "mixer LDS");
template <int W> __device__ __forceinline__ void pool16(int t0, int tid, LAS unsigned char* lds) {
    float in[16 + W - 1];
#pragma unroll
    for (int i = 0; i < 16 + W - 1; ++i) in[i] = bf2f(*(const LAS bf16*)(lds + MX_TA + (16 - W + i) * 1024 + tid * 2));
#pragma unroll
    for (int r = 0; r < 16; ++r) { float s = 0.f;
#pragma unroll
        for (int j = 0; j < W; ++j) s += in[r + j];
        const int t = t0 + r; const int cnt = (t + 1 < W) ? (t + 1) : W;
        const float d = s / (float)cnt - in[r + W - 1];
        *(LAS bf16*)(lds + MX_D + r * MX_DSTRIDE + tid * 2) = (bf16)f2bf(d); }
}
struct MixP { f32x4 g0, g1, b0, b1; };
__device__ __forceinline__ void mixer_finish(const Args& a, LAS unsigned char* lds, int crow0, int tid, int lane, int wave, const MixP& P) {
    bf16* C = (bf16*)(a.ws + WS_C);
    const LAS float* yc = (const LAS float*)(lds + MX_YC);
    { const f32x4 g0 = P.g0, g1 = P.g1, b0 = P.b0, b1 = P.b1;
#pragma unroll
      for (int i = 0; i < 2; ++i) { const int r = 2 * wave + i;
        const f32x4 y0 = *(const LAS f32x4*)(yc + r * 512 + lane * 8), y1 = *(const LAS f32x4*)(yc + r * 512 + lane * 8 + 4);
        const float mu = wave_sum((y0.x + y0.y) + (y0.z + y0.w) + (y1.x + y1.y) + (y1.z + y1.w)) * (1.0f / 512.0f);
        const f32x4 d0 = y0 - mu, d1 = y1 - mu;
        const float var = wave_sum((d0.x * d0.x + d0.y * d0.y) + (d0.z * d0.z + d0.w * d0.w) + (d1.x * d1.x + d1.y * d1.y) + (d1.z * d1.z + d1.w * d1.w)) * (1.0f / 512.0f);
        const float rs = 1.0f / sqrtf(var + EPS);
        f32x4 n0 = d0 * rs * g0 + b0, n1 = d1 * rs * g1 + b1;
#pragma unroll
        for (int j = 0; j < 4; ++j) { n0[j] = n0[j] * sigm(n0[j]); n1[j] = n1[j] * sigm(n1[j]); }
        u32x4 o; o.x = pk2(n0.x, n0.y); o.y = pk2(n0.z, n0.w); o.z = pk2(n1.x, n1.y); o.w = pk2(n1.z, n1.w);
        *(u32x4*)(C + (size_t)(crow0 + r) * DM + 512 + lane * 8) = o; } }
#pragma unroll
    for (int i = 0; i < 2; ++i) { const int r = 2 * wave + i; *(u32x4*)(C + (size_t)(crow0 + r) * DM + lane * 8) = *(const LAS u32x4*)(lds + MX_D + r * MX_DSTRIDE + lane * 16); }
}
__device__ __forceinline__ void mixer_phase(const Args& a, LAS unsigned char* lds, int bid, int G, int tid, int lane, int wave) {
    const bf16* GLU = (const bf16*)(a.ws + WS_GLU); const bf16* AP = (const bf16*)(a.ws + WS_AP);
    LAS float* yc = (LAS float*)(lds + MX_YC);
    u32x4 pr[10];
#define MX_LOAD(u) do { const int b_ = (u) >> 7, t0_ = ((u) & 127) * 16; _Pragma("unroll") for (int i = 0; i < 10; ++i) { const int p = tid + 512 * i; \
        if (p < MX_NPIECE) { const bool isg = p < 46 * 64; const int q = isg ? p : p - 46 * 64; const int t = t0_ - (isg ? 30 : 15) + (q >> 6); const int tt = t < 0 ? 0 : t; \
            const u32x4 v = *(const u32x4*)((isg ? GLU : AP) + (size_t)(b_ * SEQ + tt) * 512 + (q & 63) * 8); pr[i] = t >= 0 ? v : (u32x4){0u, 0u, 0u, 0u}; } } } while (0)
    int u = bid; bool have = u < 1024;
    if (have) MX_LOAD(u);
    float w[31];
#pragma unroll
    for (int j = 0; j < 31; ++j) w[j] = a.in[12][j * 512 + tid];
    const float bias = a.in[13][tid];
    MixP P;
    P.g0 = *(const f32x4*)(a.in[14] + lane * 8); P.g1 = *(const f32x4*)(a.in[14] + lane * 8 + 4); P.b0 = *(const f32x4*)(a.in[15] + lane * 8); P.b1 = *(const f32x4*)(a.in[15] + lane * 8 + 4);
#define MX_STORE() do { _Pragma("unroll") for (int i = 0; i < 10; ++i) { const int p = tid + 512 * i; if (p < MX_NPIECE) *(LAS u32x4*)(lds + p * 16) = pr[i]; } } while (0)
    if (have) { MX_STORE(); const int un = u + G; if (un < 1024) MX_LOAD(un); }
    while (have) {
        __syncthreads();
        const int b = u >> 7, t0 = (u & 127) * 16;
        { float in[46];
#pragma unroll
          for (int i = 0; i < 46; ++i) in[i] = bf2f(*(const LAS bf16*)(lds + MX_TG + i * 1024 + tid * 2));
#pragma unroll
          for (int r = 0; r < 16; ++r) { float acc = bias;
#pragma unroll
              for (int j = 0; j < 31; ++j) acc += w[j] * in[r + j];
              yc[r * 512 + tid] = acc; } }
        { const int g = tid >> 7;
          if (g == 0) pool16<2>(t0, tid, lds); else if (g == 1) pool16<4>(t0, tid, lds); else if (g == 2) pool16<8>(t0, tid, lds); else pool16<16>(t0, tid, lds); }
        __syncthreads();
        const int un = u + G; const bool hn = un < 1024;
        if (hn) { MX_STORE(); const int unn = un + G; if (unn < 1024) MX_LOAD(unn); }
        mixer_finish(a, lds, b * SEQ + t0, tid, lane, wave, P);
        u = un; have = hn;
    }
#undef MX_STORE
#undef MX_LOAD
    const float* US = (const float*)(a.ws + WS_US); const float* HC = (const float*)(a.ws + WS_HC); const float* HP = (const float*)(a.ws + WS_HP);
    for (int su = (bid + 8) % G; su < 8; su += G) {
        __syncthreads();
        const float w30 = w[30]; const int wdt = 2 << (tid >> 7); const float invw = 1.0f / (float)wdt;
        const int gcol = 512 + (tid >> 7) * 256 + (tid & 127);
#pragma unroll
        for (int s2 = 0; s2 < 16; ++s2) { const int bs = 16 * su + s2;
            const float val = US[(size_t)bs * 1536 + gcol], gate = US[(size_t)bs * 1536 + gcol + 128], av = US[(size_t)bs * 1536 + tid];
            const float glu = val * sigm(gate);
            a.out[O_CS + (size_t)(bs * 30 + 29) * 512 + tid] = glu; a.out[O_PS + (size_t)(bs * 15 + 14) * 512 + tid] = av;
            yc[s2 * 512 + tid] = HC[bs * 512 + tid] + w30 * glu;
            const float d = (av + HP[bs * 512 + tid]) * invw - av;
            *(LAS bf16*)(lds + MX_D + s2 * MX_DSTRIDE + tid * 2) = (bf16)f2bf(d); }
        __syncthreads();
        mixer_finish(a, lds, MP + 16 * su, tid, lane, wave, P);
    }
    __syncthreads();
}

constexpr int AT_K = 0, AT_KSTR = 528, AT_V = 64 * AT_KSTR, AT_VSTR = 144;
__device__ __forceinline__ float fexp2(float x) { return __builtin_amdgcn_exp2f(x); }
__device__ __forceinline__ void attn_prompt_unit(const Args& a, LAS unsigned char* lds, int u, int tid, int lane, int wave) {
    const int qb = u & 15, h = (u >> 4) & 3, b = u >> 6, fr = lane & 15, fq = lane >> 4;
    const bf16* Q = (const bf16*)(a.ws + WS_Q); const bf16* KB = (const bf16*)(a.ws + WS_KB); const bf16* VT = (const bf16*)(a.ws + WS_VT); bf16* O = (bf16*)(a.ws + WS_O);
    const size_t rowq = (size_t)b * SEQ + qb * 128 + wave * 16 + fr;
    bf16x8 qf[8];
#pragma unroll
    for (int kd = 0; kd < 8; ++kd) qf[kd] = *(const bf16x8*)(Q + rowq * DM + h * 256 + 32 * kd + 8 * fq);
    f32x4 o[16];
#pragma unroll
    for (int i = 0; i < 16; ++i) o[i] = (f32x4){0.f, 0.f, 0.f, 0.f};
    float mrun = -INFINITY, lrun = 0.f;
    u32x4 kr[4], vr[4];
#define AT_LOAD(c) do { _Pragma("unroll") for (int i = 0; i < 4; ++i) { const int p = tid + 512 * i; \
        kr[i] = *(const u32x4*)(KB + (size_t)(b * 256 + 64 * (c) + (p >> 5)) * DM + h * 256 + (p & 31) * 8); \
        vr[i] = *(const u32x4*)(VT + (size_t)(h * 256 + (p >> 3)) * 2048 + b * 256 + 64 * (c) + (p & 7) * 8); } } while (0)
    AT_LOAD(0);
#pragma unroll 1
    for (int c = 0; c < 4; ++c) {
        __syncthreads();
#pragma unroll
        for (int i = 0; i < 4; ++i) { const int p = tid + 512 * i;
            *(LAS u32x4*)(lds + AT_K + (p >> 5) * AT_KSTR + (p & 31) * 16) = kr[i];
            *(LAS u32x4*)(lds + AT_V + (p >> 3) * AT_VSTR + (p & 7) * 16) = vr[i]; }
        __syncthreads();
        if (c < 3) AT_LOAD(c + 1);
        f32x4 s[4];
#pragma unroll
        for (int nb = 0; nb < 4; ++nb) { s[nb] = (f32x4){0.f, 0.f, 0.f, 0.f};
#pragma unroll
            for (int kd = 0; kd < 8; ++kd) { const bf16x8 kf = *(const LAS bf16x8*)(lds + AT_K + (16 * nb + fr) * AT_KSTR + kd * 64 + fq * 16);
                s[nb] = __builtin_amdgcn_mfma_f32_16x16x32_bf16(kf, qf[kd], s[nb], 0, 0, 0); } }
        float mx = s[0][0];
#pragma unroll
        for (int nb = 0; nb < 4; ++nb)
#pragma unroll
            for (int j = 0; j < 4; ++j) mx = fmaxf(mx, s[nb][j]);
        mx = fmaxf(mx, __shfl_xor(mx, 16)); mx = fmaxf(mx, __shfl_xor(mx, 32));
        const float mnew = fmaxf(mrun, mx), alpha = fexp2(mrun - mnew);
        float ps = 0.f;
#pragma unroll
        for (int nb = 0; nb < 4; ++nb)
#pragma unroll
            for (int j = 0; j < 4; ++j) { s[nb][j] = fexp2(s[nb][j] - mnew); ps += s[nb][j]; }
        ps += __shfl_xor(ps, 16); ps += __shfl_xor(ps, 32);
        lrun = lrun * alpha + ps; mrun = mnew;
#pragma unroll
        for (int i = 0; i < 16; ++i) o[i] = o[i] * alpha;
#pragma unroll
        for (int kb = 0; kb < 2; ++kb) {
            u32x4 pw; pw.x = pg8::cvt_pk_bf16(s[2 * kb][0], s[2 * kb][1]); pw.y = pg8::cvt_pk_bf16(s[2 * kb][2], s[2 * kb][3]);
            pw.z = pg8::cvt_pk_bf16(s[2 * kb + 1][0], s[2 * kb + 1][1]); pw.w = pg8::cvt_pk_bf16(s[2 * kb + 1][2], s[2 * kb + 1][3]);
            const bf16x8 pf = __builtin_bit_cast(bf16x8, pw);
#pragma unroll
            for (int db = 0; db < 16; ++db) {
                const u32x2 v0 = *(const LAS u32x2*)(lds + AT_V + (16 * db + fr) * AT_VSTR + kb * 64 + fq * 8), v1 = *(const LAS u32x2*)(lds + AT_V + (16 * db + fr) * AT_VSTR + kb * 64 + 32 + fq * 8);
                u32x4 vw; vw.x = v0.x; vw.y = v0.y; vw.z = v1.x; vw.w = v1.y;
                o[db] = __builtin_amdgcn_mfma_f32_16x16x32_bf16(__builtin_bit_cast(bf16x8, vw), pf, o[db], 0, 0, 0); }
        }
    }
#undef AT_LOAD
    const float inv = 1.0f / lrun;
#pragma unroll
    for (int db = 0; db < 16; ++db) { const f32x4 y = o[db] * inv; u32x2 w; w.x = pg8::cvt_pk_bf16(y.x, y.y); w.y = pg8::cvt_pk_bf16(y.z, y.w);
        *(u32x2*)(O + rowq * DM + h * 256 + 16 * db + 4 * fq) = w; }
}
__device__ __forceinline__ float rdlane(float v, int l) { return __builtin_bit_cast(float, __builtin_amdgcn_readlane(__builtin_bit_cast(int, v), l)); }
__device__ __forceinline__ void attn_sample_item(const Args& a, LAS unsigned char* lds, int item, int tid, int lane, int wave) {
    const int u = 2 * item + (wave >> 2), qt = wave & 3, b = u >> 2, h = u & 3;
    const bf16* Q = (const bf16*)(a.ws + WS_Q) + (size_t)(MP + b) * DM + h * 256;
    const float* ck = a.in[5] + ((size_t)(b * 256 + 64 * qt) * 4 + h) * 256 + lane * 4; const float* cv = a.in[6] + ((size_t)(b * 256 + 64 * qt) * 4 + h) * 256 + lane * 4;
    const u32x2 qw = *(const u32x2*)(Q + lane * 4);
    const f32x4 q = {__builtin_bit_cast(float, qw.x << 16), __builtin_bit_cast(float, qw.x & 0xffff0000u), __builtin_bit_cast(float, qw.y << 16), __builtin_bit_cast(float, qw.y & 0xffff0000u)};
    f32x4 A[8], B[8];
#define SA_PTR(j) (((j) < 8 ? ck : cv) + (size_t)(((j) & 7) * 8) * 1024)
#define SA_LOAD(buf, j) do { const float* bp_ = SA_PTR(j); _Pragma("unroll") for (int i = 0; i < 8; ++i) buf[i] = __builtin_nontemporal_load((const f32x4*)(bp_ + (size_t)i * 1024)); } while (0)
#define SA_DOTS(buf, j) do { _Pragma("unroll") for (int i = 0; i < 8; ++i) { const float sd = wave_sum((buf[i].x * q.x + buf[i].y * q.y) + (buf[i].z * q.z + buf[i].w * q.w)); mine = (lane == 8 * (j) + i) ? sd : mine; } } while (0)
#define SA_ACC(buf, j) do { _Pragma("unroll") for (int i = 0; i < 8; ++i) { const float pi = pl[8 * (j) + i]; acc += buf[i] * pi; } } while (0)
    float mine = 0.f;
    SA_LOAD(A, 0); SA_LOAD(B, 1);
#pragma unroll 1
    for (int j = 0; j < 8; j += 2) { SA_DOTS(A, j); SA_LOAD(A, j + 2); SA_DOTS(B, j + 1); SA_LOAD(B, j + 3); }
    const float mloc = wave_max(mine); const float p = fexp2(mine - mloc); const float lloc = wave_sum(p);
    LAS float* pl = (LAS float*)(lds + 16384) + wave * 64;
    pl[lane] = p; LDS_WAIT();
    f32x4 acc = {0.f, 0.f, 0.f, 0.f};
#pragma unroll 1
    for (int j = 0; j < 8; j += 2) { SA_ACC(A, j); if (j + 2 < 8) SA_LOAD(A, j + 10); SA_ACC(B, j + 1); if (j + 2 < 8) SA_LOAD(B, j + 11); }
#undef SA_PTR
#undef SA_LOAD
#undef SA_DOTS
#undef SA_ACC
    LAS float* po = (LAS float*)lds; LAS float* ml = po + 8 * 256;
    __syncthreads();
    *(LAS f32x4*)(po + wave * 256 + lane * 4) = acc; if (lane == 0) { ml[2 * wave] = mloc; ml[2 * wave + 1] = lloc; }
    __syncthreads();
    { const int ul = tid >> 8, d = tid & 255;
      const float m0 = ml[8 * ul], m1 = ml[8 * ul + 2], m2 = ml[8 * ul + 4], m3 = ml[8 * ul + 6];
      const float M = fmaxf(fmaxf(m0, m1), fmaxf(m2, m3));
      const float e0 = fexp2(m0 - M), e1 = fexp2(m1 - M), e2 = fexp2(m2 - M), e3 = fexp2(m3 - M);
      const float den = (e0 * ml[8 * ul + 1] + e1 * ml[8 * ul + 3]) + (e2 * ml[8 * ul + 5] + e3 * ml[8 * ul + 7]);
      const float num = (e0 * po[(4 * ul) * 256 + d] + e1 * po[(4 * ul + 1) * 256 + d]) + (e2 * po[(4 * ul + 2) * 256 + d] + e3 * po[(4 * ul + 3) * 256 + d]);
      const int uu = 2 * item + ul;
      ((bf16*)(a.ws + WS_O))[(size_t)(MP + (uu >> 2)) * DM + (uu & 3) * 256 + d] = (bf16)f2bf(num / den); }
    __syncthreads();
}

#define XB_TMO      128
#define XB_XCNT(j)  (256  + 64 * (j))
#define XB_XSUB(j)  (1280 + 64 * (j))
#define XB_XGEN(j)  (2304 + 64 * (j))
#define XB_TOP      3328
#define XB_TOPGEN   3392
#define XCD_BAR_WORDS 3456
#define XB_SPIN_CAP (1u << 18)

__device__ __forceinline__ unsigned xb_ld(unsigned* p)              { return __hip_atomic_load(p, __ATOMIC_RELAXED, __HIP_MEMORY_SCOPE_AGENT); }
__device__ __forceinline__ unsigned xb_add(unsigned* p, unsigned v) { return __hip_atomic_fetch_add(p, v, __ATOMIC_RELAXED, __HIP_MEMORY_SCOPE_AGENT); }
__device__ __forceinline__ unsigned xb_xcc_id() { return (unsigned)__builtin_amdgcn_s_getreg((3 << 11) | 20) & 0xFu; }
#define XB_SPIN(cond, bar) do { unsigned _sp = 0; while (cond) { __builtin_amdgcn_s_sleep(1); \
    if ((++_sp & 255u) == 0u) { if (xb_ld(&(bar)[XB_TMO])) break; if (_sp > XB_SPIN_CAP) { atomicAdd(&(bar)[XB_TMO], 1u); break; } } } } while (0)

struct XcdBarrier {
    unsigned* bar; unsigned x;
    volatile LAS unsigned* st;
};

__device__ __forceinline__ XcdBarrier xcd_barrier_post(unsigned* bar, volatile LAS unsigned* st) {
    XcdBarrier b; b.bar = bar; b.x = xb_xcc_id(); b.st = st;
    if (threadIdx.x == 0) (void)xb_add(&bar[XB_XCNT(b.x)], 1u);
    return b;
}
__device__ __forceinline__ void xcd_barrier_complete(unsigned* bar, unsigned x, unsigned& nloc, unsigned& nx) {
    const unsigned G = gridDim.x * gridDim.y * gridDim.z;
    unsigned sum, cnt, mine, sp = 0u;
    for (;;) {
        sum = 0u; cnt = 0u; mine = 0u;
#pragma unroll
        for (unsigned j = 0; j < 16; ++j) { const unsigned c = xb_ld(&bar[XB_XCNT(j)]); sum += c; cnt += (c > 0u) ? 1u : 0u; mine = (j == x) ? c : mine; }
        if (sum == G) break;
        __builtin_amdgcn_s_sleep(1);
        if ((++sp & 255u) == 0u) { if (xb_ld(&bar[XB_TMO])) break; if (sp > XB_SPIN_CAP) { atomicAdd(&bar[XB_TMO], 1u); break; } }
    }
    nloc = mine > 0u ? mine : 1u; nx = cnt > 0u ? cnt : 1u;
}

__device__ __forceinline__ void xcd_barrier(const XcdBarrier& b) {
    asm volatile("s_waitcnt vmcnt(0)" ::: "memory");
    __syncthreads();
    if (threadIdx.x == 0) {
        unsigned* bar = b.bar;
        __builtin_amdgcn_s_waitcnt(0);
        unsigned nloc = b.st[0], nx = b.st[1];
        if (nloc == 0u) { xcd_barrier_complete(bar, b.x, nloc, nx); b.st[0] = nloc; b.st[1] = nx; }
        const unsigned old = xb_add(&bar[XB_XSUB(b.x)], 1u);
        const unsigned gen = old / nloc;
        if (old + 1u == (gen + 1u) * nloc) {
            __builtin_amdgcn_fence(__ATOMIC_RELEASE, "agent");
            asm volatile("s_waitcnt vmcnt(0)" ::: "memory");
            const unsigned og = xb_add(&bar[XB_TOP], 1u);
            const unsigned tg = og / nx;
            if (og + 1u == (tg + 1u) * nx) xb_add(&bar[XB_TOPGEN], 1u);
            else XB_SPIN(xb_ld(&bar[XB_TOPGEN]) == tg, bar);
            __builtin_amdgcn_fence(__ATOMIC_ACQUIRE, "agent");
            xb_add(&bar[XB_XGEN(b.x)], 1u);
            asm volatile("s_waitcnt vmcnt(0)" ::: "memory");
        } else {
            XB_SPIN(xb_ld(&bar[XB_XGEN(b.x)]) == gen, bar);
            __builtin_amdgcn_fence(__ATOMIC_ACQUIRE, "agent");
            asm volatile("s_waitcnt vmcnt(0)" ::: "memory");
        }
    }
    __syncthreads();
}

constexpr int CW_BAR = 4096;
constexpr int MISC_OFF = 131072 + 320;
__global__ void __launch_bounds__(512, 2) fwd_kernel(Args a) {
    extern __shared__ __attribute__((aligned(16))) unsigned char lds_raw[];
    LAS unsigned char* lds = (LAS unsigned char*)lds_raw;
    const int tid = threadIdx.x, lane = tid & 63, wave = __builtin_amdgcn_readfirstlane(tid >> 6);
    const int G = gridDim.x, bid = blockIdx.x;
    unsigned char* ws = a.ws;
    const int lo = a.ph_lo, hi = a.ph_hi;
    cg::grid_group grid = cg::this_grid();
    for (int u = tid; u < (LDS_BYTES - 131072) / 4; u += 512) ((LAS unsigned*)(lds + 131072))[u] = 0u;
    __syncthreads();
    volatile LAS unsigned* MISC = (volatile LAS unsigned*)(lds + MISC_OFF);
    XcdBarrier bar; bar.bar = (unsigned*)(ws + WS_CTL) + CW_BAR; bar.x = 0; bar.st = nullptr;
    if (hi - lo > 1) bar = xcd_barrier_post((unsigned*)(ws + WS_CTL) + CW_BAR, MISC + 8);
    if (lo < 0) grid.sync();
#define IN(k) (lo <= (k) && (k) < hi)
#define SEAM(k) do { if (lo <= (k) && (k) + 1 < hi) xcd_barrier(bar); } while (0)
    bf16* HB = (bf16*)(ws + WS_HB); bf16* C = (bf16*)(ws + WS_C); bf16* X3B = (bf16*)(ws + WS_X1); bf16* X1B = (bf16*)(ws + WS_X1B); bf16* Qb = (bf16*)(ws + WS_Q);
    bf16* Ob = (bf16*)(ws + WS_O); bf16* X2B = (bf16*)(ws + WS_X2B); bf16* Fb = (bf16*)(ws + WS_F);
    float* SSQ1 = (float*)(ws + WS_SSQ1); float* SSQ2 = (float*)(ws + WS_SSQ2); float* SSQ3 = (float*)(ws + WS_SSQ3);
    float* SSQ1S = (float*)(ws + WS_SSQS); float* SSQ2S = SSQ1S + NS * 64; float* SSQ3S = SSQ2S + NS * 64;
    LAS float* red = (LAS float*)lds;

    if (IN(0)) { p0_prologue(a, lds, bid, G, tid, lane, wave); }
    SEAM(0);
    if (IN(1)) {
        { pg8::Gemm g{HB, (const bf16*)(ws + WS_WIN), MP, 1536, 1024}; pg8::StaticOrder S; S.init(MP, 1536, G, bid);
          pg8::EpiIn E{(bf16*)(ws + WS_AP), (bf16*)(ws + WS_GLU), a.out + O_PP, a.out + O_CP};
          pg8::gemm_phase<pg8::EpiIn, pg8::StaticOrder, true, true>(lds, g, S, E); }
        { pg8::Gemm g{(const bf16*)(ws + WS_MB), (const bf16*)(ws + WS_WKV), MMEM, 2048, 1024}; pg8::StaticOrder S; S.init(MMEM, 2048, G, (bid + G - (128 % G)) % G);
          pg8::EpiKV E{a.out + O_MK, a.out + O_MV, (bf16*)(ws + WS_KB)};
          pg8::gemm_phase<pg8::EpiKV, pg8::StaticOrder, true, true>(lds, g, S, E); }
        { pg8::Gemm g{(const bf16*)(ws + WS_WKV) + (size_t)1024 * 1024, (const bf16*)(ws + WS_MB), 1024, MMEM, 1024}; pg8::StaticOrder S; S.init(1024, MMEM, G, (bid + G - (192 % G)) % G);
          pg8::EpiPlain E{(bf16*)(ws + WS_VT), 2048};
          pg8::gemm_phase<pg8::EpiPlain, pg8::StaticOrder, true, true>(lds, g, S, E); }
        __syncthreads();
        { SkRaw f{(float*)(ws + WS_US), 1536}; const int ge = G > 32 ? 32 : G, cc = (bid + G - (224 % G)) % G; if (cc < ge) skinny<false>(HB + (size_t)MP * DM, (const bf16*)(ws + WS_WIN), 1024, 96, cc, ge, red, tid, f); }
    }
    SEAM(1);
    if (IN(2)) {
        mixer_phase(a, lds, bid, G, tid, lane, wave);
    }
    SEAM(2);
    if (IN(3)) {
        { pg8::Gemm g{C, (const bf16*)(ws + WS_WOUT), MP, 1024, 1024}; pg8::StaticOrder S; S.init(MP, 1024, G, bid);
          pg8::EpiRes<false> E{HB, X1B, SSQ1, (const float*)(ws + WS_CTL + 512 * 1024), (const float*)(ws + WS_SSQ3), a.in[7]};
          pg8::gemm_phase<pg8::EpiRes<false>, pg8::StaticOrder, false, true>(lds, g, S, E); }
        __syncthreads();
        { SkRes<false> f{a.in[1], X1B + (size_t)MP * DM, SSQ1S, (const float*)(ws + WS_CTL + 512 * 1024)}; skinny<false>(C + (size_t)MP * DM, (const bf16*)(ws + WS_WOUT), 1024, 64, bid, G, red, tid, f); }
    }
    SEAM(3);
    if (IN(4)) {
        { pg8::Gemm g{X1B, (const bf16*)(ws + WS_WQ), MP, 1024, 1024}; pg8::StaticOrder S; S.init(MP, 1024, G, bid);
          LAS float* rtab = (LAS float*)(lds + 131072 + 1024); pg8::Unit u0; int tpm = -1;
          if (S.next(0, u0)) { tpm = u0.pm; if (tid < 256) rtab[tid] = pg8::rstd16(SSQ1 + (size_t)(u0.pm * 256 + tid) * 16); }
          __syncthreads();
          pg8::EpiQ E{SSQ1, Qb, QSCALE, rtab, tpm};
          pg8::gemm_phase<pg8::EpiQ, pg8::StaticOrder, false, true>(lds, g, S, E); }
        __syncthreads();
        { SkQ f{SSQ1S, Qb + (size_t)MP * DM}; skinny<false>(X1B + (size_t)MP * DM, (const bf16*)(ws + WS_WQ), 1024, 64, bid, G, red, tid, f); }
    }
    SEAM(4);
    if (IN(5)) {
        for (int u = bid; u < 512; u += G) attn_prompt_unit(a, lds, u, tid, lane, wave);
        __syncthreads();
        for (int it = bid; it < 256; it += G) attn_sample_item(a, lds, it, tid, lane, wave);
    }
    SEAM(5);
    if (IN(6)) {
        { pg8::Gemm g{Ob, (const bf16*)(ws + WS_WO), MP, 1024, 1024}; pg8::StaticOrder S; S.init(MP, 1024, G, bid);
          pg8::EpiRes<true> E{X1B, X2B, SSQ2, nullptr, nullptr, nullptr};
          pg8::gemm_phase<pg8::EpiRes<true>, pg8::StaticOrder, false, true>(lds, g, S, E); }
        __syncthreads();
        { SkRes<true> f{X1B + (size_t)MP * DM, X2B + (size_t)MP * DM, SSQ2S, nullptr}; skinny<false>(Ob + (size_t)MP * DM, (const bf16*)(ws + WS_WO), 1024, 64, bid, G, red, tid, f); }
    }
    SEAM(6);
    if (IN(7)) {
        { pg8::Gemm g{X2B, (const bf16*)(ws + WS_WGU), MP, FF2, 1024}; pg8::StaticOrder S; S.init(MP, FF2, G, bid);
          LAS float* rtab = (LAS float*)(lds + 131072 + 1024); pg8::Unit u0; int tpm = -1;
          if (S.next(0, u0)) { tpm = u0.pm; if (tid < 256) rtab[tid] = pg8::rstd16(SSQ2 + (size_t)(u0.pm * 256 + tid) * 16); }
          __syncthreads();
          pg8::EpiGU E{SSQ2, Fb, rtab, tpm};
          pg8::gemm_phase<pg8::EpiGU, pg8::StaticOrder, true, true>(lds, g, S, E); }
        __syncthreads();
        { SkGU f{SSQ2S, Fb + (size_t)MP * FF}; const int half = G >= 2 ? G / 2 : 1;
          if (bid >= G - half) skinny<true>(X2B + (size_t)MP * DM, (const bf16*)(ws + WS_WGU), 1024, 176, bid - (G - half), half, red, tid, f); }
    }
    SEAM(7);
    if (IN(8)) {
        { pg8::Gemm g{Fb, (const bf16*)(ws + WS_WD), MP, 1024, FF}; pg8::StaticOrder S; S.init(MP, 1024, G, bid);
          pg8::EpiRes<true> E{X2B, X3B, SSQ3, nullptr, nullptr, nullptr};
          pg8::gemm_phase<pg8::EpiRes<true>, pg8::StaticOrder, false, true>(lds, g, S, E); }
        __syncthreads();
        { SkRes<true> f{X2B + (size_t)MP * DM, X3B + (size_t)MP * DM, SSQ3S, nullptr}; skinny<false>(Fb + (size_t)MP * FF, (const bf16*)(ws + WS_WD), FF, 64, bid, G, red, tid, f); }
    }
    SEAM(8);
    if (IN(9)) {
        const int gw = bid * 8 + wave, NGW = G * 8;
        const f32x4* gf = (const f32x4*)a.in[27] + lane;
        for (int m = gw; m < MALL; m += NGW) {
            float* yrow; float ssum;
            if (m < MP) { yrow = a.out + O_Y + (size_t)m * DM; const float v = (lane < 16) ? SSQ3[(size_t)m * 16 + lane] : 0.f; ssum = wave_sum(v); }
            else { yrow = a.out + O_YS + (size_t)(m - MP) * DM; ssum = wave_sum(SSQ3S[(m - MP) * 64 + lane]); }
            const float rstd = 1.0f / sqrtf(ssum * (1.0f / DM) + EPS);
            const u32x2* xr = (const u32x2*)(X3B + (size_t)m * DM) + lane; f32x4* yr = (f32x4*)yrow + lane;
#pragma unroll
            for (int j = 0; j < 4; ++j) { const u32x2 w = xr[64 * j];
                const f32x4 v = {__builtin_bit_cast(float, w.x << 16), __builtin_bit_cast(float, w.x & 0xffff0000u), __builtin_bit_cast(float, w.y << 16), __builtin_bit_cast(float, w.y & 0xffff0000u)};
                yr[64 * j] = v * rstd * gf[64 * j]; }
        }
    }
#undef IN
#undef SEAM
}

#ifndef MK_MULTI
#define MK_MULTI 0
#endif
extern "C" void kernel_launch(void* const* d_in, const int* in_sizes, int n_in, void* d_out, int out_size, void* d_ws, size_t ws_size, hipStream_t stream) {
    static int grid = 0;
    if (grid == 0) {
        if (n_in != 28 || ws_size < WS_END) { fprintf(stderr, "kernel_launch: unexpected n_in %d / ws_size %zu\n", n_in, ws_size); grid = -1; return; }
        int dev = 0, cus = 0, per_cu = 0;
        (void)hipGetDevice(&dev); (void)hipDeviceGetAttribute(&cus, hipDeviceAttributeMultiprocessorCount, dev);
        if (hipFuncSetAttribute((const void*)fwd_kernel, hipFuncAttributeMaxDynamicSharedMemorySize, LDS_BYTES) != hipSuccess) { fprintf(stderr, "kernel_launch: hipFuncSetAttribute failed\n"); grid = -1; return; }
        if (hipOccupancyMaxActiveBlocksPerMultiprocessor(&per_cu, (const void*)fwd_kernel, 512, LDS_BYTES) != hipSuccess || per_cu < 1) { fprintf(stderr, "kernel_launch: occupancy query says %d\n", per_cu); per_cu = 1; }
        (void)hipGetLastError();
        grid = cus;
    }
    if (grid < 0) return;
    (void)hipMemsetAsync((char*)d_ws + WS_CTL, 0, CTL_ZERO_BYTES, stream);
    Args a{};
    for (int i = 0; i < 28; ++i) a.in[i] = (const float*)d_in[i];
    a.out = (float*)d_out; a.ws = (unsigned char*)d_ws;
#if MK_MULTI
    for (int p = 0; p < NPHASE; ++p) { a.ph_lo = p; a.ph_hi = p + 1; hipLaunchKernelGGL(fwd_kernel, dim3(grid), dim3(512), LDS_BYTES, stream, a); }
#else
    a.ph_lo = 0; a.ph_hi = NPHASE;
    void* args[] = {&a};
    hipError_t e = hipLaunchCooperativeKernel((const void*)fwd_kernel, dim3(grid), dim3(512), args, LDS_BYTES, stream);
    if (e != hipSuccess) fprintf(stderr, "cooperative launch failed: %s (grid %d)\n", hipGetErrorString(e), grid);
#endif
}
```

```cpp
#include <hip/hip_runtime.h>
#include <hip/hip_cooperative_groups.h>
#include <cstdio>
#include <cstdint>
namespace cg = cooperative_groups;
namespace pg8 {
#define PG8_LAS __attribute__((address_space(3)))
typedef unsigned short bf16_t;
typedef short bf16x8 __attribute__((ext_vector_type(8)));
typedef float f32x4 __attribute__((ext_vector_type(4)));
typedef unsigned u32x4 __attribute__((ext_vector_type(4)));
constexpr int BM = 256, BK = 64, HALF = 128, HTB = HALF * BK * 2  , STAGE_BYTES = 8 * HTB, NXCD = 8, WGM = 8;

__host__ __device__ __forceinline__ int lds_byte(int r, int c) { const int st = (r >> 4) * 2 + (c >> 5), rr = r & 15, cc = c & 31, ob = rr * 64 + cc * 2; return st * 1024 + (ob ^ (((ob >> 9) & 1) << 5)); }
__host__ __device__ __forceinline__ void stage_rc(int b, int& R, int& C) { const int st = b / 1024, sb = b % 1024, swz = sb ^ (((sb >> 9) & 1) << 5); R = (st >> 1) * 16 + swz / 64; C = (st & 1) * 32 + (swz % 64) / 2; }
__host__ __device__ __forceinline__ int perm32(int rho) { const int n = rho >> 4, i = rho & 15; return 8 * (i >> 2) + 4 * n + (i & 3); }

struct Unit { int pm, pn; };
struct Gemm { const bf16_t* A; const bf16_t* Bt; int M, N, K; };

struct StaticOrder {
    int nM, nN, nwg, G, c;
    __host__ __device__ void init(int M, int N, int G_, int c_) { nM = M / BM; nN = N / BM; nwg = nM * nN; G = G_; c = c_; }
    __host__ __device__ bool next(int i, Unit& u) const {
        const long L = (long)i * G + c; if (L >= nwg) return false;
        int wgid = (int)L; { const int q = nwg / NXCD, r = nwg % NXCD, xcd = wgid % NXCD, off = wgid / NXCD; wgid = (xcd < r ? xcd * (q + 1) : r * (q + 1) + (xcd - r) * q) + off; }
        const int nig = WGM * nN, gid = wgid / nig, fm = gid * WGM, gsz = (nM - fm) < WGM ? (nM - fm) : WGM;
        u.pm = fm + ((wgid % nig) % gsz); u.pn = (wgid % nig) / gsz; return true;
    }
    __device__ __forceinline__ void a_ready(const Unit&) const {}
    __device__ __forceinline__ void done(const Unit&) const {}
};
typedef unsigned u32x4 __attribute__((ext_vector_type(4)));
constexpr float EPSF = 1e-6f;
__device__ __forceinline__ unsigned cvt_pk_bf16(float lo, float hi) { unsigned r; asm volatile("v_cvt_pk_bf16_f32 %0, %1, %2" : "=v"(r) : "v"(lo), "v"(hi)); return r; }
__device__ __forceinline__ u32x4 pack8(const f32x4 a, const f32x4 b) { u32x4 w; w.x = cvt_pk_bf16(a[0], a[1]); w.y = cvt_pk_bf16(a[2], a[3]); w.z = cvt_pk_bf16(b[0], b[1]); w.w = cvt_pk_bf16(b[2], b[3]); return w; }
__device__ __forceinline__ float sigm(float x) { return __builtin_amdgcn_rcpf(1.0f + __builtin_amdgcn_exp2f(-1.4426950408889634f * x)); }
__device__ __forceinline__ float rstd16(const float* p) {
    const f32x4 a = ((const f32x4*)p)[0], b = ((const f32x4*)p)[1], c = ((const f32x4*)p)[2], d = ((const f32x4*)p)[3];
    const float s = ((a[0] + a[1]) + (a[2] + a[3])) + ((b[0] + b[1]) + (b[2] + b[3])) + ((c[0] + c[1]) + (c[2] + c[3])) + ((d[0] + d[1]) + (d[2] + d[3]));
    return 1.0f / sqrtf(s * (1.0f / 1024.0f) + EPSF);
}
struct EpiIn {
    static constexpr bool PERM = true, AFTER_DRAIN = false;
    bf16_t* AP; bf16_t* GLU; float* outPP; float* outCP;
    __device__ __forceinline__ void operator()(const f32x4 (&acc)[2][2][4][2], const Unit& u, int wr, int wc, int fr, int fq) const {
        const int row0 = u.pm * BM + wr * 64 + fr, cl = wc * 32 + 8 * fq;
        if (u.pn < 2) {
#pragma unroll
            for (int ai = 0; ai < 2; ++ai)
#pragma unroll
                for (int m = 0; m < 4; ++m) { const int row = row0 + ai * HALF + m * 16, t = row & 2047, b = row >> 11;
#pragma unroll
                    for (int bj = 0; bj < 2; ++bj) { const int col = u.pn * 256 + bj * HALF + cl; const f32x4 v0 = acc[ai][bj][m][0], v1 = acc[ai][bj][m][1];
                        *(u32x4*)(AP + (size_t)row * 512 + col) = pack8(v0, v1);
                        if (t >= 2033) { float* o = outPP + ((size_t)(b * 15 + t - 2033) * 512 + col); *(f32x4*)o = v0; *(f32x4*)(o + 4) = v1; } } }
        } else {
            const int ch = (u.pn - 2) * 128 + cl;
#pragma unroll
            for (int ai = 0; ai < 2; ++ai)
#pragma unroll
                for (int m = 0; m < 4; ++m) { const int row = row0 + ai * HALF + m * 16, t = row & 2047, b = row >> 11;
                    f32x4 o0, o1;
#pragma unroll
                    for (int j = 0; j < 4; ++j) { o0[j] = acc[ai][0][m][0][j] * sigm(acc[ai][1][m][0][j]); o1[j] = acc[ai][0][m][1][j] * sigm(acc[ai][1][m][1][j]); }
                    *(u32x4*)(GLU + (size_t)row * 512 + ch) = pack8(o0, o1);
                    if (t >= 2018) { float* o = outCP + ((size_t)(b * 30 + t - 2018) * 512 + ch); *(f32x4*)o = o0; *(f32x4*)(o + 4) = o1; } }
        }
    }
};
struct EpiKV {
    static constexpr bool PERM = true, AFTER_DRAIN = false;
    float* outK; float* outV; bf16_t* KB;
    __device__ __forceinline__ void operator()(const f32x4 (&acc)[2][2][4][2], const Unit& u, int wr, int wc, int fr, int fq) const {
        const int row0 = u.pm * BM + wr * 64 + fr, cl = wc * 32 + 8 * fq;
#pragma unroll
        for (int ai = 0; ai < 2; ++ai)
#pragma unroll
            for (int m = 0; m < 4; ++m) { const int row = row0 + ai * HALF + m * 16;
#pragma unroll
                for (int bj = 0; bj < 2; ++bj) { const int col = u.pn * 256 + bj * HALF + cl; const f32x4 v0 = acc[ai][bj][m][0], v1 = acc[ai][bj][m][1];
                    if (u.pn < 4) { float* o = outK + (size_t)row * 1024 + col; *(f32x4*)o = v0; *(f32x4*)(o + 4) = v1; *(u32x4*)(KB + (size_t)row * 1024 + col) = pack8(v0, v1); }
                    else { float* o = outV + (size_t)row * 1024 + (col - 1024); *(f32x4*)o = v0; *(f32x4*)(o + 4) = v1; } } }
    }
};
struct EpiPlain {
    static constexpr bool PERM = true, AFTER_DRAIN = false;
    bf16_t* O; int ldc;
    __device__ __forceinline__ void operator()(const f32x4 (&acc)[2][2][4][2], const Unit& u, int wr, int wc, int fr, int fq) const {
        const int row0 = u.pm * BM + wr * 64 + fr, cl = wc * 32 + 8 * fq;
#pragma unroll
        for (int ai = 0; ai < 2; ++ai)
#pragma unroll
            for (int m = 0; m < 4; ++m) { const int row = row0 + ai * HALF + m * 16;
#pragma unroll
                for (int bj = 0; bj < 2; ++bj) { const int col = u.pn * 256 + bj * HALF + cl; *(u32x4*)(O + (size_t)row * ldc + col) = pack8(acc[ai][bj][m][0], acc[ai][bj][m][1]); } }
    }
};
template <int MODE, bool DRAIN> struct EpiRes {
    static constexpr bool PERM = true, AFTER_DRAIN = DRAIN;
    const bf16_t* resid; bf16_t* xb; float* ssq; const float* bias; const float* rinv; const float* gain;
    __device__ __forceinline__ void body(const f32x4 (&acc)[2][2][4][2], const Unit& u, int wr, int wc, int fr, int fq, const PG8_LAS unsigned char* slot) const {
        const int row0 = u.pm * BM + wr * 64 + fr, cl = wc * 32 + 8 * fq;
        f32x4 gi[2][2], bv[2][2];
        if (MODE == 1) {
#pragma unroll
            for (int bj = 0; bj < 2; ++bj)
#pragma unroll
                for (int n = 0; n < 2; ++n) { const int col = u.pn * 256 + bj * HALF + cl + 4 * n; const f32x4 g = *(const f32x4*)(gain + col); bv[bj][n] = *(const f32x4*)(bias + col);
                    gi[bj][n] = (f32x4){__builtin_amdgcn_rcpf(g[0]), __builtin_amdgcn_rcpf(g[1]), __builtin_amdgcn_rcpf(g[2]), __builtin_amdgcn_rcpf(g[3])}; } }
#pragma unroll
        for (int ai = 0; ai < 2; ++ai)
#pragma unroll
            for (int m = 0; m < 4; ++m) { const int row = row0 + ai * HALF + m * 16; float ss = 0.f; float ri = 1.f; if (MODE == 1) ri = rinv[row];
#pragma unroll
                for (int bj = 0; bj < 2; ++bj) { const size_t off = (size_t)row * 1024 + u.pn * 256 + bj * HALF + cl;
                    const u32x4 w = DRAIN ? *(const PG8_LAS u32x4*)(slot + ((ai * 4 + m) * 2 + bj) * 1024) : *(const u32x4*)(resid + off);
                    f32x4 r0 = {__builtin_bit_cast(float, w.x << 16), __builtin_bit_cast(float, w.x & 0xffff0000u), __builtin_bit_cast(float, w.y << 16), __builtin_bit_cast(float, w.y & 0xffff0000u)};
                    f32x4 r1 = {__builtin_bit_cast(float, w.z << 16), __builtin_bit_cast(float, w.z & 0xffff0000u), __builtin_bit_cast(float, w.w << 16), __builtin_bit_cast(float, w.w & 0xffff0000u)};
                    if (MODE == 1) { r0 = r0 * ri * gi[bj][0] + bv[bj][0]; r1 = r1 * ri * gi[bj][1] + bv[bj][1]; }
                    const f32x4 x0 = r0 + acc[ai][bj][m][0], x1 = r1 + acc[ai][bj][m][1];
                    *(u32x4*)(xb + off) = pack8(x0, x1);
                    ss += ((x0[0] * x0[0] + x0[1] * x0[1]) + (x0[2] * x0[2] + x0[3] * x0[3])) + ((x1[0] * x1[0] + x1[1] * x1[1]) + (x1[2] * x1[2] + x1[3] * x1[3])); }
                ss += __shfl_xor(ss, 16); ss += __shfl_xor(ss, 32);
                if (fq == 0) ssq[(size_t)row * 16 + u.pn * 4 + wc] = ss; }
    }
    __device__ __forceinline__ void operator()(const f32x4 (&acc)[2][2][4][2], const Unit& u, int wr, int wc, int fr, int fq) const { body(acc, u, wr, wc, fr, fq, nullptr); }
    __device__ __forceinline__ void fused(f32x4 (&acc)[2][2][4][2], const Unit& u, int wr, int wc, int fr, int fq, PG8_LAS unsigned char* lds, int wid, int lane) const {
        const int row0 = u.pm * BM + wr * 64 + fr, cl = wc * 32 + 8 * fq;
        PG8_LAS unsigned char* wbase = lds + wid * 16384;
#pragma unroll
        for (int ai = 0; ai < 2; ++ai)
#pragma unroll
            for (int m = 0; m < 4; ++m)
#pragma unroll
                for (int bj = 0; bj < 2; ++bj) { const size_t off = (size_t)(row0 + ai * HALF + m * 16) * 1024 + u.pn * 256 + bj * HALF + cl;
                    __builtin_amdgcn_global_load_lds((const unsigned*)(resid + off), (PG8_LAS unsigned*)(wbase + ((ai * 4 + m) * 2 + bj) * 1024), 16, 0, 0); }
        asm volatile("s_waitcnt vmcnt(0)" ::: "memory");
        body(acc, u, wr, wc, fr, fq, wbase + lane * 16);
    }
};
struct EpiQ {
    static constexpr bool PERM = true, AFTER_DRAIN = false;
    const float* ssq; bf16_t* Q; float scale; const PG8_LAS float* rtab; int tab_pm;
    __device__ __forceinline__ void operator()(const f32x4 (&acc)[2][2][4][2], const Unit& u, int wr, int wc, int fr, int fq) const {
        const int row0 = u.pm * BM + wr * 64 + fr, cl = wc * 32 + 8 * fq;
#pragma unroll
        for (int ai = 0; ai < 2; ++ai)
#pragma unroll
            for (int m = 0; m < 4; ++m) { const int row = row0 + ai * HALF + m * 16; const float rs = (u.pm == tab_pm ? rtab[ai * HALF + wr * 64 + m * 16 + fr] : rstd16(ssq + (size_t)row * 16)) * scale;
#pragma unroll
                for (int bj = 0; bj < 2; ++bj) { const size_t off = (size_t)row * 1024 + u.pn * 256 + bj * HALF + cl;
                    *(u32x4*)(Q + off) = pack8(acc[ai][bj][m][0] * rs, acc[ai][bj][m][1] * rs); } }
    }
};
struct EpiGU {
    static constexpr bool PERM = true, AFTER_DRAIN = false;
    const float* ssq; bf16_t* F; const PG8_LAS float* rtab; int tab_pm;
    __device__ __forceinline__ void operator()(const f32x4 (&acc)[2][2][4][2], const Unit& u, int wr, int wc, int fr, int fq) const {
        const int row0 = u.pm * BM + wr * 64 + fr, cl = wc * 32 + 8 * fq;
#pragma unroll
        for (int ai = 0; ai < 2; ++ai)
#pragma unroll
            for (int m = 0; m < 4; ++m) { const int row = row0 + ai * HALF + m * 16; const float rs = u.pm == tab_pm ? rtab[ai * HALF + wr * 64 + m * 16 + fr] : rstd16(ssq + (size_t)row * 16);
                f32x4 o0, o1;
#pragma unroll
                for (int j = 0; j < 4; ++j) { const float g0 = acc[ai][0][m][0][j] * rs, g1 = acc[ai][0][m][1][j] * rs;
                    o0[j] = g0 * sigm(g0) * (acc[ai][1][m][0][j] * rs); o1[j] = g1 * sigm(g1) * (acc[ai][1][m][1][j] * rs); }
                *(u32x4*)(F + (size_t)row * 2816 + u.pn * 128 + cl) = pack8(o0, o1); }
    }
};
template <class Epi, class Sched, bool ALIGN_EPI = false, bool SP2 = false>
__device__ __forceinline__ void gemm_phase(PG8_LAS unsigned char* lds, const Gemm g, const Sched& S, const Epi& E) {
    const int tid = threadIdx.x, wid = __builtin_amdgcn_readfirstlane(tid >> 6), lane = tid & 63, wr = wid >> 2, wc = wid & 3, fr = lane & 15, fq = lane >> 4;
    const int K = g.K, nt = K / BK;
    unsigned voffA[2], voffB[2];
#pragma unroll
    for (int i = 0; i < 2; ++i) { int R, C; stage_rc(tid * 16 + i * 8192, R, C); const int Rb = Epi::PERM ? ((R & ~31) + perm32(R & 31)) : R;
        voffA[i] = (unsigned)(R * K + C) * 2u; voffB[i] = (unsigned)(Rb * K + C) * 2u; }
    const size_t kstep = (size_t)(BK * 2);
    const size_t hstep = (size_t)HALF * K * 2;
    const size_t tstep = 2 * hstep;
    const unsigned ldsw = (unsigned)wid * 1024u;
    const int aoff = lds_byte(wr * 64 + fr, fq * 8), boff = lds_byte(wc * 32 + fr, fq * 8);
#define PG8_SA(b, h) (((b) * 2 + (h)) * HTB)
#define PG8_SB(b, h) ((4 + (b) * 2 + (h)) * HTB)
#define PG8_STAGE(bufoff, gbase, voff) do { _Pragma("unroll") for (int _i = 0; _i < 2; ++_i) \
        __builtin_amdgcn_global_load_lds((const unsigned*)((const char*)(gbase) + (voff)[_i]), (PG8_LAS unsigned*)(lds + (bufoff) + ldsw + _i * 8192), 16, 0, 0); } while (0)
#define PG8_LDA(dst, b, h) do { _Pragma("unroll") for (int m = 0; m < 4; ++m) _Pragma("unroll") for (int k = 0; k < 2; ++k) dst[m][k] = *(const PG8_LAS bf16x8*)(lds + PG8_SA(b, h) + aoff + m * 2048 + k * 1024); } while (0)
#define PG8_LDB(dst, b, h) do { _Pragma("unroll") for (int n = 0; n < 2; ++n) _Pragma("unroll") for (int k = 0; k < 2; ++k) dst[n][k] = *(const PG8_LAS bf16x8*)(lds + PG8_SB(b, h) + boff + n * 2048 + k * 1024); } while (0)
#define PG8_MMA(ai, bj, At, Bt) do { __builtin_amdgcn_s_setprio(1); _Pragma("unroll") for (int m = 0; m < 4; ++m) _Pragma("unroll") for (int n = 0; n < 2; ++n) _Pragma("unroll") for (int k = 0; k < 2; ++k) \
        acc[ai][bj][m][n] = __builtin_amdgcn_mfma_f32_16x16x32_bf16(Bt[n][k], At[m][k], acc[ai][bj][m][n], 0, 0, 0); __builtin_amdgcn_s_setprio(0); } while (0)
#define PG8_WAIT_V(n) asm volatile("s_waitcnt vmcnt(" #n ")" ::: "memory")
#define PG8_WAIT_L(n) asm volatile("s_waitcnt lgkmcnt(" #n ")" ::: "memory")
#define PG8_BAR __builtin_amdgcn_s_barrier()
#define PG8_SCHED __builtin_amdgcn_sched_barrier(0)
    Unit cur, nxt; int ui = 0;
    if (!S.next(0, cur)) return;
    f32x4 acc[2][2][4][2];
#pragma unroll
    for (int a = 0; a < 2; ++a)
#pragma unroll
        for (int b = 0; b < 2; ++b)
#pragma unroll
            for (int m = 0; m < 4; ++m)
#pragma unroll
                for (int n = 0; n < 2; ++n) acc[a][b][m][n] = (f32x4){0.f, 0.f, 0.f, 0.f};
    bf16x8 At[4][2], B0[2][2], B1[2][2];
    const char* cA = (const char*)g.A + (size_t)cur.pm * tstep; const char* cB = (const char*)g.Bt + (size_t)cur.pn * tstep;
    S.a_ready(cur);
    if constexpr (SP2) {
        PG8_STAGE(PG8_SB(0, 0), cB, voffB); PG8_STAGE(PG8_SB(0, 1), cB + hstep, voffB); PG8_STAGE(PG8_SA(0, 0), cA, voffA); PG8_STAGE(PG8_SA(0, 1), cA + hstep, voffA);
        if (wr == 1) PG8_BAR;
        PG8_WAIT_V(2); PG8_BAR;
        PG8_STAGE(PG8_SB(1, 0), cB + kstep, voffB); PG8_STAGE(PG8_SA(1, 0), cA + kstep, voffA); PG8_STAGE(PG8_SB(1, 1), cB + hstep + kstep, voffB);
        PG8_WAIT_V(6); PG8_BAR;
    } else {
        PG8_STAGE(PG8_SB(0, 0), cB, voffB); PG8_STAGE(PG8_SA(0, 0), cA, voffA); PG8_STAGE(PG8_SB(0, 1), cB + hstep, voffB); PG8_STAGE(PG8_SA(0, 1), cA + hstep, voffA);
        if (wr == 1) PG8_BAR;
        PG8_WAIT_V(4); PG8_BAR;
        PG8_STAGE(PG8_SB(1, 0), cB + kstep, voffB); PG8_STAGE(PG8_SA(1, 0), cA + kstep, voffA); PG8_STAGE(PG8_SB(1, 1), cB + hstep + kstep, voffB);
        PG8_WAIT_V(6); PG8_BAR;
    }
    for (;;) {
        const bool has_next = S.next(ui + 1, nxt);
        const char* nA = has_next ? (const char*)g.A + (size_t)nxt.pm * tstep : cA; const char* nB = has_next ? (const char*)g.Bt + (size_t)nxt.pn * tstep : cB;
        for (int t = 0; t < nt; t += 2) {
            const bool last = (t == nt - 2);
            const char* a1 = cA + (size_t)(t + 1) * kstep;
            const char* a2 = last ? nA : cA + (size_t)(t + 2) * kstep; const char* b2 = last ? nB : cB + (size_t)(t + 2) * kstep;
            const char* a3 = a2 + kstep; const char* b3 = b2 + kstep;
            if (last && has_next) S.a_ready(nxt);
            if constexpr (SP2) {
            PG8_LDB(B0, 0, 0); PG8_LDB(B1, 0, 1); PG8_SCHED; PG8_LDA(At, 0, 0); PG8_STAGE(PG8_SA(1, 1), a1 + hstep, voffA);
            PG8_WAIT_V(8); PG8_WAIT_L(0); PG8_BAR; PG8_MMA(0, 0, At, B0); PG8_MMA(0, 1, At, B1); PG8_BAR; PG8_SCHED;
            PG8_LDA(At, 0, 1); PG8_STAGE(PG8_SB(0, 0), b2, voffB); PG8_STAGE(PG8_SB(0, 1), b2 + hstep, voffB); PG8_STAGE(PG8_SA(0, 0), a2, voffA);
            PG8_WAIT_V(8); PG8_WAIT_L(0); PG8_BAR; PG8_MMA(1, 0, At, B0); PG8_MMA(1, 1, At, B1); PG8_BAR; PG8_SCHED;
            PG8_LDB(B0, 1, 0); PG8_LDB(B1, 1, 1); PG8_SCHED; PG8_LDA(At, 1, 0); PG8_STAGE(PG8_SA(0, 1), a2 + hstep, voffA);
            PG8_WAIT_V(8); PG8_WAIT_L(0); PG8_BAR; PG8_MMA(0, 0, At, B0); PG8_MMA(0, 1, At, B1); PG8_BAR; PG8_SCHED;
            PG8_LDA(At, 1, 1); PG8_STAGE(PG8_SB(1, 0), b3, voffB); PG8_STAGE(PG8_SB(1, 1), b3 + hstep, voffB); PG8_STAGE(PG8_SA(1, 0), a3, voffA);
            PG8_WAIT_V(8); PG8_WAIT_L(0); PG8_BAR; PG8_MMA(1, 0, At, B0); PG8_MMA(1, 1, At, B1); PG8_BAR; PG8_SCHED;
            } else {
            PG8_LDB(B0, 0, 0); PG8_SCHED; PG8_LDA(At, 0, 0); PG8_STAGE(PG8_SA(1, 1), a1 + hstep, voffA);
            PG8_WAIT_L(8); PG8_BAR; PG8_WAIT_L(0); PG8_MMA(0, 0, At, B0); PG8_BAR; PG8_SCHED;
            PG8_LDB(B1, 0, 1); PG8_STAGE(PG8_SB(0, 0), b2, voffB);
            PG8_BAR; PG8_WAIT_L(0); PG8_MMA(0, 1, At, B1); PG8_BAR;
            PG8_LDA(At, 0, 1); PG8_STAGE(PG8_SA(0, 0), a2, voffA);
            PG8_BAR; PG8_WAIT_L(0); PG8_MMA(1, 0, At, B0); PG8_BAR; PG8_SCHED;
            PG8_STAGE(PG8_SB(0, 1), b2 + hstep, voffB);
            PG8_WAIT_V(6); PG8_BAR; PG8_MMA(1, 1, At, B1); PG8_BAR;
            PG8_LDB(B0, 1, 0); PG8_SCHED; PG8_LDA(At, 1, 0); PG8_STAGE(PG8_SA(0, 1), a2 + hstep, voffA);
            PG8_WAIT_L(8); PG8_BAR; PG8_WAIT_L(0); PG8_MMA(0, 0, At, B0); PG8_BAR; PG8_SCHED;
            PG8_LDB(B1, 1, 1); PG8_STAGE(PG8_SB(1, 0), b3, voffB);
            PG8_BAR; PG8_WAIT_L(0); PG8_MMA(0, 1, At, B1); PG8_BAR;
            PG8_LDA(At, 1, 1); PG8_STAGE(PG8_SA(1, 0), a3, voffA);
            PG8_BAR; PG8_WAIT_L(0); PG8_MMA(1, 0, At, B0); PG8_BAR; PG8_SCHED;
            PG8_STAGE(PG8_SB(1, 1), b3 + hstep, voffB);
            PG8_WAIT_V(6); PG8_BAR; PG8_MMA(1, 1, At, B1); PG8_BAR;
            }
        }
        if constexpr (ALIGN_EPI) { if (wr == 0) PG8_BAR; }
        if constexpr (!Epi::AFTER_DRAIN) { E(acc, cur, wr, wc, fr, fq); S.done(cur); }
        if (!has_next) break;
#pragma unroll
        for (int a = 0; a < 2; ++a)
#pragma unroll
            for (int b = 0; b < 2; ++b)
#pragma unroll
                for (int m = 0; m < 4; ++m)
#pragma unroll
                    for (int n = 0; n < 2; ++n) acc[a][b][m][n] = (f32x4){0.f, 0.f, 0.f, 0.f};
        cur = nxt; cA = nA; cB = nB; ++ui;
        if constexpr (ALIGN_EPI) { if (wr == 1) PG8_BAR; }
    }
    PG8_WAIT_V(0);
    if constexpr (!ALIGN_EPI) { if (wr == 0) PG8_BAR; }
    PG8_BAR;
    if constexpr (Epi::AFTER_DRAIN) { E.fused(acc, cur, wr, wc, fr, fq, lds, wid, lane); S.done(cur); }
#undef PG8_SA
#undef PG8_SB
#undef PG8_STAGE
#undef PG8_LDA
#undef PG8_LDB
#undef PG8_MMA
#undef PG8_WAIT_V
#undef PG8_WAIT_L
#undef PG8_BAR
#undef PG8_SCHED
}
}

#define LAS __attribute__((address_space(3)))
typedef unsigned short bf16;
typedef float f32x4 __attribute__((ext_vector_type(4)));
typedef short bf16x8 __attribute__((ext_vector_type(8)));
typedef unsigned u32x4 __attribute__((ext_vector_type(4)));
typedef unsigned u32x2 __attribute__((ext_vector_type(2)));
constexpr int DM = 1024, NB = 8, SEQ = 2048, MP = NB * SEQ, NS = 128, MALL = MP + NS, NMEM = 256, FF = 2816, FF2 = 5632, MMEM = NB * NMEM;
constexpr float EPS = 1e-6f;
constexpr float QSCALE = 0.0625f * 1.4426950408889634f;
constexpr size_t O_Y = 0, O_YS = 16777216, O_PP = O_YS + 131072, O_PS = O_PP + 61440, O_CP = O_PS + 983040, O_CS = O_CP + 122880, O_MK = O_CS + 1966080, O_MV = O_MK + 2097152;
constexpr size_t MiB = 1u << 20;
constexpr size_t WS_CTL = 0, CTL_ZERO_BYTES = MiB;
constexpr size_t WS_WIN = 1 * MiB, WS_WKV = 4 * MiB, WS_WOUT = 8 * MiB, WS_WQ = 10 * MiB, WS_WO = 12 * MiB, WS_WGU = 14 * MiB, WS_WD = 25 * MiB, WS_WMAP = 31 * MiB;
constexpr size_t WS_HB = 32 * MiB, WS_AP = 65 * MiB, WS_GLU = 82 * MiB, WS_C = 99 * MiB, WS_X1 = 132 * MiB, WS_X1B = 197 * MiB, WS_Q = 230 * MiB, WS_KB = 263 * MiB, WS_VT = 267 * MiB;
constexpr size_t WS_O = 271 * MiB, WS_X2B = 304 * MiB, WS_F = 337 * MiB, WS_MB = 426 * MiB, WS_SSQ1 = 430 * MiB, WS_SSQ2 = 431 * MiB, WS_SSQ3 = 432 * MiB, WS_SSQS = 433 * MiB, WS_US = 434 * MiB, WS_HC = 435 * MiB;
constexpr size_t WS_HP = WS_HC + 512 * 1024, WS_END = 436 * MiB;
constexpr int LDS_BYTES = 147456;
constexpr int NPHASE = 10;

template <int CTRL> __device__ __forceinline__ float dpp_mov(float v) { return __builtin_bit_cast(float, __builtin_amdgcn_update_dpp(0, __builtin_bit_cast(int, v), CTRL, 0xF, 0xF, true)); }
__device__ __forceinline__ float rdl(float v, int l) { return __builtin_bit_cast(float, __builtin_amdgcn_readlane(__builtin_bit_cast(int, v), l)); }
__device__ __forceinline__ float wave_sum(float v) {
    v += dpp_mov<0xB1>(v); v += dpp_mov<0x4E>(v); v += dpp_mov<0x141>(v); v += dpp_mov<0x140>(v);
    return (rdl(v, 0) + rdl(v, 16)) + (rdl(v, 32) + rdl(v, 48));
}
__device__ __forceinline__ float wave_max(float v) {
    v = fmaxf(v, dpp_mov<0xB1>(v)); v = fmaxf(v, dpp_mov<0x4E>(v)); v = fmaxf(v, dpp_mov<0x141>(v)); v = fmaxf(v, dpp_mov<0x140>(v));
    return fmaxf(fmaxf(rdl(v, 0), rdl(v, 16)), fmaxf(rdl(v, 32), rdl(v, 48)));
}
__device__ __forceinline__ unsigned f2bf(float f) { unsigned u = __builtin_bit_cast(unsigned, f); return (u + 0x7fffu + ((u >> 16) & 1u)) >> 16; }
__device__ __forceinline__ unsigned pk2(float lo, float hi) { return f2bf(lo) | (f2bf(hi) << 16); }
__device__ __forceinline__ float bf2f(bf16 v) { return __builtin_bit_cast(float, (unsigned)v << 16); }
__device__ __forceinline__ float sigm(float x) { return __builtin_amdgcn_rcpf(1.0f + __builtin_amdgcn_exp2f(-1.4426950408889634f * x)); }
#define LDS_WAIT() asm volatile("s_waitcnt lgkmcnt(0)" ::: "memory")

__device__ __forceinline__ void transpose_item(const float* W, int K, int N, const float* gk, bf16* WT, int dst_row0, LAS float* scr, int k0, int n0, int lane) {
    f32x4 v[8];
#pragma unroll
    for (int i = 0; i < 8; ++i) { const int kk = (lane >> 3) + 8 * i; v[i] = *(const f32x4*)(W + (size_t)(k0 + kk) * N + n0 + 4 * (lane & 7)); }
    if (gk) {
#pragma unroll
        for (int i = 0; i < 8; ++i) v[i] = v[i] * gk[k0 + (lane >> 3) + 8 * i]; }
#pragma unroll
    for (int i = 0; i < 8; ++i) { LAS float* d = scr + ((lane >> 3) + 8 * i) * 33 + 4 * (lane & 7); d[0] = v[i].x; d[1] = v[i].y; d[2] = v[i].z; d[3] = v[i].w; }
    LDS_WAIT();
    const int c = lane & 7;
#pragma unroll
    for (int j = 0; j < 4; ++j) { const int n = (lane >> 3) + 8 * j; const LAS float* s = scr + (8 * c) * 33 + n;
        u32x4 o; o.x = pk2(s[0 * 33], s[1 * 33]); o.y = pk2(s[2 * 33], s[3 * 33]); o.z = pk2(s[4 * 33], s[5 * 33]); o.w = pk2(s[6 * 33], s[7 * 33]);
        *(u32x4*)(WT + (size_t)(dst_row0 + n) * K + k0 + 8 * c) = o; }
    LDS_WAIT();
}
__device__ __forceinline__ void rms_load(const float* xrow, int lane, f32x4 (&v)[4]) {
    const f32x4* xr = (const f32x4*)xrow + lane;
#pragma unroll
    for (int j = 0; j < 4; ++j) v[j] = xr[64 * j];
}
__device__ __forceinline__ void rms_finish(const f32x4 (&v)[4], const float* g, bf16* orow, int lane, float* rinv) {
    const f32x4* gr = (const f32x4*)g + lane; float s = 0.f;
#pragma unroll
    for (int j = 0; j < 4; ++j) s += (v[j].x * v[j].x + v[j].y * v[j].y) + (v[j].z * v[j].z + v[j].w * v[j].w);
    const float rms = sqrtf(wave_sum(s) * (1.0f / DM) + EPS); const float rstd = 1.0f / rms;
    if (rinv && lane == 0) *rinv = rms;
    unsigned long long* o8 = (unsigned long long*)orow + lane;
#pragma unroll
    for (int j = 0; j < 4; ++j) { const f32x4 gg = gr[64 * j]; const f32x4 o = v[j] * rstd * gg;
        o8[64 * j] = (unsigned long long)pk2(o.x, o.y) | ((unsigned long long)pk2(o.z, o.w) << 32); }
}

struct Args { const float* in[28]; float* out; unsigned char* ws; int ph_lo, ph_hi; };

__device__ __forceinline__ void p0_prologue(const Args& a, LAS unsigned char* lds, int bid, int G, int tid, int lane, int wave) {
    unsigned char* ws = a.ws;
    LAS float* scr = (LAS float*)(lds + wave * 16384);
    const int gw = bid * 8 + wave, NGW = G * 8;
    constexpr int I_IN = 16 * 48, I_SQ = 16 * 32, I_GU = 16 * 88, I_D = 44 * 32, I_WP = 2048, I_CB = 256;
    constexpr int NITEMS = I_IN + 5 * I_SQ + 2 * I_GU + I_D + I_WP + I_CB;
    for (int it = gw; it < NITEMS; it += NGW) {
        int r = it;
        if (r < I_IN) { const int kb = r / 48, n0 = (r % 48) * 32; int dr;
            if (n0 < 512) dr = n0; else { int j = n0 - 512; int hi = 0; if (j >= 512) { j -= 512; hi = 128; } dr = 512 + (j >> 7) * 256 + hi + (j & 127); }
            transpose_item(a.in[8], 1024, 1536, nullptr, (bf16*)(ws + WS_WIN), dr, scr, 64 * kb, n0, lane); continue; } r -= I_IN;
        if (r < I_SQ) { transpose_item(a.in[20], 1024, 1024, nullptr, (bf16*)(ws + WS_WKV), (r % 32) * 32, scr, 64 * (r / 32), (r % 32) * 32, lane); continue; } r -= I_SQ;
        if (r < I_SQ) { transpose_item(a.in[21], 1024, 1024, nullptr, (bf16*)(ws + WS_WKV), 1024 + (r % 32) * 32, scr, 64 * (r / 32), (r % 32) * 32, lane); continue; } r -= I_SQ;
        if (r < I_SQ) { if (r >= I_SQ / 2) transpose_item(a.in[16], 1024, 1024, nullptr, (bf16*)(ws + WS_WOUT), (r % 32) * 32, scr, 64 * (r / 32), (r % 32) * 32, lane); continue; } r -= I_SQ;
        if (r < I_SQ) { transpose_item(a.in[19], 1024, 1024, a.in[17], (bf16*)(ws + WS_WQ), (r % 32) * 32, scr, 64 * (r / 32), (r % 32) * 32, lane); continue; } r -= I_SQ;
        if (r < I_SQ) { transpose_item(a.in[22], 1024, 1024, nullptr, (bf16*)(ws + WS_WO), (r % 32) * 32, scr, 64 * (r / 32), (r % 32) * 32, lane); continue; } r -= I_SQ;
        if (r < I_GU) { const int n0 = (r % 88) * 32; transpose_item(a.in[24], 1024, FF, a.in[23], (bf16*)(ws + WS_WGU), (n0 >> 7) * 256 + (n0 & 127), scr, 64 * (r / 88), n0, lane); continue; } r -= I_GU;
        if (r < I_GU) { const int n0 = (r % 88) * 32; transpose_item(a.in[25], 1024, FF, a.in[23], (bf16*)(ws + WS_WGU), (n0 >> 7) * 256 + 128 + (n0 & 127), scr, 64 * (r / 88), n0, lane); continue; } r -= I_GU;
        if (r < I_D) { transpose_item(a.in[26], FF, 1024, nullptr, (bf16*)(ws + WS_WD), (r % 32) * 32, scr, 64 * (r / 32), (r % 32) * 32, lane); continue; } r -= I_D;
if (r < I_WP) {
            const int g = r >> 9, n0 = ((r >> 3) & 63) * 16, c0 = (r & 7) * 16, fr = lane & 15, fq = lane >> 4;
            const float* Wout = a.in[16]; const float* Wm = a.in[9] + (size_t)g * 16384; const float* sc = a.in[11] + g * 128;
            f32x4 acc = {0.f, 0.f, 0.f, 0.f};
#pragma unroll
            for (int ks = 0; ks < 4; ++ks) { float av[8];
#pragma unroll
                for (int e = 0; e < 8; ++e) av[e] = Wout[(size_t)(g * 128 + 32 * ks + 8 * fq + e) * 1024 + n0 + fr];
                const f32x4 m0 = *(const f32x4*)(Wm + (c0 + fr) * 128 + 32 * ks + 8 * fq) * *(const f32x4*)(sc + 32 * ks + 8 * fq), m1 = *(const f32x4*)(Wm + (c0 + fr) * 128 + 32 * ks + 8 * fq + 4) * *(const f32x4*)(sc + 32 * ks + 8 * fq + 4);
                u32x4 aw, bw; aw.x = pk2(av[0], av[1]); aw.y = pk2(av[2], av[3]); aw.z = pk2(av[4], av[5]); aw.w = pk2(av[6], av[7]);
                bw.x = pk2(m0.x, m0.y); bw.y = pk2(m0.z, m0.w); bw.z = pk2(m1.x, m1.y); bw.w = pk2(m1.z, m1.w);
                acc = __builtin_amdgcn_mfma_f32_16x16x32_bf16(__builtin_bit_cast(bf16x8, aw), __builtin_bit_cast(bf16x8, bw), acc, 0, 0, 0); }
            bf16* WT = (bf16*)(ws + WS_WOUT);
#pragma unroll
            for (int jj = 0; jj < 4; ++jj) WT[(size_t)(n0 + 4 * fq + jj) * 1024 + g * 128 + c0 + fr] = (bf16)f2bf(acc[jj]);
            continue; } r -= I_WP;
        {
            const int nb = r & 15, cb = r >> 4; const float* Wout = a.in[16]; float part = 0.f;
#pragma unroll
            for (int e = 0; e < 32; ++e) { const int ch = 32 * cb + e; part += (a.in[10][ch] * a.in[11][ch]) * Wout[(size_t)ch * 1024 + 64 * nb + lane]; }
            atomicAdd((float*)(ws + WS_CTL + 512 * 1024) + 64 * nb + lane, part); }
    }
#define ROW_SRC(m) ((m) < MP ? a.in[0] + (size_t)(m) * DM : ((m) < MALL ? a.in[1] + (size_t)((m) - MP) * DM : a.in[2] + (size_t)((m) - MALL) * DM))
    { f32x4 cur[4], nxt[4]; int m = gw;
      if (m < MALL + MMEM) rms_load(ROW_SRC(m), lane, cur);
      for (; m < MALL + MMEM; m += NGW) { const int mn = m + NGW;
          if (mn < MALL + MMEM) rms_load(ROW_SRC(mn), lane, nxt);
          if (m < MALL) rms_finish(cur, a.in[7], (bf16*)(ws + WS_HB) + (size_t)m * DM, lane, (float*)(ws + WS_SSQ3) + m);
          else rms_finish(cur, a.in[18], (bf16*)(ws + WS_MB) + (size_t)(m - MALL) * DM, lane, nullptr);
#pragma unroll
          for (int j = 0; j < 4; ++j) cur[j] = nxt[j]; } }
#undef ROW_SRC
    const float* spool = a.in[3]; const float* sconv = a.in[4]; const float* wdw = a.in[12]; const float* bdw = a.in[13];
    float* HC = (float*)(ws + WS_HC); float* HP = (float*)(ws + WS_HP);
    for (int e2 = bid * 512 + tid; e2 < 2 * NS * 512; e2 += G * 512) {
        const int e = e2 & (NS * 512 - 1), b = e >> 9, ch = e & 511;
        if (e2 < NS * 512) {
            float v[30];
#pragma unroll
            for (int j = 0; j < 30; ++j) v[j] = sconv[(size_t)(b * 30 + j) * 512 + ch];
            float acc = bdw[ch];
#pragma unroll
            for (int j = 0; j < 30; ++j) { acc += wdw[j * 512 + ch] * v[j]; if (j >= 1) a.out[O_CS + (size_t)(b * 30 + j - 1) * 512 + ch] = v[j]; }
            HC[e] = acc;
        } else {
            float v[15];
#pragma unroll
            for (int j = 0; j < 15; ++j) v[j] = spool[(size_t)(b * 15 + j) * 512 + ch];
            const int w = 2 << (ch >> 7); float sacc = 0.f;
#pragma unroll
            for (int j = 0; j < 15; ++j) { if (j >= 1) a.out[O_PS + (size_t)(b * 15 + j - 1) * 512 + ch] = v[j]; if (j >= 16 - w) sacc += v[j]; }
            HP[e] = sacc;
        }
    }
}

template <bool PAIR, class Fn>
__device__ __forceinline__ void skinny(const bf16* A, const bf16* Bt, int K, int nColBlk, int c, int G, LAS float* red, int tid, const Fn& fn) {
    const int lane = tid & 63, wave = __builtin_amdgcn_readfirstlane(tid >> 6), fr = lane & 15, fq = lane >> 4;
    const int nItems = nColBlk * 4, kw = K >> 3;
    for (int it = c; it < nItems; it += G) {
        const int rb = it & 3, cb = it >> 2;
        const int n0 = PAIR ? ((cb >> 3) * 256 + (cb & 7) * 16) : cb * 16;
        const bf16* ap = A + (size_t)(32 * rb + fr) * K + wave * kw + 8 * fq;
        const bf16* bp = Bt + (size_t)(n0 + fr) * K + wave * kw + 8 * fq;
        f32x4 c00 = {0.f, 0.f, 0.f, 0.f}, c01 = c00, c10 = c00, c11 = c00;
        for (int ks = 0; ks < kw; ks += 32) {
            const bf16x8 b0 = *(const bf16x8*)(bp + ks), a0 = *(const bf16x8*)(ap + ks), a1 = *(const bf16x8*)(ap + (size_t)16 * K + ks);
            c00 = __builtin_amdgcn_mfma_f32_16x16x32_bf16(b0, a0, c00, 0, 0, 0); c01 = __builtin_amdgcn_mfma_f32_16x16x32_bf16(b0, a1, c01, 0, 0, 0);
            if (PAIR) { const bf16x8 b1 = *(const bf16x8*)(bp + (size_t)128 * K + ks);
                c10 = __builtin_amdgcn_mfma_f32_16x16x32_bf16(b1, a0, c10, 0, 0, 0); c11 = __builtin_amdgcn_mfma_f32_16x16x32_bf16(b1, a1, c11, 0, 0, 0); }
        }
        LAS float* rw = red + wave * 1024;
        *(LAS f32x4*)(rw + fr * 16 + 4 * fq) = c00; *(LAS f32x4*)(rw + (16 + fr) * 16 + 4 * fq) = c01;
        if (PAIR) { *(LAS f32x4*)(rw + 512 + fr * 16 + 4 * fq) = c10; *(LAS f32x4*)(rw + 512 + (16 + fr) * 16 + 4 * fq) = c11; }
        __syncthreads();
        float v0 = 0.f, v1 = 0.f;
#pragma unroll
        for (int w = 0; w < 8; ++w) { v0 += red[w * 1024 + tid]; if (PAIR) v1 += red[w * 1024 + 512 + tid]; }
        fn(32 * rb + (tid >> 4), cb * 16 + (tid & 15), cb, v0, v1);
        __syncthreads();
    }
}
__device__ __forceinline__ float red16(float s) { s += __shfl_xor(s, 1); s += __shfl_xor(s, 2); s += __shfl_xor(s, 4); s += __shfl_xor(s, 8); return s; }
__device__ __forceinline__ float rstd_s(const float* p, int row, int ci) {
    const float* q = p + row * 64 + ci; return 1.0f / sqrtf(red16((q[0] + q[16]) + (q[32] + q[48])) * (1.0f / DM) + EPS);
}
struct SkRaw { float* O; int ld; __device__ __forceinline__ void operator()(int row, int col, int, float v0, float) const { O[(size_t)row * ld + col] = v0; } };
template <bool RES_BF16> struct SkRes { const void* resid; bf16* xb; float* ssq; const float* bias;
    __device__ __forceinline__ void operator()(int row, int col, int cb, float v0, float) const {
        const size_t off = (size_t)row * DM + col; const float r = RES_BF16 ? bf2f(((const bf16*)resid)[off]) : ((const float*)resid)[off] + bias[col];
        const float x = r + v0; xb[off] = (bf16)f2bf(x);
        const float ss = red16(x * x); if ((col & 15) == 0) ssq[row * 64 + cb] = ss; } };
struct SkQ { const float* ssq; bf16* Q; __device__ __forceinline__ void operator()(int row, int col, int, float v0, float) const {
        const float rs = rstd_s(ssq, row, col & 15) * QSCALE; Q[(size_t)row * DM + col] = (bf16)f2bf(v0 * rs); } };
struct SkGU { const float* ssq; bf16* F; __device__ __forceinline__ void operator()(int row, int col, int, float v0, float v1) const {
        const float rs = rstd_s(ssq, row, col & 15); const float g = v0 * rs; F[(size_t)row * FF + col] = (bf16)f2bf(g * sigm(g) * (v1 * rs)); } };

constexpr int MX_TG = 0, MX_TA = 46 * 1024, MX_YC = MX_TA + 31 * 1024, MX_D = MX_YC + 16 * 2048, MX_DSTRIDE = 1024, MX_NPIECE = (46 + 31) * 64;
static_assert(MX_D + 16 * MX_DSTRIDE <= 131072, "mixer LDS");
template <int W> __device__ __forceinline__ void pool16(int t0, int tid, LAS unsigned char* lds) {
    float in[16 + W - 1];
#pragma unroll
    for (int i = 0; i < 16 + W - 1; ++i) in[i] = bf2f(*(const LAS bf16*)(lds + MX_TA + (16 - W + i) * 1024 + tid * 2));
#pragma unroll
    for (int r = 0; r < 16; ++r) { float s = 0.f;
#pragma unroll
        for (int j = 0; j < W; ++j) s += in[r + j];
        const int t = t0 + r; const int cnt = (t + 1 < W) ? (t + 1) : W;
        const float d = s / (float)cnt - in[r + W - 1];
        *(LAS bf16*)(lds + MX_D + r * MX_DSTRIDE + tid * 2) = (bf16)f2bf(d); }
}
struct MixP { f32x4 g0, g1, b0, b1; };
__device__ __forceinline__ void mixer_finish(const Args& a, LAS unsigned char* lds, int crow0, int tid, int lane, int wave, const MixP& P) {
    bf16* C = (bf16*)(a.ws + WS_C);
    const LAS float* yc = (const LAS float*)(lds + MX_YC);
    { const f32x4 g0 = P.g0, g1 = P.g1, b0 = P.b0, b1 = P.b1;
#pragma unroll
      for (int i = 0; i < 2; ++i) { const int r = 2 * wave + i;
        const f32x4 y0 = *(const LAS f32x4*)(yc + r * 512 + lane * 8), y1 = *(const LAS f32x4*)(yc + r * 512 + lane * 8 + 4);
        const float mu = wave_sum((y0.x + y0.y) + (y0.z + y0.w) + (y1.x + y1.y) + (y1.z + y1.w)) * (1.0f / 512.0f);
        const f32x4 d0 = y0 - mu, d1 = y1 - mu;
        const float var = wave_sum((d0.x * d0.x + d0.y * d0.y) + (d0.z * d0.z + d0.w * d0.w) + (d1.x * d1.x + d1.y * d1.y) + (d1.z * d1.z + d1.w * d1.w)) * (1.0f / 512.0f);
        const float rs = 1.0f / sqrtf(var + EPS);
        f32x4 n0 = d0 * rs * g0 + b0, n1 = d1 * rs * g1 + b1;
#pragma unroll
        for (int j = 0; j < 4; ++j) { n0[j] = n0[j] * sigm(n0[j]); n1[j] = n1[j] * sigm(n1[j]); }
        u32x4 o; o.x = pk2(n0.x, n0.y); o.y = pk2(n0.z, n0.w); o.z = pk2(n1.x, n1.y); o.w = pk2(n1.z, n1.w);
        *(u32x4*)(C + (size_t)(crow0 + r) * DM + 512 + lane * 8) = o; } }
#pragma unroll
    for (int i = 0; i < 2; ++i) { const int r = 2 * wave + i; *(u32x4*)(C + (size_t)(crow0 + r) * DM + lane * 8) = *(const LAS u32x4*)(lds + MX_D + r * MX_DSTRIDE + lane * 16); }
}
__device__ __forceinline__ void mixer_phase(const Args& a, LAS unsigned char* lds, int bid, int G, int tid, int lane, int wave) {
    const bf16* GLU = (const bf16*)(a.ws + WS_GLU); const bf16* AP = (const bf16*)(a.ws + WS_AP);
    LAS float* yc = (LAS float*)(lds + MX_YC);
    u32x4 pr[10];
#define MX_LOAD(u) do { const int b_ = (u) >> 7, t0_ = ((u) & 127) * 16; _Pragma("unroll") for (int i = 0; i < 10; ++i) { const int p = tid + 512 * i; \
        if (p < MX_NPIECE) { const bool isg = p < 46 * 64; const int q = isg ? p : p - 46 * 64; const int t = t0_ - (isg ? 30 : 15) + (q >> 6); const int tt = t < 0 ? 0 : t; \
            const u32x4 v = *(const u32x4*)((isg ? GLU : AP) + (size_t)(b_ * SEQ + tt) * 512 + (q & 63) * 8); pr[i] = t >= 0 ? v : (u32x4){0u, 0u, 0u, 0u}; } } } while (0)
    int u = bid; bool have = u < 1024;
    if (have) MX_LOAD(u);
    float w[31];
#pragma unroll
    for (int j = 0; j < 31; ++j) w[j] = a.in[12][j * 512 + tid];
    const float bias = a.in[13][tid];
    MixP P;
    P.g0 = *(const f32x4*)(a.in[14] + lane * 8); P.g1 = *(const f32x4*)(a.in[14] + lane * 8 + 4); P.b0 = *(const f32x4*)(a.in[15] + lane * 8); P.b1 = *(const f32x4*)(a.in[15] + lane * 8 + 4);
#define MX_STORE() do { _Pragma("unroll") for (int i = 0; i < 10; ++i) { const int p = tid + 512 * i; if (p < MX_NPIECE) *(LAS u32x4*)(lds + p * 16) = pr[i]; } } while (0)
    if (have) { MX_STORE(); const int un = u + G; if (un < 1024) MX_LOAD(un); }
    while (have) {
        __syncthreads();
        const int b = u >> 7, t0 = (u & 127) * 16;
        { float in[46];
#pragma unroll
          for (int i = 0; i < 46; ++i) in[i] = bf2f(*(const LAS bf16*)(lds + MX_TG + i * 1024 + tid * 2));
#pragma unroll
          for (int r = 0; r < 16; ++r) { float acc = bias;
#pragma unroll
              for (int j = 0; j < 31; ++j) acc += w[j] * in[r + j];
              yc[r * 512 + tid] = acc; } }
        { const int g = tid >> 7;
          if (g == 0) pool16<2>(t0, tid, lds); else if (g == 1) pool16<4>(t0, tid, lds); else if (g == 2) pool16<8>(t0, tid, lds); else pool16<16>(t0, tid, lds); }
        __syncthreads();
        const int un = u + G; const bool hn = un < 1024;
        if (hn) { MX_STORE(); const int unn = un + G; if (unn < 1024) MX_LOAD(unn); }
        mixer_finish(a, lds, b * SEQ + t0, tid, lane, wave, P);
        u = un; have = hn;
    }
#undef MX_STORE
#undef MX_LOAD
    const float* US = (const float*)(a.ws + WS_US); const float* HC = (const float*)(a.ws + WS_HC); const float* HP = (const float*)(a.ws + WS_HP);
    for (int su = (bid + 8) % G; su < 8; su += G) {
        __syncthreads();
        const float w30 = w[30]; const int wdt = 2 << (tid >> 7); const float invw = 1.0f / (float)wdt;
        const int gcol = 512 + (tid >> 7) * 256 + (tid & 127);
#pragma unroll
        for (int s2 = 0; s2 < 16; ++s2) { const int bs = 16 * su + s2;
            const float val = US[(size_t)bs * 1536 + gcol], gate = US[(size_t)bs * 1536 + gcol + 128], av = US[(size_t)bs * 1536 + tid];
            const float glu = val * sigm(gate);
            a.out[O_CS + (size_t)(bs * 30 + 29) * 512 + tid] = glu; a.out[O_PS + (size_t)(bs * 15 + 14) * 512 + tid] = av;
            yc[s2 * 512 + tid] = HC[bs * 512 + tid] + w30 * glu;
            const float d = (av + HP[bs * 512 + tid]) * invw - av;
            *(LAS bf16*)(lds + MX_D + s2 * MX_DSTRIDE + tid * 2) = (bf16)f2bf(d); }
        __syncthreads();
        mixer_finish(a, lds, MP + 16 * su, tid, lane, wave, P);
    }
    __syncthreads();
}

constexpr int AT_K = 0, AT_KSTR = 528, AT_V = 64 * AT_KSTR, AT_VSTR = 144;
__device__ __forceinline__ float fexp2(float x) { return __builtin_amdgcn_exp2f(x); }
__device__ __forceinline__ void attn_prompt_unit(const Args& a, LAS unsigned char* lds, int u, int tid, int lane, int wave) {
    const int qb = u & 15, h = (u >> 4) & 3, b = u >> 6, fr = lane & 15, fq = lane >> 4;
    const bf16* Q = (const bf16*)(a.ws + WS_Q); const bf16* KB = (const bf16*)(a.ws + WS_KB); const bf16* VT = (const bf16*)(a.ws + WS_VT); bf16* O = (bf16*)(a.ws + WS_O);
    const size_t rowq = (size_t)b * SEQ + qb * 128 + wave * 16 + fr;
    bf16x8 qf[8];
#pragma unroll
    for (int kd = 0; kd < 8; ++kd) qf[kd] = *(const bf16x8*)(Q + rowq * DM + h * 256 + 32 * kd + 8 * fq);
    f32x4 o[16];
#pragma unroll
    for (int i = 0; i < 16; ++i) o[i] = (f32x4){0.f, 0.f, 0.f, 0.f};
    float mrun = -INFINITY, lrun = 0.f;
    u32x4 kr[4], vr[4];
#define AT_LOAD(c) do { _Pragma("unroll") for (int i = 0; i < 4; ++i) { const int p = tid + 512 * i; \
        kr[i] = *(const u32x4*)(KB + (size_t)(b * 256 + 64 * (c) + (p >> 5)) * DM + h * 256 + (p & 31) * 8); \
        vr[i] = *(const u32x4*)(VT + (size_t)(h * 256 + (p >> 3)) * 2048 + b * 256 + 64 * (c) + (p & 7) * 8); } } while (0)
    AT_LOAD(0);
#pragma unroll 1
    for (int c = 0; c < 4; ++c) {
        __syncthreads();
#pragma unroll
        for (int i = 0; i < 4; ++i) { const int p = tid + 512 * i;
            *(LAS u32x4*)(lds + AT_K + (p >> 5) * AT_KSTR + (p & 31) * 16) = kr[i];
            *(LAS u32x4*)(lds + AT_V + (p >> 3) * AT_VSTR + (p & 7) * 16) = vr[i]; }
        __syncthreads();
        if (c < 3) AT_LOAD(c + 1);
        f32x4 s[4];
#pragma unroll
        for (int nb = 0; nb < 4; ++nb) { s[nb] = (f32x4){0.f, 0.f, 0.f, 0.f};
#pragma unroll
            for (int kd = 0; kd < 8; ++kd) { const bf16x8 kf = *(const LAS bf16x8*)(lds + AT_K + (16 * nb + fr) * AT_KSTR + kd * 64 + fq * 16);
                s[nb] = __builtin_amdgcn_mfma_f32_16x16x32_bf16(kf, qf[kd], s[nb], 0, 0, 0); } }
        float mx = s[0][0];
#pragma unroll
        for (int nb = 0; nb < 4; ++nb)
#pragma unroll
            for (int j = 0; j < 4; ++j) mx = fmaxf(mx, s[nb][j]);
        mx = fmaxf(mx, __shfl_xor(mx, 16)); mx = fmaxf(mx, __shfl_xor(mx, 32));
        const float mnew = fmaxf(mrun, mx), alpha = fexp2(mrun - mnew);
        float ps = 0.f;
#pragma unroll
        for (int nb = 0; nb < 4; ++nb)
#pragma unroll
            for (int j = 0; j < 4; ++j) { s[nb][j] = fexp2(s[nb][j] - mnew); ps += s[nb][j]; }
        ps += __shfl_xor(ps, 16); ps += __shfl_xor(ps, 32);
        lrun = lrun * alpha + ps; mrun = mnew;
#pragma unroll
        for (int i = 0; i < 16; ++i) o[i] = o[i] * alpha;
#pragma unroll
        for (int kb = 0; kb < 2; ++kb) {
            u32x4 pw; pw.x = pg8::cvt_pk_bf16(s[2 * kb][0], s[2 * kb][1]); pw.y = pg8::cvt_pk_bf16(s[2 * kb][2], s[2 * kb][3]);
            pw.z = pg8::cvt_pk_bf16(s[2 * kb + 1][0], s[2 * kb + 1][1]); pw.w = pg8::cvt_pk_bf16(s[2 * kb + 1][2], s[2 * kb + 1][3]);
            const bf16x8 pf = __builtin_bit_cast(bf16x8, pw);
#pragma unroll
            for (int db = 0; db < 16; ++db) {
                const u32x2 v0 = *(const LAS u32x2*)(lds + AT_V + (16 * db + fr) * AT_VSTR + kb * 64 + fq * 8), v1 = *(const LAS u32x2*)(lds + AT_V + (16 * db + fr) * AT_VSTR + kb * 64 + 32 + fq * 8);
                u32x4 vw; vw.x = v0.x; vw.y = v0.y; vw.z = v1.x; vw.w = v1.y;
                o[db] = __builtin_amdgcn_mfma_f32_16x16x32_bf16(__builtin_bit_cast(bf16x8, vw), pf, o[db], 0, 0, 0); }
        }
    }
#undef AT_LOAD
    const float inv = 1.0f / lrun;
#pragma unroll
    for (int db = 0; db < 16; ++db) { const f32x4 y = o[db] * inv; u32x2 w; w.x = pg8::cvt_pk_bf16(y.x, y.y); w.y = pg8::cvt_pk_bf16(y.z, y.w);
        *(u32x2*)(O + rowq * DM + h * 256 + 16 * db + 4 * fq) = w; }
}
__device__ __forceinline__ float rdlane(float v, int l) { return __builtin_bit_cast(float, __builtin_amdgcn_readlane(__builtin_bit_cast(int, v), l)); }
__device__ __forceinline__ void attn_sample_item(const Args& a, LAS unsigned char* lds, int item, int tid, int lane, int wave) {
    const int u = 2 * item + (wave >> 2), qt = wave & 3, b = u >> 2, h = u & 3;
    const bf16* Q = (const bf16*)(a.ws + WS_Q) + (size_t)(MP + b) * DM + h * 256;
    const float* ck = a.in[5] + ((size_t)(b * 256 + 64 * qt) * 4 + h) * 256 + lane * 4; const float* cv = a.in[6] + ((size_t)(b * 256 + 64 * qt) * 4 + h) * 256 + lane * 4;
    const u32x2 qw = *(const u32x2*)(Q + lane * 4);
    const f32x4 q = {__builtin_bit_cast(float, qw.x << 16), __builtin_bit_cast(float, qw.x & 0xffff0000u), __builtin_bit_cast(float, qw.y << 16), __builtin_bit_cast(float, qw.y & 0xffff0000u)};
    f32x4 A[8], B[8];
#define SA_PTR(j) (((j) < 8 ? ck : cv) + (size_t)(((j) & 7) * 8) * 1024)
#define SA_LOAD(buf, j) do { const float* bp_ = SA_PTR(j); _Pragma("unroll") for (int i = 0; i < 8; ++i) buf[i] = __builtin_nontemporal_load((const f32x4*)(bp_ + (size_t)i * 1024)); } while (0)
#define SA_DOTS(buf, j) do { _Pragma("unroll") for (int i = 0; i < 8; ++i) { const float sd = wave_sum((buf[i].x * q.x + buf[i].y * q.y) + (buf[i].z * q.z + buf[i].w * q.w)); mine = (lane == 8 * (j) + i) ? sd : mine; } } while (0)
#define SA_ACC(buf, j) do { _Pragma("unroll") for (int i = 0; i < 8; ++i) { const float pi = pl[8 * (j) + i]; acc += buf[i] * pi; } } while (0)
    float mine = 0.f;
    SA_LOAD(A, 0); SA_LOAD(B, 1);
#pragma unroll 1
    for (int j = 0; j < 8; j += 2) { SA_DOTS(A, j); SA_LOAD(A, j + 2); SA_DOTS(B, j + 1); SA_LOAD(B, j + 3); }
    const float mloc = wave_max(mine); const float p = fexp2(mine - mloc); const float lloc = wave_sum(p);
    LAS float* pl = (LAS float*)(lds + 16384) + wave * 64;
    pl[lane] = p; LDS_WAIT();
    f32x4 acc = {0.f, 0.f, 0.f, 0.f};
#pragma unroll 1
    for (int j = 0; j < 8; j += 2) { SA_ACC(A, j); if (j + 2 < 8) SA_LOAD(A, j + 10); SA_ACC(B, j + 1); if (j + 2 < 8) SA_LOAD(B, j + 11); }
#undef SA_PTR
#undef SA_LOAD
#undef SA_DOTS
#undef SA_ACC
    LAS float* po = (LAS float*)lds; LAS float* ml = po + 8 * 256;
    __syncthreads();
    *(LAS f32x4*)(po + wave * 256 + lane * 4) = acc; if (lane == 0) { ml[2 * wave] = mloc; ml[2 * wave + 1] = lloc; }
    __syncthreads();
    { const int ul = tid >> 8, d = tid & 255;
      const float m0 = ml[8 * ul], m1 = ml[8 * ul + 2], m2 = ml[8 * ul + 4], m3 = ml[8 * ul + 6];
      const float M = fmaxf(fmaxf(m0, m1), fmaxf(m2, m3));
      const float e0 = fexp2(m0 - M), e1 = fexp2(m1 - M), e2 = fexp2(m2 - M), e3 = fexp2(m3 - M);
      const float den = (e0 * ml[8 * ul + 1] + e1 * ml[8 * ul + 3]) + (e2 * ml[8 * ul + 5] + e3 * ml[8 * ul + 7]);
      const float num = (e0 * po[(4 * ul) * 256 + d] + e1 * po[(4 * ul + 1) * 256 + d]) + (e2 * po[(4 * ul + 2) * 256 + d] + e3 * po[(4 * ul + 3) * 256 + d]);
      const int uu = 2 * item + ul;
      ((bf16*)(a.ws + WS_O))[(size_t)(MP + (uu >> 2)) * DM + (uu & 3) * 256 + d] = (bf16)f2bf(num / den); }
    __syncthreads();
}

#define XB_TMO      128
#define XB_XCNT(j)  (256  + 64 * (j))
#define XB_XSUB(j)  (1280 + 64 * (j))
#define XB_XGEN(j)  (2304 + 64 * (j))
#define XB_TOP      3328
#define XB_TOPGEN   3392
#define XCD_BAR_WORDS 3456
#define XB_SPIN_CAP (1u << 18)

__device__ __forceinline__ unsigned xb_ld(unsigned* p)              { return __hip_atomic_load(p, __ATOMIC_RELAXED, __HIP_MEMORY_SCOPE_AGENT); }
__device__ __forceinline__ unsigned xb_add(unsigned* p, unsigned v) { return __hip_atomic_fetch_add(p, v, __ATOMIC_RELAXED, __HIP_MEMORY_SCOPE_AGENT); }
__device__ __forceinline__ unsigned xb_xcc_id() { return (unsigned)__builtin_amdgcn_s_getreg((3 << 11) | 20) & 0xFu; }
#define XB_SPIN(cond, bar) do { unsigned _sp = 0; while (cond) { __builtin_amdgcn_s_sleep(1); \
    if ((++_sp & 255u) == 0u) { if (xb_ld(&(bar)[XB_TMO])) break; if (_sp > XB_SPIN_CAP) { atomicAdd(&(bar)[XB_TMO], 1u); break; } } } } while (0)

struct XcdBarrier {
    unsigned* bar; unsigned x;
    volatile LAS unsigned* st;
};

__device__ __forceinline__ XcdBarrier xcd_barrier_post(unsigned* bar, volatile LAS unsigned* st) {
    XcdBarrier b; b.bar = bar; b.x = xb_xcc_id(); b.st = st;
    if (threadIdx.x == 0) (void)xb_add(&bar[XB_XCNT(b.x)], 1u);
    return b;
}
__device__ __forceinline__ void xcd_barrier_complete(unsigned* bar, unsigned x, unsigned& nloc, unsigned& nx) {
    const unsigned G = gridDim.x * gridDim.y * gridDim.z;
    unsigned sum, cnt, mine, sp = 0u;
    for (;;) {
        sum = 0u; cnt = 0u; mine = 0u;
#pragma unroll
        for (unsigned j = 0; j < 16; ++j) { const unsigned c = xb_ld(&bar[XB_XCNT(j)]); sum += c; cnt += (c > 0u) ? 1u : 0u; mine = (j == x) ? c : mine; }
        if (sum == G) break;
        __builtin_amdgcn_s_sleep(1);
        if ((++sp & 255u) == 0u) { if (xb_ld(&bar[XB_TMO])) break; if (sp > XB_SPIN_CAP) { atomicAdd(&bar[XB_TMO], 1u); break; } }
    }
    nloc = mine > 0u ? mine : 1u; nx = cnt > 0u ? cnt : 1u;
}

__device__ __forceinline__ void xcd_barrier(const XcdBarrier& b) {
    asm volatile("s_waitcnt vmcnt(0)" ::: "memory");
    __syncthreads();
    if (threadIdx.x == 0) {
        unsigned* bar = b.bar;
        __builtin_amdgcn_s_waitcnt(0);
        unsigned nloc = b.st[0], nx = b.st[1];
        if (nloc == 0u) { xcd_barrier_complete(bar, b.x, nloc, nx); b.st[0] = nloc; b.st[1] = nx; }
        const unsigned old = xb_add(&bar[XB_XSUB(b.x)], 1u);
        const unsigned gen = old / nloc;
        if (old + 1u == (gen + 1u) * nloc) {
            __builtin_amdgcn_fence(__ATOMIC_RELEASE, "agent");
            asm volatile("s_waitcnt vmcnt(0)" ::: "memory");
            const unsigned og = xb_add(&bar[XB_TOP], 1u);
            const unsigned tg = og / nx;
            if (og + 1u == (tg + 1u) * nx) xb_add(&bar[XB_TOPGEN], 1u);
            else XB_SPIN(xb_ld(&bar[XB_TOPGEN]) == tg, bar);
            __builtin_amdgcn_fence(__ATOMIC_ACQUIRE, "agent");
            xb_add(&bar[XB_XGEN(b.x)], 1u);
            asm volatile("s_waitcnt vmcnt(0)" ::: "memory");
        } else {
            XB_SPIN(xb_ld(&bar[XB_XGEN(b.x)]) == gen, bar);
            __builtin_amdgcn_fence(__ATOMIC_ACQUIRE, "agent");
            asm volatile("s_waitcnt vmcnt(0)" ::: "memory");
        }
    }
    __syncthreads();
}

constexpr int CW_BAR = 4096;
constexpr int MISC_OFF = 131072 + 320;
__global__ void __launch_bounds__(512, 2) fwd_kernel(Args a) {
    extern __shared__ __attribute__((aligned(16))) unsigned char lds_raw[];
    LAS unsigned char* lds = (LAS unsigned char*)lds_raw;
    const int tid = threadIdx.x, lane = tid & 63, wave = __builtin_amdgcn_readfirstlane(tid >> 6);
    const int G = gridDim.x, bid = blockIdx.x;
    unsigned char* ws = a.ws;
    const int lo = a.ph_lo, hi = a.ph_hi;
    cg::grid_group grid = cg::this_grid();
    for (int u = tid; u < (LDS_BYTES - 131072) / 4; u += 512) ((LAS unsigned*)(lds + 131072))[u] = 0u;
    __syncthreads();
    volatile LAS unsigned* MISC = (volatile LAS unsigned*)(lds + MISC_OFF);
    XcdBarrier bar; bar.bar = (unsigned*)(ws + WS_CTL) + CW_BAR; bar.x = 0; bar.st = nullptr;
    if (hi - lo > 1) bar = xcd_barrier_post((unsigned*)(ws + WS_CTL) + CW_BAR, MISC + 8);
    if (lo < 0) grid.sync();
#define IN(k) (lo <= (k) && (k) < hi)
#define SEAM(k) do { if (lo <= (k) && (k) + 1 < hi) xcd_barrier(bar); } while (0)
    bf16* HB = (bf16*)(ws + WS_HB); bf16* C = (bf16*)(ws + WS_C); bf16* X3B = (bf16*)(ws + WS_X1); bf16* X1B = (bf16*)(ws + WS_X1B); bf16* Qb = (bf16*)(ws + WS_Q);
    bf16* Ob = (bf16*)(ws + WS_O); bf16* X2B = (bf16*)(ws + WS_X2B); bf16* Fb = (bf16*)(ws + WS_F);
    float* SSQ1 = (float*)(ws + WS_SSQ1); float* SSQ2 = (float*)(ws + WS_SSQ2); float* SSQ3 = (float*)(ws + WS_SSQ3);
    float* SSQ1S = (float*)(ws + WS_SSQS); float* SSQ2S = SSQ1S + NS * 64; float* SSQ3S = SSQ2S + NS * 64;
    LAS float* red = (LAS float*)lds;

    if (IN(0)) { p0_prologue(a, lds, bid, G, tid, lane, wave); }
    SEAM(0);
    if (IN(1)) {
        { pg8::Gemm g{HB, (const bf16*)(ws + WS_WIN), MP, 1536, 1024}; pg8::StaticOrder S; S.init(MP, 1536, G, bid);
          pg8::EpiIn E{(bf16*)(ws + WS_AP), (bf16*)(ws + WS_GLU), a.out + O_PP, a.out + O_CP};
          pg8::gemm_phase<pg8::EpiIn, pg8::StaticOrder, true, true>(lds, g, S, E); }
        { pg8::Gemm g{(const bf16*)(ws + WS_MB), (const bf16*)(ws + WS_WKV), MMEM, 2048, 1024}; pg8::StaticOrder S; S.init(MMEM, 2048, G, (bid + G - (128 % G)) % G);
          pg8::EpiKV E{a.out + O_MK, a.out + O_MV, (bf16*)(ws + WS_KB)};
          pg8::gemm_phase<pg8::EpiKV, pg8::StaticOrder, true, true>(lds, g, S, E); }
        { pg8::Gemm g{(const bf16*)(ws + WS_WKV) + (size_t)1024 * 1024, (const bf16*)(ws + WS_MB), 1024, MMEM, 1024}; pg8::StaticOrder S; S.init(1024, MMEM, G, (bid + G - (192 % G)) % G);
          pg8::EpiPlain E{(bf16*)(ws + WS_VT), 2048};
          pg8::gemm_phase<pg8::EpiPlain, pg8::StaticOrder, true, true>(lds, g, S, E); }
        __syncthreads();
        { SkRaw f{(float*)(ws + WS_US), 1536}; const int ge = G > 32 ? 32 : G, cc = (bid + G - (224 % G)) % G; if (cc < ge) skinny<false>(HB + (size_t)MP * DM, (const bf16*)(ws + WS_WIN), 1024, 96, cc, ge, red, tid, f); }
    }
    SEAM(1);
    if (IN(2)) {
        mixer_phase(a, lds, bid, G, tid, lane, wave);
    }
    SEAM(2);
    if (IN(3)) {
        { pg8::Gemm g{C, (const bf16*)(ws + WS_WOUT), MP, 1024, 1024}; pg8::StaticOrder S; S.init(MP, 1024, G, bid);
          if (G == 256) { pg8::EpiRes<1, true> E{HB, X1B, SSQ1, (const float*)(ws + WS_CTL + 512 * 1024), (const float*)(ws + WS_SSQ3), a.in[7]}; pg8::gemm_phase<pg8::EpiRes<1, true>, pg8::StaticOrder, false, true>(lds, g, S, E); }
          else { pg8::EpiRes<1, false> E{HB, X1B, SSQ1, (const float*)(ws + WS_CTL + 512 * 1024), (const float*)(ws + WS_SSQ3), a.in[7]}; pg8::gemm_phase<pg8::EpiRes<1, false>, pg8::StaticOrder, false, true>(lds, g, S, E); } }
        __syncthreads();
        { SkRes<false> f{a.in[1], X1B + (size_t)MP * DM, SSQ1S, (const float*)(ws + WS_CTL + 512 * 1024)}; skinny<false>(C + (size_t)MP * DM, (const bf16*)(ws + WS_WOUT), 1024, 64, bid, G, red, tid, f); }
    }
    SEAM(3);
    if (IN(4)) {
        { pg8::Gemm g{X1B, (const bf16*)(ws + WS_WQ), MP, 1024, 1024}; pg8::StaticOrder S; S.init(MP, 1024, G, bid);
          LAS float* rtab = (LAS float*)(lds + 131072 + 1024); pg8::Unit u0; int tpm = -1;
          if (S.next(0, u0)) { tpm = u0.pm; if (tid < 256) rtab[tid] = pg8::rstd16(SSQ1 + (size_t)(u0.pm * 256 + tid) * 16); }
          __syncthreads();
          pg8::EpiQ E{SSQ1, Qb, QSCALE, rtab, tpm};
          pg8::gemm_phase<pg8::EpiQ, pg8::StaticOrder, false, true>(lds, g, S, E); }
        __syncthreads();
        { SkQ f{SSQ1S, Qb + (size_t)MP * DM}; skinny<false>(X1B + (size_t)MP * DM, (const bf16*)(ws + WS_WQ), 1024, 64, bid, G, red, tid, f); }
    }
    SEAM(4);
    if (IN(5)) {
        for (int u = bid; u < 512; u += G) attn_prompt_unit(a, lds, u, tid, lane, wave);
        __syncthreads();
        for (int it = bid; it < 256; it += G) attn_sample_item(a, lds, it, tid, lane, wave);
    }
    SEAM(5);
    if (IN(6)) {
        { pg8::Gemm g{Ob, (const bf16*)(ws + WS_WO), MP, 1024, 1024}; pg8::StaticOrder S; S.init(MP, 1024, G, bid);
          if (G == 256) { pg8::EpiRes<0, true> E{X1B, X2B, SSQ2, nullptr, nullptr, nullptr}; pg8::gemm_phase<pg8::EpiRes<0, true>, pg8::StaticOrder, false, true>(lds, g, S, E); }
          else { pg8::EpiRes<0, false> E{X1B, X2B, SSQ2, nullptr, nullptr, nullptr}; pg8::gemm_phase<pg8::EpiRes<0, false>, pg8::StaticOrder, false, true>(lds, g, S, E); } }
        __syncthreads();
        { SkRes<true> f{X1B + (size_t)MP * DM, X2B + (size_t)MP * DM, SSQ2S, nullptr}; skinny<false>(Ob + (size_t)MP * DM, (const bf16*)(ws + WS_WO), 1024, 64, bid, G, red, tid, f); }
    }
    SEAM(6);
    if (IN(7)) {
        { pg8::Gemm g{X2B, (const bf16*)(ws + WS_WGU), MP, FF2, 1024}; pg8::StaticOrder S; S.init(MP, FF2, G, bid);
          LAS float* rtab = (LAS float*)(lds + 131072 + 1024); pg8::Unit u0; int tpm = -1;
          if (S.next(0, u0)) { tpm = u0.pm; if (tid < 256) rtab[tid] = pg8::rstd16(SSQ2 + (size_t)(u0.pm * 256 + tid) * 16); }
          __syncthreads();
          pg8::EpiGU E{SSQ2, Fb, rtab, tpm};
          pg8::gemm_phase<pg8::EpiGU, pg8::StaticOrder, true, true>(lds, g, S, E); }
        __syncthreads();
        { SkGU f{SSQ2S, Fb + (size_t)MP * FF}; const int half = G >= 2 ? G / 2 : 1;
          if (bid >= G - half) skinny<true>(X2B + (size_t)MP * DM, (const bf16*)(ws + WS_WGU), 1024, 176, bid - (G - half), half, red, tid, f); }
    }
    SEAM(7);
    if (IN(8)) {
        { pg8::Gemm g{Fb, (const bf16*)(ws + WS_WD), MP, 1024, FF}; pg8::StaticOrder S; S.init(MP, 1024, G, bid);
          if (G == 256) { pg8::EpiRes<0, true> E{X2B, X3B, SSQ3, nullptr, nullptr, nullptr}; pg8::gemm_phase<pg8::EpiRes<0, true>, pg8::StaticOrder, false, true>(lds, g, S, E); }
          else { pg8::EpiRes<0, false> E{X2B, X3B, SSQ3, nullptr, nullptr, nullptr}; pg8::gemm_phase<pg8::EpiRes<0, false>, pg8::StaticOrder, false, true>(lds, g, S, E); } }
        __syncthreads();
        { SkRes<true> f{X2B + (size_t)MP * DM, X3B + (size_t)MP * DM, SSQ3S, nullptr}; skinny<false>(Fb + (size_t)MP * FF, (const bf16*)(ws + WS_WD), FF, 64, bid, G, red, tid, f); }
    }
    SEAM(8);
    if (IN(9)) {
        const int gw = bid * 8 + wave, NGW = G * 8;
        const f32x4* gf = (const f32x4*)a.in[27] + lane;
        for (int m = gw; m < MALL; m += NGW) {
            float* yrow; float ssum;
            if (m < MP) { yrow = a.out + O_Y + (size_t)m * DM; const float v = (lane < 16) ? SSQ3[(size_t)m * 16 + lane] : 0.f; ssum = wave_sum(v); }
            else { yrow = a.out + O_YS + (size_t)(m - MP) * DM; ssum = wave_sum(SSQ3S[(m - MP) * 64 + lane]); }
            const float rstd = 1.0f / sqrtf(ssum * (1.0f / DM) + EPS);
            const u32x2* xr = (const u32x2*)(X3B + (size_t)m * DM) + lane; f32x4* yr = (f32x4*)yrow + lane;
#pragma unroll
            for (int j = 0; j < 4; ++j) { const u32x2 w = xr[64 * j];
                const f32x4 v = {__builtin_bit_cast(float, w.x << 16), __builtin_bit_cast(float, w.x & 0xffff0000u), __builtin_bit_cast(float, w.y << 16), __builtin_bit_cast(float, w.y & 0xffff0000u)};
                yr[64 * j] = v * rstd * gf[64 * j]; }
        }
    }
#undef IN
#undef SEAM
}

#ifndef MK_MULTI
#define MK_MULTI 0
#endif
extern "C" void kernel_launch(void* const* d_in, const int* in_sizes, int n_in, void* d_out, int out_size, void* d_ws, size_t ws_size, hipStream_t stream) {
    static int grid = 0;
    if (grid == 0) {
        if (n_in != 28 || ws_size < WS_END) { fprintf(stderr, "kernel_launch: unexpected n_in %d / ws_size %zu\n", n_in, ws_size); grid = -1; return; }
        int dev = 0, cus = 0, per_cu = 0;
        (void)hipGetDevice(&dev); (void)hipDeviceGetAttribute(&cus, hipDeviceAttributeMultiprocessorCount, dev);
        if (hipFuncSetAttribute((const void*)fwd_kernel, hipFuncAttributeMaxDynamicSharedMemorySize, LDS_BYTES) != hipSuccess) { fprintf(stderr, "kernel_launch: hipFuncSetAttribute failed\n"); grid = -1; return; }
        if (hipOccupancyMaxActiveBlocksPerMultiprocessor(&per_cu, (const void*)fwd_kernel, 512, LDS_BYTES) != hipSuccess || per_cu < 1) { fprintf(stderr, "kernel_launch: occupancy query says %d\n", per_cu); per_cu = 1; }
        (void)hipGetLastError();
        grid = cus;
    }
    if (grid < 0) return;
    (void)hipMemsetAsync((char*)d_ws + WS_CTL, 0, CTL_ZERO_BYTES, stream);
    Args a{};
    for (int i = 0; i < 28; ++i) a.in[i] = (const float*)d_in[i];
    a.out = (float*)d_out; a.ws = (unsigned char*)d_ws;
#if MK_MULTI
    for (int p = 0; p < NPHASE; ++p) { a.ph_lo = p; a.ph_hi = p + 1; hipLaunchKernelGGL(fwd_kernel, dim3(grid), dim3(512), LDS_BYTES, stream, a); }
#else
    a.ph_lo = 0; a.ph_hi = NPHASE;
    void* args[] = {&a};
    hipError_t e = hipLaunchCooperativeKernel((const void*)fwd_kernel, dim3(grid), dim3(512), args, LDS_BYTES, stream);
    if (e != hipSuccess) fprintf(stderr, "cooperative launch failed: %s (grid %d)\n", hipGetErrorString(e), grid);
#endif
}
```
